# Optimizing an MI355X kernel written in HIP

```python
import math
import jax, jax.numpy as jnp
from jax import lax
import numpy as np

D_MODEL = 2048
BATCH = 1
SEQ = 8192
DEPTH = 4

HEAD_DIM = 128
D_MIX = D_MODEL
D_CONV = D_MIX // 4
D_FOX = (3 * D_MIX) // 8
D_NSA = D_MIX - D_CONV - D_FOX
H_FOX = D_FOX // HEAD_DIM
H_NSA = D_NSA // HEAD_DIM
NSA_KV_HEADS = 2
NSA_GROUP = H_NSA // NSA_KV_HEADS
NSA_KV_DIM = NSA_KV_HEADS * HEAD_DIM
CONV_WIDTH = 3
Q_BLOCK = 128
CMP_LEN = 32
CMP_STRIDE = 16
CMP_HIDDEN = 256
SEL_LEN = 64
SEL_TOPK = 16
WINDOW = 512
REL_BUCKETS = 32
REL_MAX_DIST = 128
NORM_EPS = 1e-6
NEG_BIG = -1e30
FORCED_SCORE = 1e4
N_IN = 4 * D_CONV + 4 * D_FOX + H_FOX + 2 * D_NSA + 6 * NSA_KV_DIM + 3 * H_NSA

kernel_name = "hybrid_conv_fox_nsa_trunk"


def _split_sizes():
    return ([D_CONV] * 4
            + [D_FOX] * 3 + [H_FOX, D_FOX]
            + [D_NSA] + [NSA_KV_DIM] * 6
            + [3 * H_NSA, D_NSA])


def _split_columns(proj):
    pts, acc = [], 0
    for w in _split_sizes()[:-1]:
        acc += w
        pts.append(acc)
    return jnp.split(proj, pts, axis=-1)


def _rms_norm(x, g):
    xf = x.astype(jnp.float32)
    y = xf * lax.rsqrt(jnp.mean(xf * xf, axis=-1, keepdims=True) + NORM_EPS)
    return (y * g.astype(jnp.float32)).astype(x.dtype)


def _t5_bucket(dist):
    max_exact = REL_BUCKETS // 2
    n = jnp.maximum(dist, 0)
    nf = jnp.maximum(n, max_exact).astype(jnp.float32)
    large = max_exact + (jnp.log(nf / max_exact) / math.log(REL_MAX_DIST / max_exact)
                         * (REL_BUCKETS - max_exact)).astype(jnp.int32)
    return jnp.where(n < max_exact, n, jnp.minimum(large, REL_BUCKETS - 1))


def _short_conv(u, gate_b, gate_c, conv_w):
    y = gate_c * u
    s = y.shape[1]
    yp = jnp.pad(y, ((0, 0), (CONV_WIDTH - 1, 0), (0, 0)))
    z = sum(conv_w[j] * yp[:, j:j + s] for j in range(CONV_WIDTH))
    return gate_b * z


def _forgetting_attention(q, k, v, f_logit, b_f):
    b, s, h, _ = q.shape
    scale = HEAD_DIM ** -0.5
    log_f = jax.nn.log_sigmoid(f_logit.astype(jnp.float32) + b_f.astype(jnp.float32))
    cum = lax.cumsum(log_f, axis=1).swapaxes(1, 2)
    nb = s // Q_BLOCK
    qb = q.reshape(b, nb, Q_BLOCK, h, HEAD_DIM).swapaxes(0, 1)
    cq = cum.reshape(b, h, nb, Q_BLOCK).transpose(2, 0, 1, 3)
    kpos = jnp.arange(s)

    def block(args):
        i, qi, ci = args
        qpos = i * Q_BLOCK + jnp.arange(Q_BLOCK)
        sc = jnp.einsum('bqhd,bkhd->bhqk', qi, k, preferred_element_type=jnp.float32) * scale
        sc = sc + ci[..., :, None] - cum[:, :, None, :]
        sc = jnp.where(kpos[None, :] <= qpos[:, None], sc, -jnp.inf)
        p = jax.nn.softmax(sc, axis=-1)
        return jnp.einsum('bhqk,bkhd->bqhd', p.astype(v.dtype), v)

    out = lax.map(block, (jnp.arange(nb), qb, cq))
    return out.swapaxes(0, 1).reshape(b, s, h * HEAD_DIM)


def _compress(kv, pe, w1, w2, blk_idx):
    b, _, g, _ = kv.shape
    n = blk_idx.shape[0]
    blocks = kv[:, blk_idx] + pe[:, None, :]
    flat = blocks.transpose(0, 1, 3, 2, 4).reshape(b, n, g, CMP_LEN * HEAD_DIM)
    return jax.nn.silu(flat @ w1) @ w2


def _native_sparse_attention(q, kc, vc, ks, vs, kw, vw, g_logit,
                             pe_k, w1_k, w2_k, pe_v, w1_v, w2_v, rel_bias):
    b, s = q.shape[:2]
    g_, r_ = NSA_KV_HEADS, NSA_GROUP
    scale = HEAD_DIM ** -0.5
    q = q.reshape(b, s, g_, r_, HEAD_DIM)
    kc, vc, ks, vs, kw, vw = [t.reshape(b, s, g_, HEAD_DIM) for t in (kc, vc, ks, vs, kw, vw)]

    n_cmp = (s - CMP_LEN) // CMP_STRIDE + 1
    blk_idx = np.arange(n_cmp)[:, None] * CMP_STRIDE + np.arange(CMP_LEN)[None, :]
    cmp_end = jnp.asarray(blk_idx[:, -1], dtype=jnp.int32)
    k_cmp = _compress(kc, pe_k, w1_k, w2_k, blk_idx)
    v_cmp = _compress(vc, pe_v, w1_v, w2_v, blk_idx)

    n_sel = s // SEL_LEN
    k_top = min(SEL_TOPK, n_sel)
    sel_start = np.arange(n_sel) * SEL_LEN
    c_lo = np.arange(n_cmp)[:, None] * CMP_STRIDE
    overlap = (c_lo < sel_start[None, :] + SEL_LEN) & (c_lo + CMP_LEN > sel_start[None, :])
    cmp_to_sel = jnp.asarray(overlap, dtype=jnp.float32)
    ks_blk = ks.reshape(b, n_sel, SEL_LEN, g_, HEAD_DIM).transpose(0, 3, 1, 2, 4)
    vs_blk = vs.reshape(b, n_sel, SEL_LEN, g_, HEAD_DIM).transpose(0, 3, 1, 2, 4)

    kw_pad = jnp.pad(kw, ((0, 0), (WINDOW, 0), (0, 0), (0, 0)))
    vw_pad = jnp.pad(vw, ((0, 0), (WINDOW, 0), (0, 0), (0, 0)))

    bias_tab = rel_bias.reshape(REL_BUCKETS, g_, r_).transpose(1, 2, 0)
    gates = jax.nn.sigmoid(g_logit.astype(jnp.float32)).reshape(b, s, g_, r_, 3)
    nb = s // Q_BLOCK
    qb = q.reshape(b, nb, Q_BLOCK, g_, r_, HEAD_DIM).swapaxes(0, 1)
    gb = gates.reshape(b, nb, Q_BLOCK, g_, r_, 3).swapaxes(0, 1)
    bidx = jnp.arange(b)[:, None, None, None]
    gidx = jnp.arange(g_)[None, :, None, None]
    g6 = jnp.arange(g_)[None, :, None, None, None, None]
    r6 = jnp.arange(r_)[None, None, :, None, None, None]
    sel_j = jnp.arange(n_sel)

    def block(args):
        i, qi, gi = args
        qpos = i * Q_BLOCK + jnp.arange(Q_BLOCK)

        s_c = jnp.einsum('bqgrd,bngd->bgrqn', qi, k_cmp, preferred_element_type=jnp.float32) * scale
        s_c = s_c + bias_tab[:, :, _t5_bucket(qpos[:, None] - cmp_end[None, :])]
        mask_c = cmp_end[None, :] <= qpos[:, None]
        p_c = jax.nn.softmax(jnp.where(mask_c, s_c, NEG_BIG), axis=-1)
        p_c = jnp.where(jnp.any(mask_c, axis=-1)[:, None], p_c, 0.0)
        o_c = jnp.einsum('bgrqn,bngd->bqgrd', p_c.astype(v_cmp.dtype), v_cmp)

        imp = jnp.einsum('bgrqn,nm->bgqm', p_c, cmp_to_sel)
        own = qpos // SEL_LEN
        eligible = sel_j[None, :] * SEL_LEN <= qpos[:, None]
        forced = ((sel_j[None, :] == 0) | (sel_j[None, :] == own[:, None])
                  | (sel_j[None, :] == own[:, None] - 1))
        score = jnp.where(eligible, jnp.where(forced, FORCED_SCORE, imp), -1.0)
        top_val, top_idx = lax.top_k(score, k_top)
        k_sel = ks_blk[bidx, gidx, top_idx]
        v_sel = vs_blk[bidx, gidx, top_idx]
        pos_sel = top_idx[..., None] * SEL_LEN + jnp.arange(SEL_LEN)
        dist_s = qpos[None, None, :, None, None] - pos_sel
        mask_s = (dist_s >= 0) & (top_val >= 0.0)[..., None]
        s_s = jnp.einsum('bqgrd,bgqkld->bgrqkl', qi, k_sel, preferred_element_type=jnp.float32) * scale
        s_s = s_s + bias_tab[g6, r6, _t5_bucket(dist_s)[:, :, None]]
        s_s = jnp.where(mask_s[:, :, None], s_s, NEG_BIG).reshape(b, g_, r_, Q_BLOCK, k_top * SEL_LEN)
        p_s = jax.nn.softmax(s_s, axis=-1).reshape(b, g_, r_, Q_BLOCK, k_top, SEL_LEN)
        o_s = jnp.einsum('bgrqkl,bgqkld->bqgrd', p_s.astype(v_sel.dtype), v_sel)

        k_win = lax.dynamic_slice_in_dim(kw_pad, i * Q_BLOCK, WINDOW + Q_BLOCK, axis=1)
        v_win = lax.dynamic_slice_in_dim(vw_pad, i * Q_BLOCK, WINDOW + Q_BLOCK, axis=1)
        kpos = i * Q_BLOCK - WINDOW + jnp.arange(WINDOW + Q_BLOCK)
        dist_w = qpos[:, None] - kpos[None, :]
        mask_w = (dist_w >= 0) & (dist_w < WINDOW) & (kpos[None, :] >= 0)
        s_w = jnp.einsum('bqgrd,bkgd->bgrqk', qi, k_win, preferred_element_type=jnp.float32) * scale
        s_w = s_w + bias_tab[:, :, _t5_bucket(dist_w)]
        p_w = jax.nn.softmax(jnp.where(mask_w, s_w, NEG_BIG), axis=-1)
        o_w = jnp.einsum('bgrqk,bkgd->bqgrd', p_w.astype(v_win.dtype), v_win)

        out = gi[..., 0:1] * o_c + gi[..., 1:2] * o_s + gi[..., 2:3] * o_w
        return out.astype(qi.dtype)

    out = lax.map(block, (jnp.arange(nb), qb, gb))
    return out.swapaxes(0, 1).reshape(b, s, H_NSA * HEAD_DIM)


def setup_inputs(seed: int = 0) -> dict:
    key = jax.random.key(seed)
    ks = jax.random.split(key, 18)
    f32 = jnp.float32

    def nrm(k, shape, sc):
        return jax.random.normal(k, shape, f32) * sc

    flat_cmp = CMP_LEN * HEAD_DIM
    return {
        'x': nrm(ks[0], (BATCH, SEQ, D_MODEL), 1.0),
        'c': nrm(ks[1], (BATCH, D_MODEL), 1.0),
        'w_ada': nrm(ks[2], (DEPTH, D_MODEL, 3 * D_MODEL), 0.5 * D_MODEL ** -0.5),
        'b_ada': nrm(ks[3], (DEPTH, 3 * D_MODEL), 0.02),
        'pre_norm': 1.0 + nrm(ks[4], (DEPTH, D_MODEL), 0.05),
        'post_norm': 1.0 + nrm(ks[5], (DEPTH, D_MODEL), 0.05),
        'w_in': nrm(ks[6], (DEPTH, D_MODEL, N_IN), D_MODEL ** -0.5),
        'b_forget': jax.random.uniform(ks[7], (DEPTH, H_FOX), f32, 1.0, 4.0),
        'conv_w': nrm(ks[8], (DEPTH, CONV_WIDTH, D_CONV), CONV_WIDTH ** -0.5),
        'cmp_pe_k': nrm(ks[9], (DEPTH, CMP_LEN, HEAD_DIM), 0.5),
        'cmp_w1_k': nrm(ks[10], (DEPTH, flat_cmp, CMP_HIDDEN), flat_cmp ** -0.5),
        'cmp_w2_k': nrm(ks[11], (DEPTH, CMP_HIDDEN, HEAD_DIM), 2.0 * CMP_HIDDEN ** -0.5),
        'cmp_pe_v': nrm(ks[12], (DEPTH, CMP_LEN, HEAD_DIM), 0.5),
        'cmp_w1_v': nrm(ks[13], (DEPTH, flat_cmp, CMP_HIDDEN), flat_cmp ** -0.5),
        'cmp_w2_v': nrm(ks[14], (DEPTH, CMP_HIDDEN, HEAD_DIM), 2.0 * CMP_HIDDEN ** -0.5),
        'w_out': nrm(ks[15], (DEPTH, D_MIX, D_MODEL), D_MIX ** -0.5),
        'rel_bias': nrm(ks[16], (REL_BUCKETS, H_NSA), 0.5),
    }


def reference(x, c, w_ada, b_ada, pre_norm, post_norm, w_in, b_forget, conv_w,
              cmp_pe_k, cmp_w1_k, cmp_w2_k, cmp_pe_v, cmp_w1_v, cmp_w2_v, w_out, rel_bias):
    b, s, _ = x.shape
    c_act = jax.nn.silu(c)
    for l in range(DEPTH):
        mod = c_act @ w_ada[l] + b_ada[l]
        shift, scale, gate = jnp.split(mod, 3, axis=-1)
        h = _rms_norm(x, pre_norm[l]) * (1.0 + scale[:, None]) + shift[:, None]

        proj = h @ w_in[l]
        (u_a, gb_a, gc_a, z_a,
         q_f, k_f, v_f, f_f, z_f,
         q_n, kc_n, vc_n, ks_n, vs_n, kw_n, vw_n, g_n, z_n) = _split_columns(proj)

        y_a = _short_conv(u_a, gb_a, gc_a, conv_w[l])
        y_f = _forgetting_attention(q_f.reshape(b, s, H_FOX, HEAD_DIM),
                                    k_f.reshape(b, s, H_FOX, HEAD_DIM),
                                    v_f.reshape(b, s, H_FOX, HEAD_DIM),
                                    f_f, b_forget[l])
        y_n = _native_sparse_attention(q_n, kc_n, vc_n, ks_n, vs_n, kw_n, vw_n, g_n,
                                       cmp_pe_k[l], cmp_w1_k[l], cmp_w2_k[l],
                                       cmp_pe_v[l], cmp_w1_v[l], cmp_w2_v[l], rel_bias)

        y = jnp.concatenate([y_a * jax.nn.silu(z_a),
                             y_f * jax.nn.silu(z_f),
                             y_n * jax.nn.silu(z_n)], axis=-1) @ w_out[l]
        x = x + gate[:, None] * _rms_norm(y, post_norm[l])
    return x
```

```cpp
#include <hip/hip_runtime.h>
#include <cstdio>
#include <cstdint>
#include <cmath>

namespace nv {
constexpr int S = 8192, DM = 2048, DEPTH = 4, NIN = 8216, HD = 128;
constexpr int C_U = 0, C_GB = 512, C_GC = 1024, C_ZA = 1536, C_QF = 2048, C_KF = 2816, C_VF = 3584, C_FF = 4352, C_ZF = 4358,
              C_QN = 5126, C_KC = 5894, C_VC = 6150, C_KS = 6406, C_VS = 6662, C_KW = 6918, C_VW = 7174, C_GN = 7430, C_ZN = 7448;
constexpr float SCALE = 0.08838834764831845f;
constexpr float NINF = -__builtin_inff();

__device__ __forceinline__ float siluf(float v) { return v / (1.f + expf(-v)); }
__device__ __forceinline__ float sigmf(float v) { return 1.f / (1.f + expf(-v)); }
__device__ __forceinline__ int t5_bucket(int dist) {
    int n = dist > 0 ? dist : 0;
    if (n < 16) return n;
    float nf = (float)n;
    int large = 16 + (int)(logf(nf / 16.f) / 2.0794415416798357f * 16.f);
    return large < 31 ? large : 31;
}

__global__ void k_ada(const float* c, const float* w_ada, const float* b_ada, float* mod) {
    int idx = blockIdx.x * 256 + threadIdx.x; if (idx >= DEPTH * 3 * DM) return;
    int l = idx / (3 * DM), j = idx % (3 * DM);
    const float* w = w_ada + (size_t)l * DM * 3 * DM + j;
    float acc = 0.f;
    for (int k = 0; k < DM; ++k) acc += siluf(c[k]) * w[(size_t)k * 3 * DM];
    mod[idx] = acc + b_ada[idx];
}
__global__ void k_hnorm(const float* x, const float* pre, const float* mod, float* h) {
    int s = blockIdx.x, t = threadIdx.x; __shared__ float red[256];
    const float* xr = x + (size_t)s * DM; float ss = 0.f;
    for (int i = t; i < DM; i += 256) ss += xr[i] * xr[i];
    red[t] = ss; __syncthreads();
    for (int o = 128; o > 0; o >>= 1) { if (t < o) red[t] += red[t + o]; __syncthreads(); }
    float rs = rsqrtf(red[0] / DM + 1e-6f);
    for (int i = t; i < DM; i += 256) h[(size_t)s * DM + i] = xr[i] * rs * pre[i] * (1.f + mod[DM + i]) + mod[i];
}
__global__ void k_resid(const float* xin, const float* y2, const float* post, const float* mod, float* xout) {
    int s = blockIdx.x, t = threadIdx.x; __shared__ float red[256];
    const float* yr = y2 + (size_t)s * DM; float ss = 0.f;
    for (int i = t; i < DM; i += 256) ss += yr[i] * yr[i];
    red[t] = ss; __syncthreads();
    for (int o = 128; o > 0; o >>= 1) { if (t < o) red[t] += red[t + o]; __syncthreads(); }
    float rs = rsqrtf(red[0] / DM + 1e-6f);
    for (int i = t; i < DM; i += 256) xout[(size_t)s * DM + i] = xin[(size_t)s * DM + i] + mod[2 * DM + i] * (yr[i] * rs * post[i]);
}
__global__ void __launch_bounds__(256) k_gemm(const float* A, const float* B, float* C, int M, int N, int K) {
    __shared__ float As[16][64 + 4], Bs[16][64 + 4];
    int tx = threadIdx.x & 15, ty = threadIdx.x >> 4, m0 = blockIdx.y * 64, n0 = blockIdx.x * 64;
    float acc[4][4] = {};
    for (int k0 = 0; k0 < K; k0 += 16) {
        for (int i = threadIdx.x; i < 64 * 16; i += 256) { int r = i >> 4, kk = i & 15; As[kk][r] = A[(size_t)(m0 + r) * K + k0 + kk]; }
        for (int i = threadIdx.x; i < 16 * 64; i += 256) { int kk = i >> 6, cc = i & 63; Bs[kk][cc] = (n0 + cc < N) ? B[(size_t)(k0 + kk) * N + n0 + cc] : 0.f; }
        __syncthreads();
#pragma unroll
        for (int kk = 0; kk < 16; ++kk) { float a[4], b[4];
#pragma unroll
            for (int i = 0; i < 4; ++i) { a[i] = As[kk][ty * 4 + i]; b[i] = Bs[kk][tx * 4 + i]; }
#pragma unroll
            for (int i = 0; i < 4; ++i)
#pragma unroll
                for (int j = 0; j < 4; ++j) acc[i][j] += a[i] * b[j]; }
        __syncthreads();
    }
    for (int i = 0; i < 4; ++i) for (int j = 0; j < 4; ++j) { int n = n0 + tx * 4 + j; if (n < N) C[(size_t)(m0 + ty * 4 + i) * N + n] = acc[i][j]; }
}
__global__ void k_conv(const float* proj, const float* cw, float* Y) {
    int idx = blockIdx.x * 256 + threadIdx.x; int s = idx >> 9, c = idx & 511;
    float z = 0.f;
    for (int j = 0; j < 3; ++j) { int t = s + j - 2; if (t >= 0) { const float* p = proj + (size_t)t * NIN; z += cw[j * 512 + c] * (p[C_GC + c] * p[C_U + c]); } }
    const float* p = proj + (size_t)s * NIN;
    Y[(size_t)s * DM + c] = p[C_GB + c] * z * siluf(p[C_ZA + c]);
}
__global__ void k_cum(const float* proj, const float* bf, float* cum) {
    int h = blockIdx.x, lane = threadIdx.x; float b = bf[h];
    float loc = 0.f;
    for (int i = 0; i < 128; ++i) { float v = proj[(size_t)(lane * 128 + i) * NIN + C_FF + h] + b; loc += (v > 0 ? -log1pf(expf(-v)) : v - log1pf(expf(v))); }
    float inc = loc;
    for (int o = 1; o < 64; o <<= 1) { float t = __shfl_up(inc, o); if (lane >= o) inc += t; }
    float run = inc - loc;
    for (int i = 0; i < 128; ++i) { float v = proj[(size_t)(lane * 128 + i) * NIN + C_FF + h] + b; run += (v > 0 ? -log1pf(expf(-v)) : v - log1pf(expf(v))); cum[h * S + lane * 128 + i] = run; }
}
__global__ void k_mlp1(const float* proj, const float* pe, const float* w1, float* hid, int col0) {
    int idx = blockIdx.x * 256 + threadIdx.x; if (idx >= 2 * 511 * 256) return;
    int j = idx & 255, row = idx >> 8, g = row / 511, n = row % 511;
    float acc = 0.f;
    for (int l = 0; l < 32; ++l) { const float* p = proj + (size_t)(16 * n + l) * NIN + col0 + g * 128;
        for (int d = 0; d < 128; ++d) acc += (p[d] + pe[l * 128 + d]) * w1[(size_t)(l * 128 + d) * 256 + j]; }
    hid[idx] = siluf(acc);
}
__global__ void k_mlp2(const float* hid, const float* w2, float* out) {
    int idx = blockIdx.x * 256 + threadIdx.x; if (idx >= 2 * 511 * 128) return;
    int d = idx & 127, row = idx >> 7; float acc = 0.f;
    for (int j = 0; j < 256; ++j) acc += hid[row * 256 + j] * w2[j * 128 + d];
    out[idx] = acc;
}

struct Bufs { const float* proj; const float* cum; const float* kcmp; const float* vcmp; const float* relb; const int* selidx; const float* selok; float* out; float* lse; };
template <class Spec, int R>
__global__ void __launch_bounds__(256) k_attn(Bufs b) {
    __shared__ float qs[R][128]; __shared__ float ps[R][256]; __shared__ float m_s[R], l_s[R], al_s[R];
    const int grp = blockIdx.x, tid = threadIdx.x, lane = tid & 63, wid = tid >> 6;
    Spec sp; sp.init(b, grp);
    for (int i = tid; i < R * 128; i += 256) qs[i >> 7][i & 127] = sp.q(i >> 7)[i & 127];
    if (tid < R) { m_s[tid] = NINF; l_s[tid] = 0.f; }
    constexpr int RH = (R + 1) / 2; const int d = tid & 127, half = tid >> 7;
    float o[RH];
#pragma unroll
    for (int r = 0; r < RH; ++r) o[r] = 0.f;
    const int NK = sp.nkeys();
    for (int c0 = 0; c0 < NK; c0 += 256) {
        __syncthreads();
        const int i = c0 + tid; float acc[R];
#pragma unroll
        for (int r = 0; r < R; ++r) acc[r] = 0.f;
        if (i < NK) { const float* kp = sp.k(i);
            for (int dd = 0; dd < 128; dd += 4) { float4 kv; kv.x = kp[dd]; kv.y = kp[dd + 1]; kv.z = kp[dd + 2]; kv.w = kp[dd + 3];
#pragma unroll
                for (int r = 0; r < R; ++r) acc[r] += qs[r][dd] * kv.x + qs[r][dd + 1] * kv.y + qs[r][dd + 2] * kv.z + qs[r][dd + 3] * kv.w; } }
#pragma unroll
        for (int r = 0; r < R; ++r) ps[r][tid] = (i < NK) ? sp.logit(r, i, acc[r]) : NINF;
        __syncthreads();
        for (int r = wid; r < R; r += 4) {
            float v0 = ps[r][lane], v1 = ps[r][lane + 64], v2 = ps[r][lane + 128], v3 = ps[r][lane + 192];
            float mx = fmaxf(fmaxf(v0, v1), fmaxf(v2, v3));
            for (int o2 = 32; o2 > 0; o2 >>= 1) mx = fmaxf(mx, __shfl_xor(mx, o2));
            const float mo = m_s[r], mn = fmaxf(mo, mx);
            float al = 1.f, p0 = 0.f, p1 = 0.f, p2 = 0.f, p3 = 0.f;
            if (mn > NINF) { al = (mo > NINF) ? expf(mo - mn) : 0.f; p0 = expf(v0 - mn); p1 = expf(v1 - mn); p2 = expf(v2 - mn); p3 = expf(v3 - mn); }
            float sm = p0 + p1 + p2 + p3;
            for (int o2 = 32; o2 > 0; o2 >>= 1) sm += __shfl_xor(sm, o2);
            ps[r][lane] = p0; ps[r][lane + 64] = p1; ps[r][lane + 128] = p2; ps[r][lane + 192] = p3;
            if (lane == 0) { m_s[r] = mn; l_s[r] = l_s[r] * al + sm; al_s[r] = al; }
        }
        __syncthreads();
#pragma unroll
        for (int r = 0; r < RH; ++r) { int rr = half * RH + r; if (rr < R) o[r] *= al_s[rr]; }
        const int lim = (NK - c0) < 256 ? (NK - c0) : 256;
        for (int j = 0; j < lim; ++j) { const float v = sp.v(c0 + j)[d];
#pragma unroll
            for (int r = 0; r < RH; ++r) { int rr = half * RH + r; if (rr < R) o[r] += ps[rr][j] * v; } }
    }
    __syncthreads();
#pragma unroll
    for (int r = 0; r < RH; ++r) { int rr = half * RH + r; if (rr < R) { float l = l_s[rr]; sp.store(rr, d, l > 0.f ? o[r] / l : 0.f); } }
    if (tid < R) sp.store_lse(tid, (l_s[tid] > 0.f) ? m_s[tid] + logf(l_s[tid]) : NINF);
}
__device__ __forceinline__ float relbias(const float* relb, int h, int dist) { return relb[t5_bucket(dist) * 6 + h]; }
struct FoxSpec { Bufs b; int h, q0;
    __device__ void init(const Bufs& b_, int grp) { b = b_; h = grp / (S / 16); q0 = (grp % (S / 16)) * 16; }
    __device__ const float* q(int r) const { return b.proj + (size_t)(q0 + r) * NIN + C_QF + h * 128; }
    __device__ int nkeys() const { return q0 + 16; }
    __device__ const float* k(int i) const { return b.proj + (size_t)i * NIN + C_KF + h * 128; }
    __device__ const float* v(int i) const { return b.proj + (size_t)i * NIN + C_VF + h * 128; }
    __device__ float logit(int r, int i, float dot) const { return (i <= q0 + r) ? dot * SCALE + b.cum[h * S + q0 + r] - b.cum[h * S + i] : NINF; }
    __device__ void store(int r, int d, float val) const { b.out[(size_t)(q0 + r) * 768 + h * 128 + d] = val; }
    __device__ void store_lse(int, float) const {}
};
struct WinSpec { Bufs b; int h, g, q0, lo;
    __device__ void init(const Bufs& b_, int grp) { b = b_; h = grp / (S / 16); g = h / 3; q0 = (grp % (S / 16)) * 16; lo = q0 - 511 > 0 ? q0 - 511 : 0; }
    __device__ const float* q(int r) const { return b.proj + (size_t)(q0 + r) * NIN + C_QN + h * 128; }
    __device__ int nkeys() const { return q0 + 16 - lo; }
    __device__ const float* k(int i) const { return b.proj + (size_t)(lo + i) * NIN + C_KW + g * 128; }
    __device__ const float* v(int i) const { return b.proj + (size_t)(lo + i) * NIN + C_VW + g * 128; }
    __device__ float logit(int r, int i, float dot) const { int dist = q0 + r - (lo + i); return (dist >= 0 && dist < 512) ? dot * SCALE + relbias(b.relb, h, dist) : NINF; }
    __device__ void store(int r, int d, float val) const { b.out[((size_t)h * S + q0 + r) * 128 + d] = val; }
    __device__ void store_lse(int, float) const {}
};
struct CmpSpec { Bufs b; int h, g, q0;
    __device__ void init(const Bufs& b_, int grp) { b = b_; h = grp / (S / 16); g = h / 3; q0 = (grp % (S / 16)) * 16; }
    __device__ const float* q(int r) const { return b.proj + (size_t)(q0 + r) * NIN + C_QN + h * 128; }
    __device__ int nkeys() const { return 511; }
    __device__ const float* k(int i) const { return b.kcmp + (size_t)(g * 511 + i) * 128; }
    __device__ const float* v(int i) const { return b.vcmp + (size_t)(g * 511 + i) * 128; }
    __device__ float logit(int r, int i, float dot) const { int dist = q0 + r - (16 * i + 31); return dist >= 0 ? dot * SCALE + relbias(b.relb, h, dist) : NINF; }
    __device__ void store(int r, int d, float val) const { b.out[((size_t)h * S + q0 + r) * 128 + d] = val; }
    __device__ void store_lse(int r, float v) const { b.lse[h * S + q0 + r] = v; }
};
struct SlcSpec { Bufs b; int qp, g;
    __device__ void init(const Bufs& b_, int grp) { b = b_; qp = grp >> 1; g = grp & 1; }
    __device__ const float* q(int r) const { return b.proj + (size_t)qp * NIN + C_QN + (3 * g + r) * 128; }
    __device__ int nkeys() const { return 1024; }
    __device__ int pos(int i) const { return b.selidx[(qp * 2 + g) * 16 + (i >> 6)] * 64 + (i & 63); }
    __device__ const float* k(int i) const { return b.proj + (size_t)pos(i) * NIN + C_KS + g * 128; }
    __device__ const float* v(int i) const { return b.proj + (size_t)pos(i) * NIN + C_VS + g * 128; }
    __device__ float logit(int r, int i, float dot) const { int p = pos(i); bool ok = b.selok[(qp * 2 + g) * 16 + (i >> 6)] >= 0.f && p <= qp;
        return ok ? dot * SCALE + relbias(b.relb, 3 * g + r, qp - p) : NINF; }
    __device__ void store(int r, int d, float val) const { b.out[((size_t)(3 * g + r) * S + qp) * 128 + d] = val; }
    __device__ void store_lse(int, float) const {}
};
__global__ void k_imp(const float* proj, const float* kcmp, const float* lse, const float* relb, float* imp) {
    int idx = blockIdx.x * 256 + threadIdx.x; int m = idx & 127, g = (idx >> 7) & 1, qp = idx >> 8;
    float acc = 0.f;
    if (m * 64 <= qp) {
        for (int n = 4 * m - 1; n <= 4 * m + 3; ++n) { if (n < 0 || n > 510) continue; int dist = qp - (16 * n + 31); if (dist < 0) continue;
            const float* kp = kcmp + (size_t)(g * 511 + n) * 128;
            for (int r = 0; r < 3; ++r) { int h = 3 * g + r; float ls = lse[h * S + qp]; if (!(ls > NINF)) continue;
                const float* qv = proj + (size_t)qp * NIN + C_QN + h * 128; float dot = 0.f;
                for (int d = 0; d < 128; ++d) dot += qv[d] * kp[d];
                acc += expf(dot * SCALE + relbias(relb, h, dist) - ls); } } }
    imp[idx] = acc;
}
__global__ void k_topk(const float* imp, int* selidx, float* selok) {
    int idx = blockIdx.x * 256 + threadIdx.x; if (idx >= S * 2) return; int qp = idx >> 1;
    const float* im = imp + (size_t)idx * 128; int own = qp >> 6;
    unsigned long long tk0 = 0ull, tk1 = 0ull;
    for (int t = 0; t < 16; ++t) { float best = -3.f; int bi = 0;
        for (int m = 0; m < 128; ++m) { if (((m < 64 ? tk0 >> m : tk1 >> (m - 64)) & 1ull) != 0ull) continue;
            bool elig = m * 64 <= qp, forced = (m == 0) || (m == own) || (m == own - 1);
            float sc = elig ? (forced ? 1e4f : im[m]) : -1.f;
            if (sc > best) { best = sc; bi = m; } }
        if (bi < 64) tk0 |= 1ull << bi; else tk1 |= 1ull << (bi - 64); selidx[idx * 16 + t] = bi; selok[idx * 16 + t] = best; }
}
__global__ void k_yasm(const float* proj, const float* yf, const float* oc, const float* os, const float* ow, float* Y) {
    int idx = blockIdx.x * 256 + threadIdx.x; int s = idx / 1536, c = idx % 1536; const float* p = proj + (size_t)s * NIN;
    if (c < 768) { Y[(size_t)s * DM + 512 + c] = yf[(size_t)s * 768 + c] * siluf(p[C_ZF + c]); }
    else { int cc = c - 768, h = cc >> 7, d = cc & 127; size_t o = ((size_t)h * S + s) * 128 + d;
        float g0 = sigmf(p[C_GN + h * 3 + 0]), g1 = sigmf(p[C_GN + h * 3 + 1]), g2 = sigmf(p[C_GN + h * 3 + 2]);
        Y[(size_t)s * DM + 1280 + cc] = (g0 * oc[o] + g1 * os[o] + g2 * ow[o]) * siluf(p[C_ZN + cc]); }
}
}

extern "C" void kernel_launch(void* const* d_in, const int* in_sizes, int n_in, void* d_out, int out_size, void* d_ws, size_t ws_size, hipStream_t stream) {
    using namespace nv;
    const float* x = (const float*)d_in[0]; const float* c = (const float*)d_in[1]; const float* w_ada = (const float*)d_in[2]; const float* b_ada = (const float*)d_in[3];
    const float* pre = (const float*)d_in[4]; const float* post = (const float*)d_in[5]; const float* w_in = (const float*)d_in[6]; const float* bfor = (const float*)d_in[7];
    const float* convw = (const float*)d_in[8]; const float* pe_k = (const float*)d_in[9]; const float* w1k = (const float*)d_in[10]; const float* w2k = (const float*)d_in[11];
    const float* pe_v = (const float*)d_in[12]; const float* w1v = (const float*)d_in[13]; const float* w2v = (const float*)d_in[14]; const float* w_out = (const float*)d_in[15];
    const float* relb = (const float*)d_in[16];
    float* out = (float*)d_out; char* ws = (char*)d_ws; size_t off = 0;
    auto carve = [&](size_t bytes) { void* p = ws + off; off += (bytes + 255) & ~(size_t)255; return p; };
    float* mod = (float*)carve((size_t)DEPTH * 3 * DM * 4); float* h = (float*)carve((size_t)S * DM * 4); float* proj = (float*)carve((size_t)S * NIN * 4 + 65536);
    float* Y = (float*)carve((size_t)S * DM * 4); float* Y2 = (float*)carve((size_t)S * DM * 4); float* cum = (float*)carve(6 * S * 4);
    float* hid = (float*)carve(2 * 511 * 256 * 4); float* kcmp = (float*)carve(2 * 511 * 128 * 4); float* vcmp = (float*)carve(2 * 511 * 128 * 4);
    float* yf = (float*)carve((size_t)S * 768 * 4); float* oc = (float*)carve((size_t)6 * S * 128 * 4); float* os = (float*)carve((size_t)6 * S * 128 * 4); float* ow = (float*)carve((size_t)6 * S * 128 * 4);
    float* lse = (float*)carve(6 * S * 4); float* imp = (float*)carve((size_t)S * 2 * 128 * 4); int* selidx = (int*)carve(S * 2 * 16 * 4); float* selok = (float*)carve(S * 2 * 16 * 4);
    if (off > ws_size) { fprintf(stderr, "ws too small\n"); return; }
    k_ada<<<DEPTH * 3 * DM / 256, 256, 0, stream>>>(c, w_ada, b_ada, mod);
    for (int l = 0; l < DEPTH; ++l) {
        const float* xin = l == 0 ? x : out; const float* ml = mod + (size_t)l * 3 * DM;
        k_hnorm<<<S, 256, 0, stream>>>(xin, pre + l * DM, ml, h);
        k_gemm<<<dim3((NIN + 63) / 64, S / 64), 256, 0, stream>>>(h, w_in + (size_t)l * DM * NIN, proj, S, NIN, DM);
        k_conv<<<S * 512 / 256, 256, 0, stream>>>(proj, convw + l * 3 * 512, Y);
        k_cum<<<6, 64, 0, stream>>>(proj, bfor + l * 6, cum);
        k_mlp1<<<2 * 511, 256, 0, stream>>>(proj, pe_k + l * 4096, w1k + (size_t)l * 4096 * 256, hid, C_KC);
        k_mlp2<<<(2 * 511 * 128 + 255) / 256, 256, 0, stream>>>(hid, w2k + l * 256 * 128, kcmp);
        k_mlp1<<<2 * 511, 256, 0, stream>>>(proj, pe_v + l * 4096, w1v + (size_t)l * 4096 * 256, hid, C_VC);
        k_mlp2<<<(2 * 511 * 128 + 255) / 256, 256, 0, stream>>>(hid, w2v + l * 256 * 128, vcmp);
        Bufs b{proj, cum, kcmp, vcmp, relb, selidx, selok, nullptr, lse};
        b.out = yf; k_attn<FoxSpec, 16><<<6 * S / 16, 256, 0, stream>>>(b);
        b.out = ow; k_attn<WinSpec, 16><<<6 * S / 16, 256, 0, stream>>>(b);
        b.out = oc; k_attn<CmpSpec, 16><<<6 * S / 16, 256, 0, stream>>>(b);
        k_imp<<<S * 2 * 128 / 256, 256, 0, stream>>>(proj, kcmp, lse, relb, imp);
        k_topk<<<S * 2 / 256, 256, 0, stream>>>(imp, selidx, selok);
        b.out = os; k_attn<SlcSpec, 3><<<S * 2, 256, 0, stream>>>(b);
        k_yasm<<<S * 1536 / 256, 256, 0, stream>>>(proj, yf, oc, os, ow, Y);
        k_gemm<<<dim3(DM / 64, S / 64), 256, 0, stream>>>(Y, w_out + (size_t)l * DM * DM, Y2, S, DM, DM);
        k_resid<<<S, 256, 0, stream>>>(xin, Y2, post + l * DM, ml, out);
    }
}
```

```cpp
#include <hip/hip_runtime.h>
#include <hip/hip_bf16.h>
#include <cstdio>
#include <cstdint>
#include <cmath>
#ifndef STEP_LEVEL
#define STEP_LEVEL 4
#endif
#ifndef DBG_NAIVE_SEL
#define DBG_NAIVE_SEL 0
#endif
namespace pg8 {
#define PG8_LAS __attribute__((address_space(3)))
typedef unsigned short bf16_t;
typedef short bf16x8 __attribute__((ext_vector_type(8)));
typedef float f32x4 __attribute__((ext_vector_type(4)));
typedef unsigned u32x4 __attribute__((ext_vector_type(4)));
constexpr int BM = 256, BK = 64, HALF = 128, HTB = HALF * BK * 2  , STAGE_BYTES = 8 * HTB, NXCD = 8, WGM = 8;

__host__ __device__ __forceinline__ int lds_byte(int r, int c) { const int st = (r >> 4) * 2 + (c >> 5), rr = r & 15, cc = c & 31, ob = rr * 64 + cc * 2; return st * 1024 + (ob ^ (((ob >> 9) & 1) << 5)); }
__host__ __device__ __forceinline__ void stage_rc(int b, int& R, int& C) { const int st = b / 1024, sb = b % 1024, swz = sb ^ (((sb >> 9) & 1) << 5); R = (st >> 1) * 16 + swz / 64; C = (st & 1) * 32 + (swz % 64) / 2; }
__host__ __device__ __forceinline__ int perm32(int rho) { const int n = rho >> 4, i = rho & 15; return 8 * (i >> 2) + 4 * n + (i & 3); }

struct Unit { int pm, pn; };
struct Gemm { const bf16_t* A; const bf16_t* Bt; int M, N, K; };

struct StaticOrder {
    int nM, nN, nwg, G, c;
    __host__ __device__ void init(int M, int N, int G_, int c_) { nM = M / BM; nN = N / BM; nwg = nM * nN; G = G_; c = c_; }
    __host__ __device__ bool next(int i, Unit& u) const {
        const long L = (long)i * G + c; if (L >= nwg) return false;
        int wgid = (int)L; { const int q = nwg / NXCD, r = nwg % NXCD, xcd = wgid % NXCD, off = wgid / NXCD; wgid = (xcd < r ? xcd * (q + 1) : r * (q + 1) + (xcd - r) * q) + off; }
        const int nig = WGM * nN, gid = wgid / nig, fm = gid * WGM, gsz = (nM - fm) < WGM ? (nM - fm) : WGM;
        u.pm = fm + ((wgid % nig) % gsz); u.pn = (wgid % nig) / gsz; return true;
    }
    __device__ __forceinline__ void a_ready(const Unit&) const {}
    __device__ __forceinline__ void done(const Unit&) const {}
};

__device__ __forceinline__ unsigned cvt_pk_bf16(float lo, float hi) { unsigned r; asm volatile("v_cvt_pk_bf16_f32 %0, %1, %2" : "=v"(r) : "v"(lo), "v"(hi)); return r; }
typedef float f32x2 __attribute__((ext_vector_type(2)));
__device__ __forceinline__ f32x2 gelu_pk(f32x2 v) {
    const f32x2 av = __builtin_elementwise_abs(v), d = av * 0.2316418882f + 1.0f;
    f32x2 t; t.x = __builtin_amdgcn_rcpf(d.x); t.y = __builtin_amdgcn_rcpf(d.y);
    f32x2 q = t * 0.5307027145f + (-0.7265760135f); q = q * t + 0.7107068705f; q = q * t + (-0.142248368f); q = q * t + 0.127414796f; q = q * t;
    const f32x2 s = (v * v) * (-0.72134752044f);
    f32x2 e; e.x = __builtin_amdgcn_exp2f(s.x); e.y = __builtin_amdgcn_exp2f(s.y);
    const f32x2 m = v * (q * e), r = v - m;
    f32x2 o; o.x = v.x < 0.f ? m.x : r.x; o.y = v.y < 0.f ? m.y : r.y; return o;
}

template <int ACT  > struct EpiBf16 {
    static constexpr bool PERM = true, AFTER_DRAIN = false; static_assert(ACT == 0 || ACT == 1, "EpiBf16: ACT is 0 (none) or 1 (gelu_pk)");
    bf16_t* O; int ldc; const float* bias; int split_cols; size_t split_stride; float scale0;
    __device__ __forceinline__ void operator()(const f32x4 (&acc)[2][2][4][2], const Unit& u, int wr, int wc, int fr, int fq) const {
        const int row0 = u.pm * BM + wr * 64 + fr; int colt = u.pn * BM; bf16_t* base = O;
        float sc = 1.f; if (split_cols) { const int t = colt / split_cols; base += (size_t)t * split_stride; colt -= t * split_cols; if (t == 0) sc = scale0; }
        const int col0 = colt + wc * 32 + 8 * fq, bcol0 = u.pn * BM + wc * 32 + 8 * fq;
        f32x4 bv[2][2];
#pragma unroll
        for (int bj = 0; bj < 2; ++bj)
#pragma unroll
            for (int n = 0; n < 2; ++n) bv[bj][n] = bias ? *(const f32x4*)(bias + bcol0 + bj * HALF + 4 * n) : (f32x4){0.f, 0.f, 0.f, 0.f};
#pragma unroll
        for (int ai = 0; ai < 2; ++ai)
#pragma unroll
            for (int m = 0; m < 4; ++m) { bf16_t* rowp = base + (size_t)(row0 + ai * HALF + m * 16) * ldc + col0;
#pragma unroll
                for (int bj = 0; bj < 2; ++bj) { f32x4 v0 = acc[ai][bj][m][0] + bv[bj][0], v1 = acc[ai][bj][m][1] + bv[bj][1];
                    if (ACT == 1) { f32x2 a = gelu_pk((f32x2){v0[0], v0[1]}), b = gelu_pk((f32x2){v0[2], v0[3]}), c = gelu_pk((f32x2){v1[0], v1[1]}), d = gelu_pk((f32x2){v1[2], v1[3]});
                        v0 = (f32x4){a.x, a.y, b.x, b.y}; v1 = (f32x4){c.x, c.y, d.x, d.y}; }
                    v0 = v0 * sc; v1 = v1 * sc; u32x4 w; w.x = cvt_pk_bf16(v0[0], v0[1]); w.y = cvt_pk_bf16(v0[2], v0[3]); w.z = cvt_pk_bf16(v1[0], v1[1]); w.w = cvt_pk_bf16(v1[2], v1[3]);
                    *(u32x4*)(rowp + bj * HALF) = w; } }
    }
};
struct EpiProj {
    static constexpr bool PERM = true, AFTER_DRAIN = false;
    bf16_t* conv; bf16_t* zf; bf16_t* zn; bf16_t* att;
    __device__ __forceinline__ void operator()(const f32x4 (&acc)[2][2][4][2], const Unit& u, int wr, int wc, int fr, int fq) const {
        const int pn = u.pn; bf16_t* base; int ld; size_t hs; constexpr size_t HS = (size_t)8192 * 128;
        if (pn < 8) { base = conv + pn * 256; ld = 2048; hs = 128; }
        else if (pn < 17) { base = att + (size_t)((pn - 8) * 2) * HS; ld = 128; hs = HS; }
        else if (pn < 20) { base = zf + (pn - 17) * 256; ld = 768; hs = 128; }
        else if (pn < 29) { base = att + (size_t)(18 + (pn - 20) * 2) * HS; ld = 128; hs = HS; }
        else { base = zn + (pn - 29) * 256; ld = 768; hs = 128; }
        const int row0 = u.pm * BM + wr * 64 + fr, col0 = wc * 32 + 8 * fq;
#pragma unroll
        for (int ai = 0; ai < 2; ++ai)
#pragma unroll
            for (int m = 0; m < 4; ++m) { bf16_t* rowp = base + (size_t)(row0 + ai * HALF + m * 16) * ld + col0;
#pragma unroll
                for (int bj = 0; bj < 2; ++bj) { const f32x4 v0 = acc[ai][bj][m][0], v1 = acc[ai][bj][m][1];
                    u32x4 w; w.x = cvt_pk_bf16(v0[0], v0[1]); w.y = cvt_pk_bf16(v0[2], v0[3]); w.z = cvt_pk_bf16(v1[0], v1[1]); w.w = cvt_pk_bf16(v1[2], v1[3]);
                    *(u32x4*)(rowp + (size_t)bj * hs) = w; } }
    }
};
struct EpiF32 {
    static constexpr bool PERM = false, AFTER_DRAIN = false;
    float* O; int ldc;
    __device__ __forceinline__ void operator()(const f32x4 (&acc)[2][2][4][2], const Unit& u, int wr, int wc, int fr, int fq) const {
        const int row0 = u.pm * BM + wr * 64 + fr, col0 = u.pn * BM + wc * 32 + 4 * fq;
#pragma unroll
        for (int ai = 0; ai < 2; ++ai)
#pragma unroll
            for (int m = 0; m < 4; ++m) { float* rowp = O + (size_t)(row0 + ai * HALF + m * 16) * ldc + col0;
#pragma unroll
                for (int bj = 0; bj < 2; ++bj)
#pragma unroll
                    for (int n = 0; n < 2; ++n) *(f32x4*)(rowp + bj * HALF + n * 16) = acc[ai][bj][m][n]; }
    }
};
template <class Epi, class Sched, bool ALIGN_EPI = false, bool SP2 = false>
__device__ __forceinline__ void gemm_phase(PG8_LAS unsigned char* lds, const Gemm g, const Sched& S, const Epi& E, const int tid) {
    const int wid = __builtin_amdgcn_readfirstlane(tid >> 6), lane = tid & 63, wr = wid >> 2, wc = wid & 3, fr = lane & 15, fq = lane >> 4;
    const int K = g.K, nt = K / BK;
    unsigned voffA[2], voffB[2];
#pragma unroll
    for (int i = 0; i < 2; ++i) { int R, C; stage_rc(tid * 16 + i * 8192, R, C); const int Rb = Epi::PERM ? ((R & ~31) + perm32(R & 31)) : R;
        voffA[i] = (unsigned)(R * K + C) * 2u; voffB[i] = (unsigned)(Rb * K + C) * 2u; }
    const size_t kstep = (size_t)(BK * 2);
    const size_t hstep = (size_t)HALF * K * 2;
    const size_t tstep = 2 * hstep;
    const unsigned ldsw = (unsigned)wid * 1024u;
    const int aoff = lds_byte(wr * 64 + fr, fq * 8), boff = lds_byte(wc * 32 + fr, fq * 8);
#define PG8_SA(b, h) (((b) * 2 + (h)) * HTB)
#define PG8_SB(b, h) ((4 + (b) * 2 + (h)) * HTB)
#define PG8_STAGE(bufoff, gbase, voff) do { _Pragma("unroll") for (int _i = 0; _i < 2; ++_i) \
        __builtin_amdgcn_global_load_lds((const unsigned*)((const char*)(gbase) + (voff)[_i]), (PG8_LAS unsigned*)(lds + (bufoff) + ldsw + _i * 8192), 16, 0, 0); } while (0)
#define PG8_LDA(dst, b, h) do { _Pragma("unroll") for (int m = 0; m < 4; ++m) _Pragma("unroll") for (int k = 0; k < 2; ++k) dst[m][k] = *(const PG8_LAS bf16x8*)(lds + PG8_SA(b, h) + aoff + m * 2048 + k * 1024); } while (0)
#define PG8_LDB(dst, b, h) do { _Pragma("unroll") for (int n = 0; n < 2; ++n) _Pragma("unroll") for (int k = 0; k < 2; ++k) dst[n][k] = *(const PG8_LAS bf16x8*)(lds + PG8_SB(b, h) + boff + n * 2048 + k * 1024); } while (0)
#define PG8_MMA(ai, bj, At, Bt) do { __builtin_amdgcn_s_setprio(1); _Pragma("unroll") for (int m = 0; m < 4; ++m) _Pragma("unroll") for (int n = 0; n < 2; ++n) _Pragma("unroll") for (int k = 0; k < 2; ++k) \
        acc[ai][bj][m][n] = __builtin_amdgcn_mfma_f32_16x16x32_bf16(Bt[n][k], At[m][k], acc[ai][bj][m][n], 0, 0, 0); __builtin_amdgcn_s_setprio(0); } while (0)
#define PG8_WAIT_V(n) asm volatile("s_waitcnt vmcnt(" #n ")" ::: "memory")
#define PG8_WAIT_L(n) asm volatile("s_waitcnt lgkmcnt(" #n ")" ::: "memory")
#define PG8_BAR __builtin_amdgcn_s_barrier()
#define PG8_SCHED __builtin_amdgcn_sched_barrier(0)
    Unit cur, nxt; int ui = 0;
    if (!S.next(0, cur)) return;
    f32x4 acc[2][2][4][2];
#pragma unroll
    for (int a = 0; a < 2; ++a)
#pragma unroll
        for (int b = 0; b < 2; ++b)
#pragma unroll
            for (int m = 0; m < 4; ++m)
#pragma unroll
                for (int n = 0; n < 2; ++n) acc[a][b][m][n] = (f32x4){0.f, 0.f, 0.f, 0.f};
    bf16x8 At[4][2], B0[2][2], B1[2][2];
    const char* cA = (const char*)g.A + (size_t)cur.pm * tstep; const char* cB = (const char*)g.Bt + (size_t)cur.pn * tstep;
    S.a_ready(cur);
    if constexpr (SP2) {
        PG8_STAGE(PG8_SB(0, 0), cB, voffB); PG8_STAGE(PG8_SB(0, 1), cB + hstep, voffB); PG8_STAGE(PG8_SA(0, 0), cA, voffA); PG8_STAGE(PG8_SA(0, 1), cA + hstep, voffA);
        if (wr == 1) PG8_BAR;
        PG8_WAIT_V(2); PG8_BAR;
        PG8_STAGE(PG8_SB(1, 0), cB + kstep, voffB); PG8_STAGE(PG8_SA(1, 0), cA + kstep, voffA); PG8_STAGE(PG8_SB(1, 1), cB + hstep + kstep, voffB);
        PG8_WAIT_V(6); PG8_BAR;
    } else {
        PG8_STAGE(PG8_SB(0, 0), cB, voffB); PG8_STAGE(PG8_SA(0, 0), cA, voffA); PG8_STAGE(PG8_SB(0, 1), cB + hstep, voffB); PG8_STAGE(PG8_SA(0, 1), cA + hstep, voffA);
        if (wr == 1) PG8_BAR;
        PG8_WAIT_V(4); PG8_BAR;
        PG8_STAGE(PG8_SB(1, 0), cB + kstep, voffB); PG8_STAGE(PG8_SA(1, 0), cA + kstep, voffA); PG8_STAGE(PG8_SB(1, 1), cB + hstep + kstep, voffB);
        PG8_WAIT_V(6); PG8_BAR;
    }
    for (;;) {
        const bool has_next = S.next(ui + 1, nxt);
        const char* nA = has_next ? (const char*)g.A + (size_t)nxt.pm * tstep : cA; const char* nB = has_next ? (const char*)g.Bt + (size_t)nxt.pn * tstep : cB;
        for (int t = 0; t < nt; t += 2) {
            const bool last = (t == nt - 2);
            const char* a1 = cA + (size_t)(t + 1) * kstep;
            const char* a2 = last ? nA : cA + (size_t)(t + 2) * kstep; const char* b2 = last ? nB : cB + (size_t)(t + 2) * kstep;
            const char* a3 = a2 + kstep; const char* b3 = b2 + kstep;
            if (last && has_next) S.a_ready(nxt);
            if constexpr (SP2) {
            PG8_LDB(B0, 0, 0); PG8_LDB(B1, 0, 1); PG8_SCHED; PG8_LDA(At, 0, 0); PG8_STAGE(PG8_SA(1, 1), a1 + hstep, voffA);
            PG8_WAIT_V(8); PG8_WAIT_L(0); PG8_BAR; PG8_MMA(0, 0, At, B0); PG8_MMA(0, 1, At, B1); PG8_BAR; PG8_SCHED;
            PG8_LDA(At, 0, 1); PG8_STAGE(PG8_SB(0, 0), b2, voffB); PG8_STAGE(PG8_SB(0, 1), b2 + hstep, voffB); PG8_STAGE(PG8_SA(0, 0), a2, voffA);
            PG8_WAIT_V(8); PG8_WAIT_L(0); PG8_BAR; PG8_MMA(1, 0, At, B0); PG8_MMA(1, 1, At, B1); PG8_BAR; PG8_SCHED;
            PG8_LDB(B0, 1, 0); PG8_LDB(B1, 1, 1); PG8_SCHED; PG8_LDA(At, 1, 0); PG8_STAGE(PG8_SA(0, 1), a2 + hstep, voffA);
            PG8_WAIT_V(8); PG8_WAIT_L(0); PG8_BAR; PG8_MMA(0, 0, At, B0); PG8_MMA(0, 1, At, B1); PG8_BAR; PG8_SCHED;
            PG8_LDA(At, 1, 1); PG8_STAGE(PG8_SB(1, 0), b3, voffB); PG8_STAGE(PG8_SB(1, 1), b3 + hstep, voffB); PG8_STAGE(PG8_SA(1, 0), a3, voffA);
            PG8_WAIT_V(8); PG8_WAIT_L(0); PG8_BAR; PG8_MMA(1, 0, At, B0); PG8_MMA(1, 1, At, B1); PG8_BAR; PG8_SCHED;
            } else {
            PG8_LDB(B0, 0, 0); PG8_SCHED; PG8_LDA(At, 0, 0); PG8_STAGE(PG8_SA(1, 1), a1 + hstep, voffA);
            PG8_WAIT_L(8); PG8_BAR; PG8_WAIT_L(0); PG8_MMA(0, 0, At, B0); PG8_BAR; PG8_SCHED;
            PG8_LDB(B1, 0, 1); PG8_STAGE(PG8_SB(0, 0), b2, voffB);
            PG8_BAR; PG8_WAIT_L(0); PG8_MMA(0, 1, At, B1); PG8_BAR;
            PG8_LDA(At, 0, 1); PG8_STAGE(PG8_SA(0, 0), a2, voffA);
            PG8_BAR; PG8_WAIT_L(0); PG8_MMA(1, 0, At, B0); PG8_BAR; PG8_SCHED;
            PG8_STAGE(PG8_SB(0, 1), b2 + hstep, voffB);
            PG8_WAIT_V(6); PG8_BAR; PG8_MMA(1, 1, At, B1); PG8_BAR;
            PG8_LDB(B0, 1, 0); PG8_SCHED; PG8_LDA(At, 1, 0); PG8_STAGE(PG8_SA(0, 1), a2 + hstep, voffA);
            PG8_WAIT_L(8); PG8_BAR; PG8_WAIT_L(0); PG8_MMA(0, 0, At, B0); PG8_BAR; PG8_SCHED;
            PG8_LDB(B1, 1, 1); PG8_STAGE(PG8_SB(1, 0), b3, voffB);
            PG8_BAR; PG8_WAIT_L(0); PG8_MMA(0, 1, At, B1); PG8_BAR;
            PG8_LDA(At, 1, 1); PG8_STAGE(PG8_SA(1, 0), a3, voffA);
            PG8_BAR; PG8_WAIT_L(0); PG8_MMA(1, 0, At, B0); PG8_BAR; PG8_SCHED;
            PG8_STAGE(PG8_SB(1, 1), b3 + hstep, voffB);
            PG8_WAIT_V(6); PG8_BAR; PG8_MMA(1, 1, At, B1); PG8_BAR;
            }
        }
        if constexpr (ALIGN_EPI) { if (wr == 0) PG8_BAR; }
        if constexpr (!Epi::AFTER_DRAIN) { E(acc, cur, wr, wc, fr, fq); S.done(cur); }
        if (!has_next) break;
#pragma unroll
        for (int a = 0; a < 2; ++a)
#pragma unroll
            for (int b = 0; b < 2; ++b)
#pragma unroll
                for (int m = 0; m < 4; ++m)
#pragma unroll
                    for (int n = 0; n < 2; ++n) acc[a][b][m][n] = (f32x4){0.f, 0.f, 0.f, 0.f};
        cur = nxt; cA = nA; cB = nB; ++ui;
        if constexpr (ALIGN_EPI) { if (wr == 1) PG8_BAR; }
    }
    PG8_WAIT_V(0);
    if constexpr (!ALIGN_EPI) { if (wr == 0) PG8_BAR; }
    PG8_BAR;
    if constexpr (Epi::AFTER_DRAIN) { E.fused(acc, cur, wr, wc, fr, fq, lds, wid, lane); S.done(cur); }
#undef PG8_SA
#undef PG8_SB
#undef PG8_STAGE
#undef PG8_LDA
#undef PG8_LDB
#undef PG8_MMA
#undef PG8_WAIT_V
#undef PG8_WAIT_L
#undef PG8_BAR
#undef PG8_SCHED
}
}
namespace att {
typedef unsigned short bf16;
typedef short bf16x8 __attribute__((ext_vector_type(8)));
typedef short s16x4 __attribute__((ext_vector_type(4)));
typedef float f32x16 __attribute__((ext_vector_type(16)));
typedef float f32x4 __attribute__((ext_vector_type(4)));
typedef unsigned u32x4 __attribute__((ext_vector_type(4)));
enum { MODE_FOX = 0, MODE_WIN = 1, MODE_SLC = 2 };
constexpr int D = 128, NW = 8, QBLK = 32, KVBLK = 64, QB = NW * QBLK, SEQ = 8192;
constexpr float SCALE = 0.08838834764831845f, THR = 8.f;
constexpr int SHM_V = KVBLK * D * 2, SHM_K = KVBLK * D * 2;
constexpr int LDS_Q = 2 * SHM_V + 2 * SHM_K, LDS_WSF = LDS_Q + NW * QBLK * D * 2, LDS_T5 = LDS_WSF + NW * 128 * 4, LDS_BIAS = LDS_T5 + 6 * 132 * 4, ATT_LDS_BYTES = LDS_BIAS + 512;
constexpr int WBIG = 1 << 30;
#define KSWZ(row, colB) ((row) * 256 + ((colB) ^ (((row) & 7) << 4)))
#define SBAR() __builtin_amdgcn_sched_barrier(0)
__device__ __forceinline__ int v_st(int k, int c) { const int kk = (k & ~0xC) | ((k & 4) << 1) | ((k & 8) >> 1); return ((kk >> 3) * 4 + (c >> 5)) * 512 + ((kk & 7) * 32 + (c & 31)) * 2; }
__device__ __forceinline__ int v_rd_base(int lane) { return ((lane & 3) << 3) | (((lane >> 2) & 3) << 6) | (((lane >> 4) & 1) << 5) | (((lane >> 5) & 1) << 8); }
constexpr int v_rd_off(int d0, int ks, int half) { return d0 * 512 + ks * 4096 + half * 2048; }
__device__ __forceinline__ int crow(int r, int hi) { return (r & 3) + 8 * (r >> 2) + 4 * hi; }
__device__ __forceinline__ unsigned cvtpk(float lo, float hi) { unsigned r; asm volatile("v_cvt_pk_bf16_f32 %0, %1, %2" : "=v"(r) : "v"(lo), "v"(hi)); return r; }
__device__ __forceinline__ bf16x8 load8(const bf16* p) { return *reinterpret_cast<const bf16x8*>(p); }
__device__ __forceinline__ float bflo(unsigned w) { return __builtin_bit_cast(float, w << 16); }
__device__ __forceinline__ float bfhi(unsigned w) { return __builtin_bit_cast(float, w & 0xffff0000u); }
__device__ __forceinline__ float silu_(float v) { return v * __builtin_amdgcn_rcpf(1.f + __expf(-v)); }
__device__ __forceinline__ float slc_cv(int j, unsigned w0, unsigned w1, unsigned w2, unsigned w3, float c31) {
    const unsigned wj = j < 32 ? w0 : (j < 64 ? w1 : (j < 96 ? w2 : w3)); return ((wj >> (j & 31)) & 1u) ? c31 : -__builtin_inff(); }
__device__ __forceinline__ void mask_tile(f32x16& p0, f32x16& p1, int dq, unsigned W) {
    const float NEG = -__builtin_inff();
#pragma unroll
    for (int r = 0; r < 16; ++r) { const int c = (r & 3) + 8 * (r >> 2);
        if ((unsigned)(dq - c) >= W) p0[r] = NEG;
        if ((unsigned)(dq - c - 32) >= W) p1[r] = NEG; }
}
__device__ __forceinline__ void t5_tile(f32x16& p0, f32x16& p1, int dq, const float* Td) {
#pragma unroll
    for (int g4 = 0; g4 < 4; ++g4) {
#pragma unroll
        for (int i = 0; i < 4; ++i) { const int r = 4 * g4 + i, c = (r & 3) + 8 * (r >> 2);
            int d0 = dq - c, d1 = dq - c - 32; d0 = d0 < 0 ? 0 : (d0 > 127 ? 127 : d0); d1 = d1 < 0 ? 0 : (d1 > 127 ? 127 : d1);
            p0[r] += Td[d0]; p1[r] += Td[d1]; }
        asm volatile("" ::: "memory"); }
}
__device__ __forceinline__ void partialSM(f32x16& p0, f32x16& p1, float& m_reg, float& mn, float& alpha) {
    float pmax = p0[0];
#pragma unroll
    for (int r = 1; r < 16; ++r) pmax = fmaxf(pmax, p0[r]);
#pragma unroll
    for (int r = 0; r < 16; ++r) pmax = fmaxf(pmax, p1[r]);
    { auto rr = __builtin_amdgcn_permlane32_swap(__float_as_uint(pmax), __float_as_uint(pmax), false, false);
      pmax = fmaxf(__uint_as_float(rr[0]), __uint_as_float(rr[1])); }
    constexpr float C2 = 1.4426950408889634f * SCALE;
    if (__builtin_expect(__all((pmax - m_reg) * SCALE <= THR), 1)) { mn = m_reg; alpha = 1.f; }
    else { mn = fmaxf(m_reg, pmax); alpha = __builtin_amdgcn_exp2f((m_reg - mn) * C2); m_reg = mn; }
    const float mnL = -mn * C2;
#pragma unroll
    for (int r = 0; r < 16; ++r) p0[r] = fmaf(p0[r], C2, mnL);
#pragma unroll
    for (int r = 0; r < 16; ++r) p1[r] = fmaf(p1[r], C2, mnL);
#pragma unroll
    for (int r = 0; r < 16; ++r) p0[r] = __builtin_amdgcn_exp2f(p0[r]);
}
__device__ __forceinline__ void finishSM(f32x16& p0, f32x16& p1, float alpha, float& l_reg, bf16x8& pa0, bf16x8& pa1, bf16x8& pa2, bf16x8& pa3) {
#pragma unroll
    for (int r = 0; r < 16; ++r) p1[r] = __builtin_amdgcn_exp2f(p1[r]);
    float ps = 0;
#pragma unroll
    for (int r = 0; r < 16; ++r) ps += p0[r];
#pragma unroll
    for (int r = 0; r < 16; ++r) ps += p1[r];
    { auto rr = __builtin_amdgcn_permlane32_swap(__float_as_uint(ps), __float_as_uint(ps), false, false);
      ps = __uint_as_float(rr[0]) + __uint_as_float(rr[1]); }
    l_reg = l_reg * alpha + ps;
#define PK4(P, B_, OUT) do { unsigned a0 = cvtpk(P[B_+0], P[B_+1]), a1 = cvtpk(P[B_+2], P[B_+3]);                          \
        unsigned b0 = cvtpk(P[B_+4], P[B_+5]), b1 = cvtpk(P[B_+6], P[B_+7]);                                             \
        auto r0 = __builtin_amdgcn_permlane32_swap(a0, b0, false, false); auto r1 = __builtin_amdgcn_permlane32_swap(a1, b1, false, false); \
        u32x4 w = {r0[0], r1[0], r0[1], r1[1]}; OUT = *reinterpret_cast<bf16x8*>(&w); } while (0)
    PK4(p0, 0, pa0); PK4(p0, 8, pa1); PK4(p1, 0, pa2); PK4(p1, 8, pa3);
#undef PK4
}
template <int KB, bool SK, int MODE>
__device__ __forceinline__ void qkt(f32x16& p0, f32x16& p1, const char* K_lds, const char* B_lds, float cv, int r32, int hi, const char* Qw, bool act) {
    if (SK && !act) { const float NEG = -__builtin_inff();
#pragma unroll
        for (int r = 0; r < 16; ++r) { p0[r] = NEG; p1[r] = NEG; } return; }
    if (MODE == MODE_FOX) { const float* bb = (const float*)(B_lds + KB * 256) + 4 * hi;
        const f32x4 a0 = *(const f32x4*)(bb), a1 = *(const f32x4*)(bb + 8), a2 = *(const f32x4*)(bb + 16), a3 = *(const f32x4*)(bb + 24);
        const f32x4 b0 = *(const f32x4*)(bb + 32), b1 = *(const f32x4*)(bb + 40), b2 = *(const f32x4*)(bb + 48), b3 = *(const f32x4*)(bb + 56);
        p0 = (f32x16){a0[0], a0[1], a0[2], a0[3], a1[0], a1[1], a1[2], a1[3], a2[0], a2[1], a2[2], a2[3], a3[0], a3[1], a3[2], a3[3]};
        p1 = (f32x16){b0[0], b0[1], b0[2], b0[3], b1[0], b1[1], b1[2], b1[3], b2[0], b2[1], b2[2], b2[3], b3[0], b3[1], b3[2], b3[3]}; }
    else {
#pragma unroll
        for (int r = 0; r < 16; ++r) { p0[r] = cv; p1[r] = cv; } }
    const char* kb[4]; const char* qb[4];
#pragma unroll
    for (int dd = 0; dd < 4; ++dd) { const int off = KSWZ(r32, (dd * 16 + hi * 8) * 2); kb[dd] = K_lds + KB * SHM_K + off; qb[dd] = Qw + off; }
#pragma unroll
    for (int d0 = 0; d0 < 8; ++d0) { const char* a = kb[d0 & 3] + (d0 >> 2) * 128;
        bf16x8 b0 = *reinterpret_cast<const bf16x8*>(a);
        bf16x8 b1 = *reinterpret_cast<const bf16x8*>(a + 32 * 256);
        const bf16x8 qv = *reinterpret_cast<const bf16x8*>(qb[d0 & 3] + (d0 >> 2) * 128);
        p0 = __builtin_amdgcn_mfma_f32_32x32x16_bf16(b0, qv, p0, 0, 0, 0);
        p1 = __builtin_amdgcn_mfma_f32_32x32x16_bf16(b1, qv, p1, 0, 0, 0); }
}
template <int VB, bool SK>
__device__ __forceinline__ void pv_tile(f32x16* o, int vb0, bf16x8 pa0, bf16x8 pa1, bf16x8 pa2, bf16x8 pa3, bool act) {
    if (SK && !act) return;
#define TRRD(dst, off) asm volatile("ds_read_b64_tr_b16 %0, %1 offset:%2" : "=&v"(dst) : "v"(vb0), "i"(off) : "memory")
#define PV_D0(d0) do { s16x4 l0, l1, l2, l3, h0, h1, h2, h3; constexpr int b_ = VB * SHM_V + v_rd_off(d0, 0, 0); \
        TRRD(l0, b_); TRRD(h0, b_ + 2048); TRRD(l1, b_ + 4096); TRRD(h1, b_ + 6144); TRRD(l2, b_ + 8192); TRRD(h2, b_ + 10240); TRRD(l3, b_ + 12288); TRRD(h3, b_ + 14336); \
        asm volatile("s_waitcnt lgkmcnt(0)" ::: "memory"); SBAR();   \
        o[d0] = __builtin_amdgcn_mfma_f32_32x32x16_bf16(pa0, (bf16x8){l0[0], l0[1], l0[2], l0[3], h0[0], h0[1], h0[2], h0[3]}, o[d0], 0, 0, 0);   \
        o[d0] = __builtin_amdgcn_mfma_f32_32x32x16_bf16(pa1, (bf16x8){l1[0], l1[1], l1[2], l1[3], h1[0], h1[1], h1[2], h1[3]}, o[d0], 0, 0, 0);   \
        o[d0] = __builtin_amdgcn_mfma_f32_32x32x16_bf16(pa2, (bf16x8){l2[0], l2[1], l2[2], l2[3], h2[0], h2[1], h2[2], h2[3]}, o[d0], 0, 0, 0);   \
        o[d0] = __builtin_amdgcn_mfma_f32_32x32x16_bf16(pa3, (bf16x8){l3[0], l3[1], l3[2], l3[3], h3[0], h3[1], h3[2], h3[3]}, o[d0], 0, 0, 0); } while (0)
    PV_D0(0); PV_D0(1); PV_D0(2); PV_D0(3);
#undef PV_D0
#undef TRRD
}
struct BlockRef { const bf16* Q; const bf16* K; const bf16* V; const float* bias; int P0, W, h, mode; };
struct Aux {
    const float* biasF;
    const unsigned* selm;
    const float* small;
    const bf16* zf; const bf16* zn; const bf16* oc; bf16* ow; bf16* y;
};
struct Seam { bf16x8 st_v0, st_v1, st_k0, st_k1; f32x4 st_b; };
__device__ __forceinline__ int swa_jlo(int P0, int W) { const int lowk = P0 - W + 1; return lowk > 0 ? lowk / KVBLK : 0; }
#define ROW(p, k0, rr) ((p) + (size_t)((k0) + (rr)) * D + sc)
#define VMW() asm volatile("s_waitcnt vmcnt(0)" ::: "memory")
#define VMWN(n) asm volatile("s_waitcnt vmcnt(%0)" :: "i"(n) : "memory")
#define SLOAD_H(Kp, Vp, Bp, k0) do { S.st_v0 = load8(ROW(Vp, k0, sr)); S.st_v1 = load8(ROW(Vp, k0, 32 + sr));              \
                         S.st_k0 = load8(ROW(Kp, k0, sr)); S.st_k1 = load8(ROW(Kp, k0, 32 + sr));                        \
                         if ((Bp) != nullptr && tid < 16) S.st_b = *(const f32x4*)((Bp) + (k0) + 4 * tid); } while (0)
#define SWRITE_HK(bf, Bp) do { *(bf16x8*)(K_lds + (bf) * SHM_K + kws) = S.st_k0; *(bf16x8*)(K_lds + (bf) * SHM_K + kws + 32 * 256) = S.st_k1; \
                         if ((Bp) != nullptr && tid < 16) *(f32x4*)(B_lds + (bf) * 256 + tid * 16) = S.st_b; } while (0)
#define SWRITE_HV(bf) do { *(bf16x8*)(V_lds + (bf) * SHM_V + vst0) = S.st_v0; *(bf16x8*)(V_lds + (bf) * SHM_V + vst1) = S.st_v1; } while (0)
#define SWRITE_H(bf, Bp) do { SWRITE_HV(bf); SWRITE_HK(bf, Bp); } while (0)
__device__ __forceinline__ void attn_prime(const BlockRef& cur, char* lds, Seam& S, int tid) {
    const int wid = __builtin_amdgcn_readfirstlane(tid >> 6), lane = tid & 63, r32 = lane & 31, hi = lane >> 5;
    const int sr = tid >> 4, sc = (tid & 15) * 8, kws = KSWZ(sr, sc * 2); char* K_lds = lds + 2 * SHM_V; char* B_lds = lds + LDS_BIAS;
    const int kb0 = swa_jlo(cur.P0, cur.W) * KVBLK;
    bf16x8 qt_[8]; char* Qw = lds + LDS_Q + wid * (QBLK * D * 2);
#pragma unroll
    for (int d0 = 0; d0 < 8; ++d0) qt_[d0] = load8(cur.Q + (size_t)(wid * QBLK + r32) * D + d0 * 16 + hi * 8);
    SLOAD_H(cur.K, cur.V, cur.bias, kb0); VMW(); SWRITE_HK(0, cur.bias);
    { int r32q = r32, hiq = hi; asm volatile("" : "+v"(r32q), "+v"(hiq));
#pragma unroll
      for (int dd = 0; dd < 4; ++dd) { char* qd = Qw + KSWZ(r32q, (dd * 16 + hiq * 8) * 2); *(bf16x8*)qd = qt_[dd]; *(bf16x8*)(qd + 128) = qt_[dd + 4]; } }
    __syncthreads();
}
template <int MODE>
__device__ __forceinline__ void attn_block(const BlockRef& cur, const BlockRef& nxt, const Aux& X, char* lds, Seam& S, int tid_in) {
    constexpr bool SK = (MODE == MODE_WIN);
    int tid = tid_in; asm volatile("" : "+v"(tid));
    const int wid = __builtin_amdgcn_readfirstlane(tid >> 6), lane = tid & 63, r32 = lane & 31, hi = lane >> 5;
    const int W = cur.W, h = cur.h;
    const int j_lo = swa_jlo(cur.P0, W);
    int j_hi = (cur.P0 + QB - 1) / KVBLK + 1; if (j_hi > SEQ / KVBLK) j_hi = SEQ / KVBLK;
    const int NT = j_hi - j_lo;
    const int kbn = swa_jlo(nxt.P0, nxt.W) * KVBLK;
    const int qlo = cur.P0 + wid * QBLK, qm = qlo + r32 - 4 * hi;
    char* V_lds = lds; char* K_lds = lds + 2 * SHM_V; char* B_lds = lds + LDS_BIAS;
    char* Qw = lds + LDS_Q + wid * (QBLK * D * 2);
    float* ws = (float*)(lds + LDS_WSF) + wid * 128; float* li_l = ws, * al_l = ws + 32, * gw_l = ws + 64;
    const float* Td = (const float*)(lds + LDS_T5) + h * 132;
    float m_reg = -1e30f, l_reg = 0; f32x16 o[4] = {};
    const int sr = tid >> 4, sc = (tid & 15) * 8, vst0 = v_st(sr, sc), vst1 = v_st(32 + sr, sc), kws = KSWZ(sr, sc * 2);
    const int vb0 = (int)(uintptr_t)V_lds + v_rd_base(lane);
    const bf16* Kh = cur.K; const bf16* Vh = cur.V;
    float c31 = 0.f; unsigned sw0 = 0, sw1 = 0, sw2 = 0, sw3 = 0;
    if (MODE != MODE_FOX) c31 = Td[128];
    if (MODE == MODE_SLC) { const u32x4 wv = *(const u32x4*)(X.selm + ((size_t)(h / 3) * SEQ + qlo + r32) * 4); sw0 = wv.x; sw1 = wv.y; sw2 = wv.z; sw3 = wv.w; }
    const float* bF = cur.bias;
#define RESC(a) do { if (__any((a) < 1.f)) { if (hi == 0) al_l[r32] = (a); asm volatile("s_waitcnt lgkmcnt(0)" ::: "memory");              \
                     for (int d_ = 0; d_ < 4; ++d_) for (int r = 0; r < 16; ++r) o[d_][r] *= al_l[crow(r, hi)]; } } while (0)
#define KBASE(t) ((j_lo + (t)) * KVBLK)
#define ACT(t) (KBASE(t) <= qlo + QBLK - 1 && KBASE(t) + KVBLK - 1 >= qlo - W + 1)
#define CV(t) ((MODE == MODE_SLC) ? slc_cv(j_lo + (t), sw0, sw1, sw2, sw3, c31) : c31)
#define MASKT(P0_, P1_, t) do { const int kb_ = KBASE(t);                                                                                \
        if (MODE != MODE_FOX && (!SK || ACT(t)) && (kb_ + KVBLK - 1 + 112 >= qlo)) t5_tile(P0_, P1_, qm - kb_, Td);                      \
        if ((!SK || ACT(t)) && (kb_ + KVBLK - 1 > qlo || kb_ <= qlo + QBLK - 1 - W)) mask_tile(P0_, P1_, qm - kb_, (unsigned)W); } while (0)
    f32x16 p0, p1; float mnX, alX; bf16x8 pa0, pa1, pa2, pa3; bf16x8 qn_[8];
    SWRITE_HV(0);
    __syncthreads();
#define STEP(t, PB) do { const bool last_ = ((t) + 1 == NT);                                                                  \
        if (!last_) SLOAD_H(Kh, Vh, bF, KBASE((t) + 1)); else SLOAD_H(nxt.K, nxt.V, nxt.bias, kbn);                           \
        SBAR(); qkt<PB, SK, MODE>(p0, p1, K_lds, B_lds, CV(t), r32, hi, Qw, ACT(t)); SBAR();                                   \
        if (last_) { _Pragma("unroll") for (int d0 = 0; d0 < 8; ++d0) qn_[d0] = load8(nxt.Q + (size_t)(wid * QBLK + r32) * D + d0 * 16 + hi * 8); } \
        MASKT(p0, p1, (t)); partialSM(p0, p1, m_reg, mnX, alX); RESC(alX);                                                    \
        finishSM(p0, p1, alX, l_reg, pa0, pa1, pa2, pa3); SBAR();                                                             \
        pv_tile<PB, SK>(o, vb0, pa0, pa1, pa2, pa3, ACT(t)); SBAR();                                                          \
        if (!last_) { VMW(); SWRITE_H(1 - (PB), bF); }                                                                        \
        __syncthreads(); } while (0)
    for (int t = 0; t < NT; t += 2) { STEP(t, 0); if (t + 1 < NT) STEP(t + 1, 1); }
#undef STEP
    VMW(); SWRITE_HK(0, nxt.bias);
    { int r32q = r32, hiq = hi; asm volatile("" : "+v"(r32q), "+v"(hiq));
#pragma unroll
      for (int dd = 0; dd < 4; ++dd) { char* qd = Qw + KSWZ(r32q, (dd * 16 + hiq * 8) * 2); *(bf16x8*)qd = qn_[dd]; *(bf16x8*)(qd + 128) = qn_[dd + 4]; } }
    SBAR();
    int r32e = r32, hie = hi; asm volatile("" : "+v"(r32e), "+v"(hie));
    { float f = __builtin_amdgcn_rcpf(l_reg), gwv = 0.f;
      if (MODE == MODE_SLC) { const float* sm = X.small + (size_t)(qlo + r32e) * 32 + 6 + 3 * h; f *= 1.f / (1.f + __expf(-sm[1])); gwv = 1.f / (1.f + __expf(-sm[2])); }
      if (hie == 0) { li_l[r32e] = f; if (MODE == MODE_SLC) gw_l[r32e] = gwv; } }
    asm volatile("s_waitcnt lgkmcnt(0)" ::: "memory");
    float rli[16];
#pragma unroll
    for (int r = 0; r < 16; ++r) rli[r] = li_l[crow(r, hie)];
#pragma unroll
    for (int r = 0; r < 16; ++r) { const int q = qlo + crow(r, hie); float gwr = 0.f; if (MODE == MODE_SLC) gwr = gw_l[crow(r, hie)];
#pragma unroll
        for (int d0 = 0; d0 < 4; ++d0) { const int col = d0 * 32 + r32e; const float v = o[d0][r] * rli[r]; const float vn = __builtin_bit_cast(float, __builtin_amdgcn_mov_dpp(__builtin_bit_cast(int, v), 0xB1, 0xF, 0xF, true));
            if ((r32e & 1) == 0) {
                if (MODE == MODE_FOX) { const unsigned z2 = *(const unsigned*)(X.zf + (size_t)q * 768 + h * 128 + col);
                    *(unsigned*)(X.y + (size_t)q * 2048 + 512 + h * 128 + col) = cvtpk(v * silu_(bflo(z2)), vn * silu_(bfhi(z2))); }
                else if (MODE == MODE_WIN) { *(unsigned*)(X.ow + ((size_t)h * SEQ + q) * 128 + col) = cvtpk(v, vn); }
                else { const size_t oo = ((size_t)h * SEQ + q) * 128 + col; const unsigned c2 = *(const unsigned*)(X.oc + oo), w2 = *(const unsigned*)(X.ow + oo), z2 = *(const unsigned*)(X.zn + (size_t)q * 768 + h * 128 + col);
                    *(unsigned*)(X.y + (size_t)q * 2048 + 1280 + h * 128 + col) = cvtpk((v + bflo(c2) + gwr * bflo(w2)) * silu_(bflo(z2)), (vn + bfhi(c2) + gwr * bfhi(w2)) * silu_(bfhi(z2))); } } } }
    __syncthreads();
#undef RESC
#undef KBASE
#undef ACT
#undef CV
#undef MASKT
}
#undef ROW
#undef VMW
#undef VMWN
#undef SLOAD_H
#undef SWRITE_HK
#undef SWRITE_HV
#undef SWRITE_H
#undef KSWZ
#undef SBAR
}
#define GAS __attribute__((address_space(1)))
#define LAS __attribute__((address_space(3)))
typedef unsigned short bf16;
typedef unsigned v4u __attribute__((ext_vector_type(4)));
typedef float f32x4 __attribute__((ext_vector_type(4)));
typedef short bf16x8 __attribute__((ext_vector_type(8)));
typedef GAS unsigned gu32;
typedef GAS unsigned long long gu64;
#define RLX_AGENT __ATOMIC_RELAXED, __HIP_MEMORY_SCOPE_AGENT
#define LDS_WAIT() asm volatile("s_waitcnt lgkmcnt(0)" ::: "memory")
#define VM_WAIT() asm volatile("s_waitcnt vmcnt(0)" ::: "memory")
__device__ __forceinline__ unsigned long long rt() { return __builtin_amdgcn_s_memrealtime(); }
__device__ __forceinline__ unsigned f2bf(float f) { unsigned u = __builtin_bit_cast(unsigned, f); return (u + 0x7fffu + ((u >> 16) & 1u)) >> 16; }
__device__ __forceinline__ unsigned pk2(float lo, float hi) { return f2bf(lo) | (f2bf(hi) << 16); }
#define XB_TMO      128
#define XB_XCNT(j)  (256  + 64 * (j))
#define XB_XSUB(j)  (1280 + 64 * (j))
#define XB_XGEN(j)  (2304 + 64 * (j))
#define XB_TOP      3328
#define XB_TOPGEN   3392
#define XCD_BAR_WORDS 3456
#define XB_SPIN_CAP (1u << 18)

__device__ __forceinline__ unsigned xb_ld(unsigned* p)              { return __hip_atomic_load(p, __ATOMIC_RELAXED, __HIP_MEMORY_SCOPE_AGENT); }
__device__ __forceinline__ unsigned xb_add(unsigned* p, unsigned v) { return __hip_atomic_fetch_add(p, v, __ATOMIC_RELAXED, __HIP_MEMORY_SCOPE_AGENT); }
__device__ __forceinline__ unsigned xb_xcc_id() { return (unsigned)__builtin_amdgcn_s_getreg((3 << 11) | 20) & 0xFu; }
#define XB_SPIN(cond, bar) do { unsigned _sp = 0; while (cond) { __builtin_amdgcn_s_sleep(1); \
    if ((++_sp & 255u) == 0u) { if (xb_ld(&(bar)[XB_TMO])) break; if (_sp > XB_SPIN_CAP) { atomicAdd(&(bar)[XB_TMO], 1u); break; } } } } while (0)

struct XcdBarrier {
    unsigned* bar; unsigned x;
    volatile LAS unsigned* st;
};

__device__ __forceinline__ XcdBarrier xcd_barrier_post(unsigned* bar, volatile LAS unsigned* st) {
    XcdBarrier b; b.bar = bar; b.x = xb_xcc_id(); b.st = st;
    if (threadIdx.x == 0) (void)xb_add(&bar[XB_XCNT(b.x)], 1u);
    return b;
}
__device__ __forceinline__ void xcd_barrier_complete(unsigned* bar, unsigned x, unsigned& nloc, unsigned& nx) {
    const unsigned G = gridDim.x * gridDim.y * gridDim.z;
    unsigned sum, cnt, mine, sp = 0u;
    for (;;) {
        sum = 0u; cnt = 0u; mine = 0u;
#pragma unroll
        for (unsigned j = 0; j < 16; ++j) { const unsigned c = xb_ld(&bar[XB_XCNT(j)]); sum += c; cnt += (c > 0u) ? 1u : 0u; mine = (j == x) ? c : mine; }
        if (sum == G) break;
        __builtin_amdgcn_s_sleep(1);
        if ((++sp & 255u) == 0u) { if (xb_ld(&bar[XB_TMO])) break; if (sp > XB_SPIN_CAP) { atomicAdd(&bar[XB_TMO], 1u); break; } }
    }
    nloc = mine > 0u ? mine : 1u; nx = cnt > 0u ? cnt : 1u;
}

__device__ __forceinline__ void xcd_barrier(const XcdBarrier& b) {
    asm volatile("s_waitcnt vmcnt(0)" ::: "memory");
    __syncthreads();
    if (threadIdx.x == 0) {
        unsigned* bar = b.bar;
        __builtin_amdgcn_s_waitcnt(0);
        unsigned nloc = b.st[0], nx = b.st[1];
        if (nloc == 0u) { xcd_barrier_complete(bar, b.x, nloc, nx); b.st[0] = nloc; b.st[1] = nx; }
        const unsigned old = xb_add(&bar[XB_XSUB(b.x)], 1u);
        const unsigned gen = old / nloc;
        if (old + 1u == (gen + 1u) * nloc) {
            __builtin_amdgcn_fence(__ATOMIC_RELEASE, "agent");
            asm volatile("s_waitcnt vmcnt(0)" ::: "memory");
            const unsigned og = xb_add(&bar[XB_TOP], 1u);
            const unsigned tg = og / nx;
            if (og + 1u == (tg + 1u) * nx) xb_add(&bar[XB_TOPGEN], 1u);
            else XB_SPIN(xb_ld(&bar[XB_TOPGEN]) == tg, bar);
            __builtin_amdgcn_fence(__ATOMIC_ACQUIRE, "agent");
            xb_add(&bar[XB_XGEN(b.x)], 1u);
            asm volatile("s_waitcnt vmcnt(0)" ::: "memory");
        } else {
            XB_SPIN(xb_ld(&bar[XB_XGEN(b.x)]) == gen, bar);
            __builtin_amdgcn_fence(__ATOMIC_ACQUIRE, "agent");
            asm volatile("s_waitcnt vmcnt(0)" ::: "memory");
        }
    }
    __syncthreads();
}
constexpr int NWAVES = 8, NTHR = 512;
constexpr int S = 8192, DM = 2048, DEPTH = 4, NIN = 8216, NBIG = 8192;
constexpr float SM_SCALE = 0.08838834764831845f, NORM_EPS = 1e-6f;
constexpr size_t MiB = 1u << 20, HEADB = (size_t)S * 128 * 2;
constexpr size_t WS_CTL = 0, CTL_ZERO_BYTES = 1 * MiB;
constexpr size_t WS_MOD = 1 * MiB, WS_B1P = 1 * MiB + 128 * 1024, WS_SMALL = 2 * MiB, WS_BIASF = 3 * MiB, WS_SELM = 3 * MiB + 512 * 1024;
constexpr size_t WS_KCMP = 4 * MiB, WS_VCMPT = 4 * MiB + 256 * 1024, WS_WSM = 5 * MiB, WS_W2T = 6 * MiB, WS_W1T = 8 * MiB, WS_WOUT = 24 * MiB, WS_WIN = 56 * MiB;
constexpr size_t WS_H = 184 * MiB, WS_CONV = 216 * MiB, WS_ZF = 248 * MiB, WS_ZN = 260 * MiB, WS_ATT = 272 * MiB, WS_OC = 346 * MiB, WS_OW = 358 * MiB, WS_Y = 370 * MiB, WS_Y2 = 402 * MiB;
constexpr size_t WS_NAIVE = 480 * MiB;
constexpr int HP_QF = 0, HP_KF = 6, HP_VF = 12, HP_QN = 18, HP_KC = 24, HP_VC = 26, HP_KS = 28, HP_VS = 30, HP_KW = 32, HP_VW = 34;
constexpr int CW_BAR = 4096;
constexpr int RING_BYTES = 131072, LDSCTL_OFF = 146432, MISC_OFF = LDSCTL_OFF + 320, LDS_BYTES = 147456;
constexpr int NPH = 6, NSTEPS = 2 + DEPTH * NPH;
constexpr int SCHED_D_LEN = 3;
__device__ const unsigned short SCHED_D[256 * SCHED_D_LEN] = {
  0x02bf, 0xffff, 0xffff,
  0x029f, 0xffff, 0xffff,
  0x027f, 0xffff, 0xffff,
  0x025f, 0xffff, 0xffff,
  0x023f, 0xffff, 0xffff,
  0x021f, 0xffff, 0xffff,
  0x00bf, 0xffff, 0xffff,
  0x009f, 0xffff, 0xffff,
  0x007f, 0xffff, 0xffff,
  0x005f, 0xffff, 0xffff,
  0x003f, 0xffff, 0xffff,
  0x001f, 0xffff, 0xffff,
  0x02be, 0xffff, 0xffff,
  0x029e, 0xffff, 0xffff,
  0x027e, 0xffff, 0xffff,
  0x025e, 0xffff, 0xffff,
  0x023e, 0xffff, 0xffff,
  0x021e, 0xffff, 0xffff,
  0x00be, 0xffff, 0xffff,
  0x009e, 0xffff, 0xffff,
  0x007e, 0xffff, 0xffff,
  0x005e, 0xffff, 0xffff,
  0x003e, 0xffff, 0xffff,
  0x001e, 0xffff, 0xffff,
  0x02bd, 0xffff, 0xffff,
  0x029d, 0xffff, 0xffff,
  0x027d, 0xffff, 0xffff,
  0x025d, 0xffff, 0xffff,
  0x023d, 0xffff, 0xffff,
  0x021d, 0xffff, 0xffff,
  0x00bd, 0xffff, 0xffff,
  0x009d, 0xffff, 0xffff,
  0x007d, 0xffff, 0xffff,
  0x005d, 0xffff, 0xffff,
  0x003d, 0xffff, 0xffff,
  0x001d, 0xffff, 0xffff,
  0x02bc, 0xffff, 0xffff,
  0x029c, 0xffff, 0xffff,
  0x027c, 0xffff, 0xffff,
  0x025c, 0xffff, 0xffff,
  0x023c, 0xffff, 0xffff,
  0x021c, 0xffff, 0xffff,
  0x00bc, 0xffff, 0xffff,
  0x009c, 0xffff, 0xffff,
  0x007c, 0xffff, 0xffff,
  0x005c, 0xffff, 0xffff,
  0x003c, 0xffff, 0xffff,
  0x001c, 0xffff, 0xffff,
  0x02bb, 0xffff, 0xffff,
  0x029b, 0xffff, 0xffff,
  0x027b, 0xffff, 0xffff,
  0x025b, 0xffff, 0xffff,
  0x023b, 0xffff, 0xffff,
  0x021b, 0xffff, 0xffff,
  0x00bb, 0xffff, 0xffff,
  0x009b, 0xffff, 0xffff,
  0x007b, 0xffff, 0xffff,
  0x005b, 0xffff, 0xffff,
  0x003b, 0xffff, 0xffff,
  0x001b, 0xffff, 0xffff,
  0x02ba, 0xffff, 0xffff,
  0x029a, 0xffff, 0xffff,
  0x027a, 0xffff, 0xffff,
  0x025a, 0xffff, 0xffff,
  0x023a, 0xffff, 0xffff,
  0x021a, 0xffff, 0xffff,
  0x00ba, 0xffff, 0xffff,
  0x009a, 0xffff, 0xffff,
  0x007a, 0xffff, 0xffff,
  0x005a, 0xffff, 0xffff,
  0x003a, 0xffff, 0xffff,
  0x001a, 0xffff, 0xffff,
  0x02b9, 0xffff, 0xffff,
  0x0299, 0xffff, 0xffff,
  0x0279, 0xffff, 0xffff,
  0x0259, 0xffff, 0xffff,
  0x0239, 0xffff, 0xffff,
  0x0219, 0xffff, 0xffff,
  0x00b9, 0xffff, 0xffff,
  0x0099, 0xffff, 0xffff,
  0x0079, 0xffff, 0xffff,
  0x0059, 0xffff, 0xffff,
  0x0039, 0xffff, 0xffff,
  0x0019, 0xffff, 0xffff,
  0x02b8, 0xffff, 0xffff,
  0x0298, 0xffff, 0xffff,
  0x0278, 0xffff, 0xffff,
  0x0258, 0xffff, 0xffff,
  0x0238, 0xffff, 0xffff,
  0x0218, 0xffff, 0xffff,
  0x00b8, 0xffff, 0xffff,
  0x0098, 0xffff, 0xffff,
  0x0078, 0xffff, 0xffff,
  0x0058, 0xffff, 0xffff,
  0x0038, 0xffff, 0xffff,
  0x0018, 0xffff, 0xffff,
  0x02b7, 0xffff, 0xffff,
  0x0297, 0xffff, 0xffff,
  0x0277, 0xffff, 0xffff,
  0x0257, 0xffff, 0xffff,
  0x0237, 0xffff, 0xffff,
  0x0217, 0xffff, 0xffff,
  0x00b7, 0xffff, 0xffff,
  0x0097, 0xffff, 0xffff,
  0x0077, 0xffff, 0xffff,
  0x0057, 0xffff, 0xffff,
  0x0037, 0xffff, 0xffff,
  0x0017, 0xffff, 0xffff,
  0x02b6, 0xffff, 0xffff,
  0x0296, 0xffff, 0xffff,
  0x0276, 0xffff, 0xffff,
  0x0256, 0xffff, 0xffff,
  0x0236, 0xffff, 0xffff,
  0x0216, 0xffff, 0xffff,
  0x00b6, 0xffff, 0xffff,
  0x0096, 0xffff, 0xffff,
  0x0076, 0xffff, 0xffff,
  0x0056, 0xffff, 0xffff,
  0x0036, 0xffff, 0xffff,
  0x0016, 0xffff, 0xffff,
  0x02b5, 0x0060, 0xffff,
  0x0295, 0x0040, 0xffff,
  0x0275, 0x0020, 0xffff,
  0x0255, 0x0000, 0xffff,
  0x0235, 0xffff, 0xffff,
  0x0215, 0xffff, 0xffff,
  0x00b5, 0xffff, 0xffff,
  0x0095, 0xffff, 0xffff,
  0x0075, 0xffff, 0xffff,
  0x0055, 0xffff, 0xffff,
  0x0035, 0xffff, 0xffff,
  0x0015, 0xffff, 0xffff,
  0x02b4, 0x0061, 0xffff,
  0x0294, 0x0041, 0xffff,
  0x0274, 0x0021, 0xffff,
  0x0254, 0x0001, 0xffff,
  0x0234, 0x02a0, 0xffff,
  0x0214, 0x0280, 0xffff,
  0x00b4, 0x0260, 0xffff,
  0x0094, 0x0240, 0xffff,
  0x0074, 0x0220, 0xffff,
  0x0054, 0x0200, 0xffff,
  0x0034, 0x00a0, 0xffff,
  0x0014, 0x0080, 0xffff,
  0x02b3, 0x0062, 0xffff,
  0x0293, 0x0042, 0xffff,
  0x0273, 0x0022, 0xffff,
  0x0253, 0x0002, 0xffff,
  0x0233, 0x02a1, 0xffff,
  0x0213, 0x0281, 0xffff,
  0x00b3, 0x0261, 0xffff,
  0x0093, 0x0241, 0xffff,
  0x0073, 0x0221, 0xffff,
  0x0053, 0x0201, 0xffff,
  0x0033, 0x00a1, 0xffff,
  0x0013, 0x0081, 0xffff,
  0x02b2, 0x0063, 0xffff,
  0x0292, 0x0043, 0xffff,
  0x0272, 0x0023, 0xffff,
  0x0252, 0x0003, 0xffff,
  0x0232, 0x02a2, 0xffff,
  0x0212, 0x0282, 0xffff,
  0x00b2, 0x0262, 0xffff,
  0x0092, 0x0242, 0xffff,
  0x0072, 0x0222, 0xffff,
  0x0052, 0x0202, 0xffff,
  0x0032, 0x00a2, 0xffff,
  0x0012, 0x0082, 0xffff,
  0x02b1, 0x0064, 0xffff,
  0x0291, 0x0044, 0xffff,
  0x0271, 0x0024, 0xffff,
  0x0251, 0x0004, 0xffff,
  0x0231, 0x02a3, 0xffff,
  0x0211, 0x0283, 0xffff,
  0x00b1, 0x0263, 0xffff,
  0x0091, 0x0243, 0xffff,
  0x0071, 0x0223, 0xffff,
  0x0051, 0x0203, 0xffff,
  0x0031, 0x00a3, 0xffff,
  0x0011, 0x0083, 0xffff,
  0x02b0, 0x0065, 0xffff,
  0x0290, 0x0045, 0xffff,
  0x0270, 0x0025, 0xffff,
  0x0250, 0x0005, 0xffff,
  0x0230, 0x02a4, 0xffff,
  0x0210, 0x0284, 0xffff,
  0x00b0, 0x0264, 0xffff,
  0x0090, 0x0244, 0xffff,
  0x0070, 0x0224, 0xffff,
  0x0050, 0x0204, 0xffff,
  0x0030, 0x00a4, 0xffff,
  0x0010, 0x0084, 0xffff,
  0x02af, 0x0066, 0xffff,
  0x028f, 0x0046, 0xffff,
  0x026f, 0x0026, 0xffff,
  0x024f, 0x0006, 0xffff,
  0x022f, 0x02a5, 0xffff,
  0x020f, 0x0285, 0xffff,
  0x00af, 0x0265, 0xffff,
  0x008f, 0x0245, 0xffff,
  0x006f, 0x0225, 0xffff,
  0x004f, 0x0205, 0xffff,
  0x002f, 0x00a5, 0xffff,
  0x000f, 0x0085, 0xffff,
  0x02ae, 0x0067, 0xffff,
  0x028e, 0x0047, 0xffff,
  0x026e, 0x0027, 0xffff,
  0x024e, 0x0007, 0xffff,
  0x022e, 0x02a6, 0xffff,
  0x020e, 0x0286, 0xffff,
  0x00ae, 0x0266, 0xffff,
  0x008e, 0x0246, 0xffff,
  0x006e, 0x0226, 0xffff,
  0x004e, 0x0206, 0xffff,
  0x002e, 0x00a6, 0xffff,
  0x000e, 0x0086, 0xffff,
  0x02ad, 0x0068, 0xffff,
  0x028d, 0x0048, 0xffff,
  0x026d, 0x0028, 0xffff,
  0x024d, 0x0008, 0xffff,
  0x022d, 0x02a7, 0xffff,
  0x020d, 0x0287, 0xffff,
  0x00ad, 0x0267, 0xffff,
  0x008d, 0x0247, 0xffff,
  0x006d, 0x0227, 0xffff,
  0x004d, 0x0207, 0xffff,
  0x002d, 0x00a7, 0xffff,
  0x000d, 0x0087, 0xffff,
  0x02ac, 0x0069, 0xffff,
  0x028c, 0x0049, 0xffff,
  0x026c, 0x0029, 0xffff,
  0x024c, 0x0009, 0xffff,
  0x022c, 0x02a8, 0xffff,
  0x020c, 0x0288, 0xffff,
  0x00ac, 0x0268, 0xffff,
  0x008c, 0x0248, 0xffff,
  0x006c, 0x0228, 0xffff,
  0x004c, 0x0208, 0xffff,
  0x002c, 0x00a8, 0xffff,
  0x000c, 0x0088, 0xffff,
  0x02ab, 0x006a, 0xffff,
  0x028b, 0x004a, 0xffff,
  0x026b, 0x002a, 0xffff,
  0x024b, 0x000a, 0xffff,
  0x022b, 0x02a9, 0xffff,
  0x020b, 0x0289, 0xffff,
  0x00ab, 0x0269, 0xffff,
  0x008b, 0x0249, 0xffff,
  0x006b, 0x0229, 0xffff,
  0x004b, 0x0209, 0xffff,
  0x002b, 0x00a9, 0xffff,
  0x000b, 0x0089, 0xffff,
  0x02aa, 0x022a, 0xffff,
  0x028a, 0x020a, 0xffff,
  0x026a, 0x00aa, 0xffff,
  0x024a, 0x008a, 0xffff };
__device__ const unsigned short SCHED_B[256 * 2] = {
  0x0100, 0xffff,
  0x0101, 0xffff,
  0x0102, 0xffff,
  0x0103, 0xffff,
  0x0104, 0xffff,
  0x0105, 0xffff,
  0x0106, 0xffff,
  0x0107, 0xffff,
  0x0108, 0xffff,
  0x0109, 0xffff,
  0x010a, 0xffff,
  0x010b, 0xffff,
  0x010c, 0xffff,
  0x010d, 0xffff,
  0x010e, 0xffff,
  0x010f, 0xffff,
  0x0110, 0xffff,
  0x0111, 0xffff,
  0x0112, 0xffff,
  0x0113, 0xffff,
  0x0114, 0xffff,
  0x0115, 0xffff,
  0x0116, 0xffff,
  0x0117, 0xffff,
  0x0118, 0xffff,
  0x0119, 0xffff,
  0x011a, 0xffff,
  0x011b, 0xffff,
  0x011c, 0xffff,
  0x011d, 0xffff,
  0x011e, 0xffff,
  0x011f, 0xffff,
  0x0120, 0xffff,
  0x0121, 0xffff,
  0x0122, 0xffff,
  0x0123, 0xffff,
  0x0124, 0xffff,
  0x0125, 0xffff,
  0x0126, 0xffff,
  0x0127, 0xffff,
  0x0128, 0xffff,
  0x0129, 0xffff,
  0x012a, 0xffff,
  0x012b, 0xffff,
  0x012c, 0xffff,
  0x012d, 0xffff,
  0x012e, 0xffff,
  0x012f, 0xffff,
  0x0130, 0xffff,
  0x0131, 0xffff,
  0x0132, 0xffff,
  0x0133, 0xffff,
  0x0134, 0xffff,
  0x0135, 0xffff,
  0x0136, 0xffff,
  0x0137, 0xffff,
  0x0138, 0xffff,
  0x0139, 0xffff,
  0x013a, 0xffff,
  0x013b, 0xffff,
  0x013c, 0xffff,
  0x013d, 0xffff,
  0x013e, 0xffff,
  0x013f, 0xffff,
  0x0140, 0xffff,
  0x0141, 0xffff,
  0x0142, 0xffff,
  0x0143, 0xffff,
  0x0144, 0xffff,
  0x0145, 0xffff,
  0x0146, 0xffff,
  0x0147, 0xffff,
  0x0148, 0xffff,
  0x0149, 0xffff,
  0x014a, 0xffff,
  0x014b, 0xffff,
  0x014c, 0xffff,
  0x014d, 0xffff,
  0x014e, 0xffff,
  0x014f, 0xffff,
  0x0150, 0xffff,
  0x0151, 0xffff,
  0x0152, 0xffff,
  0x0153, 0xffff,
  0x0154, 0xffff,
  0x0155, 0xffff,
  0x0156, 0xffff,
  0x0157, 0xffff,
  0x0158, 0xffff,
  0x0159, 0xffff,
  0x015a, 0xffff,
  0x015b, 0xffff,
  0x015c, 0xffff,
  0x015d, 0xffff,
  0x015e, 0xffff,
  0x015f, 0xffff,
  0x0160, 0xffff,
  0x0161, 0xffff,
  0x0162, 0xffff,
  0x0163, 0xffff,
  0x0164, 0xffff,
  0x0165, 0xffff,
  0x0166, 0xffff,
  0x0167, 0xffff,
  0x0168, 0xffff,
  0x0169, 0xffff,
  0x016a, 0xffff,
  0x016b, 0xffff,
  0x016c, 0xffff,
  0x016d, 0xffff,
  0x016e, 0xffff,
  0x016f, 0xffff,
  0x0170, 0xffff,
  0x0171, 0xffff,
  0x0172, 0xffff,
  0x0173, 0xffff,
  0x0174, 0xffff,
  0x0175, 0xffff,
  0x0176, 0xffff,
  0x0177, 0xffff,
  0x0178, 0xffff,
  0x0179, 0xffff,
  0x017a, 0xffff,
  0x017b, 0xffff,
  0x017c, 0xffff,
  0x017d, 0xffff,
  0x017e, 0xffff,
  0x017f, 0xffff,
  0x0180, 0xffff,
  0x0181, 0xffff,
  0x0182, 0xffff,
  0x0183, 0xffff,
  0x0184, 0xffff,
  0x0185, 0xffff,
  0x0186, 0xffff,
  0x0187, 0xffff,
  0x0188, 0xffff,
  0x0189, 0xffff,
  0x018a, 0xffff,
  0x018b, 0xffff,
  0x018c, 0xffff,
  0x018d, 0xffff,
  0x018e, 0xffff,
  0x018f, 0xffff,
  0x0190, 0xffff,
  0x0191, 0xffff,
  0x0192, 0xffff,
  0x0193, 0xffff,
  0x0194, 0xffff,
  0x0195, 0xffff,
  0x0196, 0xffff,
  0x0197, 0xffff,
  0x0198, 0xffff,
  0x0199, 0xffff,
  0x019a, 0xffff,
  0x019b, 0xffff,
  0x019c, 0xffff,
  0x019d, 0xffff,
  0x019e, 0xffff,
  0x019f, 0xffff,
  0x01a0, 0xffff,
  0x01a1, 0xffff,
  0x01a2, 0xffff,
  0x01a3, 0xffff,
  0x01a4, 0xffff,
  0x01a5, 0xffff,
  0x01a6, 0xffff,
  0x01a7, 0xffff,
  0x01a8, 0xffff,
  0x01a9, 0xffff,
  0x01aa, 0xffff,
  0x01ab, 0xffff,
  0x01ac, 0xffff,
  0x01ad, 0xffff,
  0x01ae, 0xffff,
  0x01af, 0xffff,
  0x01b0, 0xffff,
  0x01b1, 0xffff,
  0x01b2, 0xffff,
  0x01b3, 0xffff,
  0x01b4, 0xffff,
  0x01b5, 0xffff,
  0x01b6, 0xffff,
  0x01b7, 0xffff,
  0x01b8, 0xffff,
  0x01b9, 0xffff,
  0x01ba, 0xffff,
  0x01bb, 0xffff,
  0x01bc, 0xffff,
  0x01bd, 0xffff,
  0x01be, 0xffff,
  0x01bf, 0xffff,
  0xffff, 0xffff,
  0xffff, 0xffff,
  0xffff, 0xffff,
  0xffff, 0xffff,
  0xffff, 0xffff,
  0xffff, 0xffff,
  0xffff, 0xffff,
  0xffff, 0xffff,
  0xffff, 0xffff,
  0xffff, 0xffff,
  0xffff, 0xffff,
  0xffff, 0xffff,
  0xffff, 0xffff,
  0xffff, 0xffff,
  0xffff, 0xffff,
  0xffff, 0xffff,
  0xffff, 0xffff,
  0xffff, 0xffff,
  0xffff, 0xffff,
  0xffff, 0xffff,
  0xffff, 0xffff,
  0xffff, 0xffff,
  0xffff, 0xffff,
  0xffff, 0xffff,
  0xffff, 0xffff,
  0xffff, 0xffff,
  0xffff, 0xffff,
  0xffff, 0xffff,
  0xffff, 0xffff,
  0xffff, 0xffff,
  0xffff, 0xffff,
  0xffff, 0xffff,
  0xffff, 0xffff,
  0xffff, 0xffff,
  0xffff, 0xffff,
  0xffff, 0xffff,
  0xffff, 0xffff,
  0xffff, 0xffff,
  0xffff, 0xffff,
  0xffff, 0xffff,
  0xffff, 0xffff,
  0xffff, 0xffff,
  0xffff, 0xffff,
  0xffff, 0xffff,
  0xffff, 0xffff,
  0xffff, 0xffff,
  0xffff, 0xffff,
  0xffff, 0xffff,
  0xffff, 0xffff,
  0xffff, 0xffff,
  0xffff, 0xffff,
  0xffff, 0xffff,
  0xffff, 0xffff,
  0xffff, 0xffff,
  0xffff, 0xffff,
  0xffff, 0xffff,
  0xffff, 0xffff,
  0xffff, 0xffff,
  0xffff, 0xffff,
  0xffff, 0xffff,
  0xffff, 0xffff,
  0xffff, 0xffff,
  0xffff, 0xffff,
  0xffff, 0xffff };
__device__ const unsigned char T5_BUCKET[128] = { 0, 1, 2, 3, 4, 5, 6, 7, 8, 9, 10, 11, 12, 13, 14, 15, 16, 16, 16, 17, 17, 18, 18, 18, 19, 19, 19, 20, 20, 20, 20, 21, 21, 21, 21, 22, 22, 22, 22, 22, 23, 23, 23, 23, 23, 23, 24, 24, 24, 24, 24, 24, 25, 25, 25, 25, 25, 25, 25, 26, 26, 26, 26, 26, 26, 26, 26, 27, 27, 27, 27, 27, 27, 27, 27, 27, 27, 28, 28, 28, 28, 28, 28, 28, 28, 28, 28, 29, 29, 29, 29, 29, 29, 29, 29, 29, 29, 29, 29, 30, 30, 30, 30, 30, 30, 30, 30, 30, 30, 30, 30, 30, 30, 31, 31, 31, 31, 31, 31, 31, 31, 31, 31, 31, 31, 31, 31, 31 };
struct Args { const float* in[17]; float* out; unsigned char* ws; int step_lo, step_hi, li, pad; };
struct Ctx { LAS unsigned char* lds; int tid, lane, wave, vcu, G; };

#define swz_xor(v, pat) __builtin_bit_cast(float, __builtin_amdgcn_ds_swizzle(__builtin_bit_cast(int, (v)), (pat)))
__device__ __forceinline__ float other_half(float v, int lane) { return __builtin_bit_cast(float, __builtin_amdgcn_ds_bpermute((lane ^ 32) << 2, __builtin_bit_cast(int, v))); }
__device__ __forceinline__ float wave_sum(float v) {
    v += swz_xor(v, 0x041F); v += swz_xor(v, 0x081F); v += swz_xor(v, 0x101F); v += swz_xor(v, 0x201F); v += swz_xor(v, 0x401F);
    return __builtin_bit_cast(float, __builtin_amdgcn_readlane(__builtin_bit_cast(int, v), 0)) + __builtin_bit_cast(float, __builtin_amdgcn_readlane(__builtin_bit_cast(int, v), 32));
}
__device__ __forceinline__ float siluf(float v) { return v / (1.f + __expf(-v)); }
__device__ __forceinline__ float sigmf(float v) { return 1.f / (1.f + __expf(-v)); }

__device__ __forceinline__ void tr_item(const float* W, int ldw, int srccol0, int k0, bf16* WTrow0, int K, LAS float* scr, int lane) {
#pragma unroll 8
    for (int i = 0; i < 32; ++i) { const int kk = 2 * i + (lane >> 5); scr[kk * 33 + (lane & 31)] = W[(size_t)(k0 + kk) * ldw + srccol0 + (lane & 31)]; }
    LDS_WAIT(); asm volatile("" ::: "memory");
    const int c = lane & 7;
#pragma unroll
    for (int j = 0; j < 4; ++j) { const int n = (lane >> 3) + 8 * j; const LAS float* s = scr + (8 * c) * 33 + n;
        v4u o; o.x = pk2(s[0 * 33], s[1 * 33]); o.y = pk2(s[2 * 33], s[3 * 33]); o.z = pk2(s[4 * 33], s[5 * 33]); o.w = pk2(s[6 * 33], s[7 * 33]);
        *(GAS v4u*)(WTrow0 + (size_t)n * K + 8 * c) = o; }
    LDS_WAIT(); asm volatile("" ::: "memory");
}
__device__ __forceinline__ void p0_prologue(const Args& a, const Ctx& C) {
    unsigned char* ws = a.ws;
    LAS float* fl = (LAS float*)C.lds;
    { const float* cvec = a.in[1]; const float* w_ada = a.in[2]; const float* b_ada = a.in[3]; float* mod = (float*)(ws + WS_MOD);
      for (int i = C.tid; i < DM; i += NTHR) fl[i] = siluf(cvec[i]);
      __syncthreads();
      for (int it = C.vcu; it < 384; it += C.G) {
          const int l = it / 96, cb = (it % 96) * 64, col = C.tid & 63, kg = C.tid >> 6;
          const float* w = w_ada + (size_t)l * DM * (3 * DM) + cb + col; float acc = 0.f;
#pragma unroll 8
          for (int k = kg * 256; k < kg * 256 + 256; ++k) acc += fl[k] * w[(size_t)k * (3 * DM)];
          fl[2048 + kg * 64 + col] = acc; __syncthreads();
          if (C.tid < 64) { float s = 0.f;
#pragma unroll
              for (int g = 0; g < 8; ++g) s += fl[2048 + g * 64 + C.tid];
              mod[l * 3 * DM + cb + C.tid] = s + b_ada[l * 3 * DM + cb + C.tid]; }
          __syncthreads(); }
    }
    for (int it = C.vcu; it < 64; it += C.G) {
        const int l = it >> 4, kv = (it >> 3) & 1, kc = it & 7, col = C.tid & 255, kh = C.tid >> 8;
        const float* pe = (kv ? a.in[12] : a.in[9]) + l * 4096; const float* w1 = (kv ? a.in[13] : a.in[10]) + (size_t)l * 4096 * 256 + col; float acc = 0.f;
        const int kb = kc * 512 + kh * 256;
#pragma unroll 8
        for (int k = kb; k < kb + 256; ++k) acc += pe[k] * w1[(size_t)k * 256];
        __syncthreads(); fl[C.tid] = acc; __syncthreads();
        if (C.tid < 256) ((float*)(ws + WS_B1P))[((l * 2 + kv) * 8 + kc) * 256 + C.tid] = fl[C.tid] + fl[C.tid + 256];
    }
    __syncthreads();
    LAS float* scr = (LAS float*)(C.lds + C.wave * 16384);
    const int gw = C.vcu * NWAVES + C.wave, NGW = C.G * NWAVES;
    constexpr int I_WIN = 32 * 256, I_WOUT = 32 * 64, I_W1 = 64 * 8, I_W2 = 4 * 4, I_L = I_WIN + I_WOUT + 2 * I_W1 + 2 * I_W2;
    for (int it = gw; it < DEPTH * I_L; it += NGW) {
        const int l = it / I_L; int r = it % I_L;
        if (r < I_WIN) { const int kb = r >> 8, nb = r & 255, j0 = nb * 32, src = j0 + (j0 < 4352 ? 0 : (j0 < 7424 ? 6 : 24));
            tr_item(a.in[6] + (size_t)l * DM * NIN, NIN, src, kb * 64, (bf16*)(ws + WS_WIN) + ((size_t)l * NBIG + j0) * DM + kb * 64, DM, scr, C.lane); continue; }
        r -= I_WIN;
        if (r < I_WOUT) { const int kb = r >> 6, nb = r & 63;
            tr_item(a.in[15] + (size_t)l * DM * DM, DM, nb * 32, kb * 64, (bf16*)(ws + WS_WOUT) + ((size_t)l * DM + nb * 32) * DM + kb * 64, DM, scr, C.lane); continue; }
        r -= I_WOUT;
        if (r < 2 * I_W1) { const int kv = r / I_W1, q = r % I_W1, kb = q >> 3, nb = q & 7;
            tr_item((kv ? a.in[13] : a.in[10]) + (size_t)l * 4096 * 256, 256, nb * 32, kb * 64, (bf16*)(ws + WS_W1T) + ((size_t)(l * 2 + kv) * 256 + nb * 32) * 4096 + kb * 64, 4096, scr, C.lane); continue; }
        r -= 2 * I_W1;
        { const int kv = r / I_W2, q = r % I_W2, kb = q >> 2, nb = q & 3;
            tr_item((kv ? a.in[14] : a.in[11]) + (size_t)l * 256 * 128, 128, nb * 32, kb * 64, (bf16*)(ws + WS_W2T) + ((size_t)(l * 2 + kv) * 128 + nb * 32) * 256 + kb * 64, 256, scr, C.lane); }
    }
    for (int idx = gw * 64 + C.lane; idx < DEPTH * 32 * DM; idx += NGW * 64) {
        const int l = idx / (32 * DM), n = (idx / DM) & 31, k = idx % DM;
        float v = 0.f; if (n < 24) v = a.in[6][(size_t)l * DM * NIN + (size_t)k * NIN + (n < 6 ? 4352 + n : 7430 + (n - 6))];
        ((bf16*)(ws + WS_WSM))[idx] = (bf16)f2bf(v);
    }
}

__device__ __forceinline__ void rowpass(const Args& a, const Ctx& C, int l) {
    unsigned char* ws = a.ws; const float* mod = (const float*)(ws + WS_MOD);
    const float* xin = (l <= 1) ? a.in[0] : a.out; const float* y2 = (const float*)(ws + WS_Y2);
    const int gw = C.vcu * NWAVES + C.wave, NGW = C.G * NWAVES;
    f32x4 a1[8], a2[8], a3[8];
#pragma unroll
    for (int j = 0; j < 8; ++j) { const int c = 4 * C.lane + 256 * j;
        if (l > 0) { const f32x4 g = *(const f32x4*)(mod + (l - 1) * 3 * DM + 2 * DM + c), p = *(const f32x4*)(a.in[5] + (l - 1) * DM + c); a1[j] = g * p; } else a1[j] = (f32x4){0.f, 0.f, 0.f, 0.f};
        if (l < DEPTH) { const f32x4 p = *(const f32x4*)(a.in[4] + l * DM + c), sc = *(const f32x4*)(mod + l * 3 * DM + DM + c); a2[j] = p * (sc + 1.0f); a3[j] = *(const f32x4*)(mod + l * 3 * DM + c); }
        else { a2[j] = (f32x4){0.f, 0.f, 0.f, 0.f}; a3[j] = a2[j]; } }
    for (int m = gw; m < S; m += NGW) {
        f32x4 x[8];
#pragma unroll
        for (int j = 0; j < 8; ++j) x[j] = *(const f32x4*)(xin + (size_t)m * DM + 4 * C.lane + 256 * j);
        if (l > 0) {
            f32x4 y[8]; float ss = 0.f;
#pragma unroll
            for (int j = 0; j < 8; ++j) { y[j] = *(const f32x4*)(y2 + (size_t)m * DM + 4 * C.lane + 256 * j); ss += (y[j].x * y[j].x + y[j].y * y[j].y) + (y[j].z * y[j].z + y[j].w * y[j].w); }
            const float rs = __builtin_amdgcn_rsqf(wave_sum(ss) * (1.f / DM) + NORM_EPS);
#pragma unroll
            for (int j = 0; j < 8; ++j) { x[j] = x[j] + a1[j] * (y[j] * rs); *(f32x4*)(a.out + (size_t)m * DM + 4 * C.lane + 256 * j) = x[j]; }
        }
        if (l < DEPTH) {
            float ss = 0.f;
#pragma unroll
            for (int j = 0; j < 8; ++j) ss += (x[j].x * x[j].x + x[j].y * x[j].y) + (x[j].z * x[j].z + x[j].w * x[j].w);
            const float rs = __builtin_amdgcn_rsqf(wave_sum(ss) * (1.f / DM) + NORM_EPS);
            bf16* hrow = (bf16*)(ws + WS_H) + (size_t)m * DM;
#pragma unroll
            for (int j = 0; j < 8; ++j) { const f32x4 hv = (x[j] * rs) * a2[j] + a3[j];
                *(unsigned long long*)(hrow + 4 * C.lane + 256 * j) = (unsigned long long)pk2(hv.x, hv.y) | ((unsigned long long)pk2(hv.z, hv.w) << 32); }
        }
    }
}

typedef float f32x4m __attribute__((ext_vector_type(4)));
__device__ __forceinline__ void small_unit(const Args& a, const Ctx& C, int l, int u) {
    const bf16* H = (const bf16*)(a.ws + WS_H); const bf16* W = (const bf16*)(a.ws + WS_WSM) + (size_t)l * 32 * DM; float* out = (float*)(a.ws + WS_SMALL);
    const int mt = C.wave & 3, nt = C.wave >> 2, fr = C.lane & 15, fq = C.lane >> 4, r0 = u * 64 + mt * 16;
    const bf16* ap = H + (size_t)(r0 + fr) * DM + 8 * fq; const bf16* bp = W + (size_t)(nt * 16 + fr) * DM + 8 * fq;
    f32x4 acc = {0.f, 0.f, 0.f, 0.f};
#pragma unroll 8
    for (int k0 = 0; k0 < DM; k0 += 32) { const bf16x8 av = *(const bf16x8*)(ap + k0), bv = *(const bf16x8*)(bp + k0); acc = __builtin_amdgcn_mfma_f32_16x16x32_bf16(av, bv, acc, 0, 0, 0); }
#pragma unroll
    for (int i = 0; i < 4; ++i) out[(size_t)(r0 + 4 * fq + i) * 32 + nt * 16 + fr] = acc[i];
}
__device__ __forceinline__ void build_t5(char* ldsg, const float* relb, int tid) {
    float* T = (float*)(ldsg + att::LDS_T5);
    for (int i = tid; i < 6 * 129; i += NTHR) { const int h = i / 129, d = i % 129; const float c31 = relb[31 * 6 + h];
        T[h * 132 + d] = (d < 128 ? (relb[(int)T5_BUCKET[d < 128 ? d : 127] * 6 + h] - c31) : c31) * (1.0f / SM_SCALE); }
    __syncthreads();
}
__device__ __forceinline__ att::BlockRef make_ref(unsigned char* ws, int mode, int h, int qb) {
    att::BlockRef r; const att::bf16* P = (const att::bf16*)(ws + WS_ATT); constexpr size_t PL = (size_t)S * 128;
    const int qp = (mode == att::MODE_FOX) ? HP_QF + h : HP_QN + h;
    const int kp = (mode == att::MODE_FOX) ? HP_KF + h : ((mode == att::MODE_WIN) ? HP_KW + h / 3 : HP_KS + h / 3);
    const int vp = (mode == att::MODE_FOX) ? HP_VF + h : ((mode == att::MODE_WIN) ? HP_VW + h / 3 : HP_VS + h / 3);
    r.Q = P + qp * PL + (size_t)qb * 256 * 128; r.K = P + kp * PL; r.V = P + vp * PL;
    r.bias = (mode == att::MODE_FOX) ? (const float*)(ws + WS_BIASF) + (size_t)h * S : nullptr;
    r.P0 = qb * 256; r.W = (mode == att::MODE_WIN) ? 512 : att::WBIG; r.h = h; r.mode = mode; return r;
}
__device__ __forceinline__ att::Aux make_aux(unsigned char* ws) {
    att::Aux X; X.biasF = (const float*)(ws + WS_BIASF); X.selm = (const unsigned*)(ws + WS_SELM); X.small = (const float*)(ws + WS_SMALL);
    X.zf = (const att::bf16*)(ws + WS_ZF); X.zn = (const att::bf16*)(ws + WS_ZN); X.oc = (const att::bf16*)(ws + WS_OC); X.ow = (att::bf16*)(ws + WS_OW); X.y = (att::bf16*)(ws + WS_Y); return X;
}
template <int MODE>
__device__ __forceinline__ void attn_stream(unsigned char* ws, char* ldsg, const unsigned short* list, int tid) {
    int i = 0; unsigned code;
    for (;; ++i) { code = list[i]; if (code == 0xFFFFu) return; if ((int)(code >> 8) == MODE) break; }
    const att::Aux X = make_aux(ws);
    att::BlockRef cur = make_ref(ws, MODE, (code >> 5) & 7, code & 31); att::Seam Sm;
    att::attn_prime(cur, ldsg, Sm, tid);
    for (;;) {
        unsigned nc; for (++i;; ++i) { nc = list[i]; if (nc == 0xFFFFu || (int)(nc >> 8) == MODE) break; }
        const bool last = (nc == 0xFFFFu);
        const att::BlockRef nxt = last ? cur : make_ref(ws, MODE, (nc >> 5) & 7, nc & 31);
        att::attn_block<MODE>(cur, nxt, X, ldsg, Sm, tid);
        if (last) break;
        cur = nxt;
    }
}
__device__ __forceinline__ void conv_phase(const Args& a, const Ctx& C, int l) {
    const bf16* cv = (const bf16*)(a.ws + WS_CONV); bf16* Y = (bf16*)(a.ws + WS_Y); const float* cw = a.in[8] + l * 3 * 512;
    for (int idx = C.vcu * NTHR + C.tid; idx < S * 64; idx += C.G * NTHR) {
        const int s = idx >> 6, c = (idx & 63) * 8; float z[8];
#pragma unroll
        for (int e = 0; e < 8; ++e) z[e] = 0.f;
#pragma unroll
        for (int j = 0; j < 3; ++j) { const int t = s + j - 2; if (t >= 0) { const v4u uu = *(const v4u*)(cv + (size_t)t * 2048 + c), gg = *(const v4u*)(cv + (size_t)t * 2048 + 1024 + c);
#pragma unroll
            for (int e = 0; e < 4; ++e) { const unsigned uw = uu[e], gw = gg[e];
                z[2 * e] += cw[j * 512 + c + 2 * e] * (att::bflo(gw) * att::bflo(uw)); z[2 * e + 1] += cw[j * 512 + c + 2 * e + 1] * (att::bfhi(gw) * att::bfhi(uw)); } } }
        const v4u bb = *(const v4u*)(cv + (size_t)s * 2048 + 512 + c), zz = *(const v4u*)(cv + (size_t)s * 2048 + 1536 + c); v4u o;
#pragma unroll
        for (int e = 0; e < 4; ++e) o[e] = pk2(att::bflo(bb[e]) * z[2 * e] * siluf(att::bflo(zz[e])), att::bfhi(bb[e]) * z[2 * e + 1] * siluf(att::bfhi(zz[e])));
        *(v4u*)(Y + (size_t)s * 2048 + c) = o;
    }
}
__device__ __forceinline__ void mlp_unit(const Args& a, const Ctx& C, int l, int u) {
    unsigned char* ws = a.ws; const int kv = u >> 6, g = (u >> 5) & 1, nb = u & 31, fr = C.lane & 15, fq = C.lane >> 4, w = C.wave;
    const bf16* src = (const bf16*)(ws + WS_ATT) + (size_t)((kv ? HP_VC : HP_KC) + g) * S * 128;
    const bf16* ap = src + (size_t)(16 * (16 * nb + fr)) * 128 + 8 * fq;
    const bf16* w1t = (const bf16*)(ws + WS_W1T) + (size_t)(l * 2 + kv) * 256 * 4096; const bf16* bp = w1t + (size_t)(32 * w + fr) * 4096 + 8 * fq;
    f32x4 acc0 = {0.f, 0.f, 0.f, 0.f}, acc1 = acc0;
#pragma unroll 4
    for (int k0 = 0; k0 < 4096; k0 += 32) { const bf16x8 av = *(const bf16x8*)(ap + k0), b0 = *(const bf16x8*)(bp + k0), b1 = *(const bf16x8*)(bp + (size_t)16 * 4096 + k0);
        acc0 = __builtin_amdgcn_mfma_f32_16x16x32_bf16(av, b0, acc0, 0, 0, 0); acc1 = __builtin_amdgcn_mfma_f32_16x16x32_bf16(av, b1, acc1, 0, 0, 0); }
    const float* b1p = (const float*)(ws + WS_B1P) + (size_t)(l * 2 + kv) * 8 * 256; float bs0 = 0.f, bs1 = 0.f;
#pragma unroll
    for (int cchunk = 0; cchunk < 8; ++cchunk) { bs0 += b1p[cchunk * 256 + 32 * w + fr]; bs1 += b1p[cchunk * 256 + 32 * w + 16 + fr]; }
    LAS bf16* hid = (LAS bf16*)(C.lds);
    __syncthreads();
#pragma unroll
    for (int i = 0; i < 4; ++i) { hid[(4 * fq + i) * 264 + 32 * w + fr] = (bf16)f2bf(siluf(acc0[i] + bs0)); hid[(4 * fq + i) * 264 + 32 * w + 16 + fr] = (bf16)f2bf(siluf(acc1[i] + bs1)); }
    __syncthreads();
    const bf16* w2t = (const bf16*)(ws + WS_W2T) + (size_t)(l * 2 + kv) * 128 * 256 + (size_t)(16 * w + fr) * 256 + 8 * fq;
    f32x4 acc = {0.f, 0.f, 0.f, 0.f};
#pragma unroll
    for (int k0 = 0; k0 < 256; k0 += 32) { const bf16x8 av = *(const LAS bf16x8*)(hid + fr * 264 + k0 + 8 * fq), bv = *(const bf16x8*)(w2t + k0); acc = __builtin_amdgcn_mfma_f32_16x16x32_bf16(av, bv, acc, 0, 0, 0); }
    if (kv == 0) { bf16* kc = (bf16*)(ws + WS_KCMP) + (size_t)g * 512 * 128;
#pragma unroll
        for (int i = 0; i < 4; ++i) kc[(size_t)(16 * nb + 4 * fq + i) * 128 + 16 * w + fr] = (bf16)f2bf(acc[i]); }
    else { bf16* vt = (bf16*)(ws + WS_VCMPT) + (size_t)g * 128 * 512 + (size_t)(16 * w + fr) * 512 + 16 * nb + 4 * fq;
        *(unsigned long long*)vt = (unsigned long long)pk2(acc[0], acc[1]) | ((unsigned long long)pk2(acc[2], acc[3]) << 32); }
    __syncthreads();
}
__device__ __forceinline__ float logsig(float v) { const float e = __builtin_amdgcn_exp2f(-fabsf(v) * 1.4426950408889634f); return fminf(v, 0.f) - __builtin_amdgcn_logf(1.f + e) * 0.6931471805599453f; }
__device__ __forceinline__ void scan_head(const Args& a, int l, int h, int lane) {
    const float* sm = (const float*)(a.ws + WS_SMALL); float* out = (float*)(a.ws + WS_BIASF) + (size_t)h * S; const float b = a.in[7][l * 6 + h];
    float loc = 0.f;
    for (int i = 0; i < 128; ++i) { const float v = sm[(size_t)(lane * 128 + i) * 32 + h] + b; loc += logsig(v); }
    float inc = loc;
#pragma unroll
    for (int o = 1; o < 64; o <<= 1) { const int src = lane >= o ? lane - o : lane; const float t = __builtin_bit_cast(float, __builtin_amdgcn_ds_bpermute(src << 2, __builtin_bit_cast(int, inc))); if (lane >= o) inc += t; }
    float run = inc - loc;
    for (int i = 0; i < 128; ++i) { const float v = sm[(size_t)(lane * 128 + i) * 32 + h] + b; run += logsig(v); out[lane * 128 + i] = -run * (1.0f / SM_SCALE); }
}
typedef float f32x16 __attribute__((ext_vector_type(16)));
__device__ __forceinline__ void cmp_unit(const Args& a, int g, int qt, LAS float* impw, const float* T5, int lane) {
    unsigned char* ws = a.ws; const int r32 = lane & 31, hi = lane >> 5, q = 32 * qt + r32, ntile = qt / 16 + 1;
    constexpr float C2 = 1.4426950408889634f * SM_SCALE; const float NEG = -__builtin_inff();
    for (int i = lane; i < 32 * 130; i += 64) impw[i] = 0.f;
    asm volatile("s_waitcnt lgkmcnt(0)" ::: "memory");
    const bf16* kc = (const bf16*)(ws + WS_KCMP) + (size_t)g * 512 * 128; const bf16* vt = (const bf16*)(ws + WS_VCMPT) + (size_t)g * 128 * 512;
    const float* small = (const float*)(ws + WS_SMALL);
    for (int r = 0; r < 3; ++r) {
        const int h = 3 * g + r; const float* Td = T5 + h * 132; const float c31 = Td[128];
        const bf16* qp = (const bf16*)(ws + WS_ATT) + (size_t)(HP_QN + h) * S * 128 + (size_t)q * 128 + 8 * hi;
        bf16x8 qr[8];
#pragma unroll
        for (int d0 = 0; d0 < 8; ++d0) qr[d0] = *(const bf16x8*)(qp + d0 * 16);
#define CMP_SCORES(sc, jt) do { _Pragma("unroll") for (int e = 0; e < 16; ++e) sc[e] = c31;                                          \
            const bf16* kp_ = kc + (size_t)(32 * (jt) + r32) * 128 + 8 * hi;                                                        \
            _Pragma("unroll") for (int d0 = 0; d0 < 8; ++d0) sc = __builtin_amdgcn_mfma_f32_32x32x16_bf16(*(const bf16x8*)(kp_ + d0 * 16), qr[d0], sc, 0, 0, 0); \
            _Pragma("unroll") for (int e = 0; e < 16; ++e) { const int n_ = 32 * (jt) + att::crow(e, hi), dist_ = q - 16 * n_ - 31;     \
                if (dist_ < 0) sc[e] = NEG; else if (dist_ < 113) sc[e] += Td[dist_]; } } while (0)
        float m = -1e30f, lsum = 0.f;
        for (int jt = 0; jt < ntile; ++jt) { f32x16 sc; CMP_SCORES(sc, jt);
            float mx = sc[0];
#pragma unroll
            for (int e = 1; e < 16; ++e) mx = fmaxf(mx, sc[e]);
            const float mn = fmaxf(m, mx); float ps = 0.f;
#pragma unroll
            for (int e = 0; e < 16; ++e) ps += __builtin_amdgcn_exp2f((sc[e] - mn) * C2);
            lsum = lsum * __builtin_amdgcn_exp2f((m - mn) * C2) + ps; m = mn; }
        { const float mo = other_half(m, lane), lo = other_half(lsum, lane); const float M = fmaxf(m, mo);
          lsum = lsum * __builtin_amdgcn_exp2f((m - M) * C2) + lo * __builtin_amdgcn_exp2f((mo - M) * C2); m = M; }
        const float inv = lsum > 0.f ? 1.f / lsum : 0.f;
        f32x16 oT[4];
#pragma unroll
        for (int d = 0; d < 4; ++d)
#pragma unroll
            for (int e = 0; e < 16; ++e) oT[d][e] = 0.f;
        for (int jt = 0; jt < ntile; ++jt) { f32x16 sc; CMP_SCORES(sc, jt);
#pragma unroll
            for (int e = 0; e < 16; ++e) sc[e] = __builtin_amdgcn_exp2f((sc[e] - m) * C2) * inv;
            asm volatile("" ::: "memory");
#pragma unroll
            for (int c = 0; c < 4; ++c) { const int Mi = 8 * jt + 2 * c + hi; LAS float* ip = impw + r32 * 130 + Mi;
                ip[0] += (sc[4 * c] + sc[4 * c + 1]) + (sc[4 * c + 2] + sc[4 * c + 3]); }
            asm volatile("s_waitcnt lgkmcnt(0)" ::: "memory");
#pragma unroll
            for (int c = 0; c < 4; ++c) { const int Mi = 8 * jt + 2 * c + hi; LAS float* ip = impw + r32 * 130 + Mi + 1; ip[0] += sc[4 * c + 3]; }
            asm volatile("s_waitcnt lgkmcnt(0)" ::: "memory");
            bf16x8 pb[2];
#pragma unroll
            for (int s2 = 0; s2 < 2; ++s2) { att::u32x4 wv = {att::cvtpk(sc[8 * s2], sc[8 * s2 + 1]), att::cvtpk(sc[8 * s2 + 2], sc[8 * s2 + 3]), att::cvtpk(sc[8 * s2 + 4], sc[8 * s2 + 5]), att::cvtpk(sc[8 * s2 + 6], sc[8 * s2 + 7])}; pb[s2] = *reinterpret_cast<bf16x8*>(&wv); }
#pragma unroll
            for (int d = 0; d < 4; ++d)
#pragma unroll
                for (int s2 = 0; s2 < 2; ++s2) { const bf16* vp = vt + (size_t)(32 * d + r32) * 512 + 32 * jt + 16 * s2 + 4 * hi;
                    const unsigned long long lo = *(const unsigned long long*)vp, hh = *(const unsigned long long*)(vp + 8);
                    att::u32x4 av = {(unsigned)lo, (unsigned)(lo >> 32), (unsigned)hh, (unsigned)(hh >> 32)};
                    oT[d] = __builtin_amdgcn_mfma_f32_32x32x16_bf16(*reinterpret_cast<bf16x8*>(&av), pb[s2], oT[d], 0, 0, 0); }
        }
#undef CMP_SCORES
        const float gc = sigmf(small[(size_t)q * 32 + 6 + 3 * h]);
        bf16* op = (bf16*)(ws + WS_OC) + ((size_t)h * S + q) * 128;
#pragma unroll
        for (int d = 0; d < 4; ++d)
#pragma unroll
            for (int c = 0; c < 4; ++c) *(unsigned long long*)(op + 32 * d + 8 * c + 4 * hi) =
                (unsigned long long)pk2(oT[d][4 * c] * gc, oT[d][4 * c + 1] * gc) | ((unsigned long long)pk2(oT[d][4 * c + 2] * gc, oT[d][4 * c + 3] * gc) << 32);
    }
    asm volatile("s_waitcnt lgkmcnt(0)" ::: "memory");
    const int own = q >> 6; float t[13];
#pragma unroll
    for (int i = 0; i < 13; ++i) t[i] = -1.f;
    for (int j = 0; j < 64; ++j) { const int Mi = 64 * hi + j; float x = impw[r32 * 130 + Mi];
        if (Mi > own || Mi == 0 || Mi == own || Mi == own - 1) x = -1.f;
#pragma unroll
        for (int i = 0; i < 13; ++i) { const float hv = fmaxf(t[i], x); x = fminf(t[i], x); t[i] = hv; } }
    float thr = fmaxf(other_half(t[12], lane), t[12]);
#pragma unroll
    for (int i = 1; i < 13; ++i) thr = fmaxf(thr, fminf(t[i - 1], other_half(t[12 - i], lane)));
    if (own < 16) thr = -1.f;
    unsigned w0 = 0u, w1 = 0u;
    for (int j = 0; j < 64; ++j) { const int Mi = 64 * hi + j; const float x = impw[r32 * 130 + Mi];
        const bool elig = Mi <= own, forced = (Mi == 0) || (Mi == own) || (Mi == own - 1);
        const unsigned bit = (elig && (forced || x >= thr)) ? 1u : 0u;
        if (j < 32) w0 |= bit << j; else w1 |= bit << (j - 32); }
    unsigned* sm = (unsigned*)(ws + WS_SELM) + ((size_t)g * S + q) * 4 + 2 * hi;
    *(unsigned long long*)sm = (unsigned long long)w0 | ((unsigned long long)w1 << 32);
}
__global__ void __launch_bounds__(NTHR, 2) skel_fwd(Args a_) {
    extern __shared__ __attribute__((aligned(16))) unsigned char lds_[];
    char* ldsg = (char*)lds_;
    Ctx C; C.lds = (LAS unsigned char*)lds_; C.tid = threadIdx.x; C.lane = C.tid & 63; C.wave = __builtin_amdgcn_readfirstlane((int)threadIdx.x >> 6);
    C.G = gridDim.x; { const int bx = blockIdx.x; C.vcu = (C.G % 8 == 0) ? (bx % 8) * (C.G / 8) + bx / 8 : bx; }
    for (int u = threadIdx.x; u < (LDS_BYTES - LDSCTL_OFF) / 4; u += NTHR) ((LAS unsigned*)(C.lds + LDSCTL_OFF))[u] = 0u;
    __syncthreads();
    XcdBarrier bar = xcd_barrier_post((unsigned*)(a_.ws + WS_CTL) + CW_BAR + a_.li * XCD_BAR_WORDS, (volatile LAS unsigned*)(C.lds + MISC_OFF) + 8);
    const int step_hi = a_.step_hi;
    for (int st = a_.step_lo; st < step_hi; ++st) {
        { int l_; asm volatile("v_mbcnt_lo_u32_b32 %0, -1, 0\n\tv_mbcnt_hi_u32_b32 %0, -1, %0" : "=v"(l_)); C.lane = l_; C.tid = C.wave * 64 + l_; }
        const Args& a = a_;
        unsigned char* ws = a.ws;
        if (st == 0) p0_prologue(a, C);
        else if (st == 1) rowpass(a, C, 0);
        else {
            const int l = (st - 2) / NPH, ph = (st - 2) % NPH;
            if (ph == 0) {
                pg8::Gemm g{(const pg8::bf16_t*)(ws + WS_H), (const pg8::bf16_t*)(ws + WS_WIN) + (size_t)l * NBIG * DM, S, NBIG, DM};
                pg8::StaticOrder So; So.init(S, NBIG, C.G, (int)blockIdx.x);
                pg8::EpiProj E{(pg8::bf16_t*)(ws + WS_CONV), (pg8::bf16_t*)(ws + WS_ZF), (pg8::bf16_t*)(ws + WS_ZN), (pg8::bf16_t*)(ws + WS_ATT)};
                pg8::gemm_phase<pg8::EpiProj, pg8::StaticOrder, true, true>(C.lds, g, So, E, C.tid);
                for (int u = C.vcu; u < 128; u += C.G) small_unit(a, C, l, u);
            } else if (ph == 1) {
                build_t5(ldsg, a.in[16], C.tid);
                if (C.vcu < 256) attn_stream<att::MODE_WIN>(ws, ldsg, SCHED_B + C.vcu * 2, C.tid);
                for (int it = (C.vcu + 64) & 255; it < 128; it += C.G) mlp_unit(a, C, l, it);
                conv_phase(a, C, l);
#if STEP_LEVEL >= 3
            } else if (ph == 2) {
                build_t5(ldsg, a.in[16], C.tid);
                if (C.wave < 2) { for (int u = C.vcu + C.G * C.wave; u < 512; u += 2 * C.G) { const int g = u >> 8, qq = u & 255, qt = g ? 255 - qq : qq;
                        cmp_unit(a, g, qt, (LAS float*)(C.lds + C.wave * 16640), (const float*)(ldsg + att::LDS_T5), C.lane); } }
                else if (C.vcu == 0 && C.wave < 8) scan_head(a, l, C.wave - 2, C.lane);
#endif
#if STEP_LEVEL >= 4
            } else if (ph == 3) {
                build_t5(ldsg, a.in[16], C.tid);
                if (C.vcu < 256) { attn_stream<att::MODE_FOX>(ws, ldsg, SCHED_D + C.vcu * SCHED_D_LEN, C.tid); attn_stream<att::MODE_SLC>(ws, ldsg, SCHED_D + C.vcu * SCHED_D_LEN, C.tid); }
#endif
            } else if (ph == 4) {
                pg8::Gemm g{(const pg8::bf16_t*)(ws + WS_Y), (const pg8::bf16_t*)(ws + WS_WOUT) + (size_t)l * DM * DM, S, DM, DM};
                pg8::StaticOrder So; So.init(S, DM, C.G, (int)blockIdx.x);
                pg8::EpiF32 E{(float*)(ws + WS_Y2), DM};
                pg8::gemm_phase<pg8::EpiF32, pg8::StaticOrder, true, true>(C.lds, g, So, E, C.tid);
            } else if (ph == 5) {
                rowpass(a, C, l + 1);
            }
        }
        if (st + 1 < step_hi) xcd_barrier(bar);
    }
}
#ifndef ONE_LAUNCH
#define ONE_LAUNCH 1
#endif
static void launch_steps(const Args& base, int lo, int hi, int li, int grid, hipStream_t stream) {
    Args a = base; a.step_lo = lo; a.step_hi = hi; a.li = li;
    hipLaunchKernelGGL(skel_fwd, dim3(grid), dim3(NTHR), LDS_BYTES, stream, a);
}
extern "C" void kernel_launch(void* const* d_in, const int* in_sizes, int n_in, void* d_out, int out_size, void* d_ws, size_t ws_size, hipStream_t stream) {
    static int grid = 0;
    if (grid == 0) {
        int dev = 0, cus = 0, per_cu = 0;
        hipGetDevice(&dev); hipDeviceGetAttribute(&cus, hipDeviceAttributeMultiprocessorCount, dev);
        hipFuncSetAttribute((const void*)skel_fwd, hipFuncAttributeMaxDynamicSharedMemorySize, LDS_BYTES);
        hipOccupancyMaxActiveBlocksPerMultiprocessor(&per_cu, (const void*)skel_fwd, NTHR, LDS_BYTES);
        (void)hipGetLastError();
        if (per_cu < 1) fprintf(stderr, "kernel_launch: occupancy query says %d blocks/CU\n", per_cu);
        grid = cus;
        if (grid != 256) fprintf(stderr, "kernel_launch: built for 256 CUs, found %d\n", cus);
    }
    hipMemsetAsync((char*)d_ws + WS_CTL, 0, CTL_ZERO_BYTES, stream);
    Args a{}; for (int i = 0; i < 17; ++i) a.in[i] = (const float*)d_in[i];
    a.out = (float*)d_out; a.ws = (unsigned char*)d_ws;
#if ONE_LAUNCH
    launch_steps(a, 0, NSTEPS, 1, grid, stream);
#else
    launch_steps(a, 0, 2, 1, grid, stream);
    for (int st = 2; st < NSTEPS; ++st) launch_steps(a, st, st + 1, 0, grid, stream);
#endif
}
```

```cpp
#include <hip/hip_runtime.h>
#include <hip/hip_bf16.h>
#include <cstdio>
#include <cstdint>
#include <cmath>
#ifndef STEP_LEVEL
#define STEP_LEVEL 4
#endif
#ifndef DBG_NAIVE_SEL
#define DBG_NAIVE_SEL 0
#endif
namespace pg8 {
#define PG8_LAS __attribute__((address_space(3)))
typedef unsigned short bf16_t;
typedef short bf16x8 __attribute__((ext_vector_type(8)));
typedef float f32x4 __attribute__((ext_vector_type(4)));
typedef unsigned u32x4 __attribute__((ext_vector_type(4)));
constexpr int BM = 256, BK = 64, HALF = 128, HTB = HALF * BK * 2  , STAGE_BYTES = 8 * HTB, NXCD = 8, WGM = 8;

__host__ __device__ __forceinline__ int lds_byte(int r, int c) { const int st = (r >> 4) * 2 + (c >> 5), rr = r & 15, cc = c & 31, ob = rr * 64 + cc * 2; return st * 1024 + (ob ^ (((ob >> 9) & 1) << 5)); }
__host__ __device__ __forceinline__ void stage_rc(int b, int& R, int& C) { const int st = b / 1024, sb = b % 1024, swz = sb ^ (((sb >> 9) & 1) << 5); R = (st >> 1) * 16 + swz / 64; C = (st & 1) * 32 + (swz % 64) / 2; }
__host__ __device__ __forceinline__ int perm32(int rho) { const int n = rho >> 4, i = rho & 15; return 8 * (i >> 2) + 4 * n + (i & 3); }

struct Unit { int pm, pn; };
struct Gemm { const bf16_t* A; const bf16_t* Bt; int M, N, K; };

struct StaticOrder {
    int nM, nN, nwg, G, c;
    __host__ __device__ void init(int M, int N, int G_, int c_) { nM = M / BM; nN = N / BM; nwg = nM * nN; G = G_; c = c_; }
    __host__ __device__ bool next(int i, Unit& u) const {
        const long L = (long)i * G + c; if (L >= nwg) return false;
        int wgid = (int)L; { const int q = nwg / NXCD, r = nwg % NXCD, xcd = wgid % NXCD, off = wgid / NXCD; wgid = (xcd < r ? xcd * (q + 1) : r * (q + 1) + (xcd - r) * q) + off; }
        const int nig = WGM * nN, gid = wgid / nig, fm = gid * WGM, gsz = (nM - fm) < WGM ? (nM - fm) : WGM;
        u.pm = fm + ((wgid % nig) % gsz); u.pn = (wgid % nig) / gsz; return true;
    }
    __device__ __forceinline__ void a_ready(const Unit&) const {}
    __device__ __forceinline__ void done(const Unit&) const {}
};

__device__ __forceinline__ unsigned cvt_pk_bf16(float lo, float hi) { unsigned r; asm volatile("v_cvt_pk_bf16_f32 %0, %1, %2" : "=v"(r) : "v"(lo), "v"(hi)); return r; }
typedef float f32x2 __attribute__((ext_vector_type(2)));
__device__ __forceinline__ f32x2 gelu_pk(f32x2 v) {
    const f32x2 av = __builtin_elementwise_abs(v), d = av * 0.2316418882f + 1.0f;
    f32x2 t; t.x = __builtin_amdgcn_rcpf(d.x); t.y = __builtin_amdgcn_rcpf(d.y);
    f32x2 q = t * 0.5307027145f + (-0.7265760135f); q = q * t + 0.7107068705f; q = q * t + (-0.142248368f); q = q * t + 0.127414796f; q = q * t;
    const f32x2 s = (v * v) * (-0.72134752044f);
    f32x2 e; e.x = __builtin_amdgcn_exp2f(s.x); e.y = __builtin_amdgcn_exp2f(s.y);
    const f32x2 m = v * (q * e), r = v - m;
    f32x2 o; o.x = v.x < 0.f ? m.x : r.x; o.y = v.y < 0.f ? m.y : r.y; return o;
}

template <int ACT  > struct EpiBf16 {
    static constexpr bool PERM = true, AFTER_DRAIN = false; static_assert(ACT == 0 || ACT == 1, "EpiBf16: ACT is 0 (none) or 1 (gelu_pk)");
    bf16_t* O; int ldc; const float* bias; int split_cols; size_t split_stride; float scale0;
    __device__ __forceinline__ void operator()(const f32x4 (&acc)[2][2][4][2], const Unit& u, int wr, int wc, int fr, int fq) const {
        const int row0 = u.pm * BM + wr * 64 + fr; int colt = u.pn * BM; bf16_t* base = O;
        float sc = 1.f; if (split_cols) { const int t = colt / split_cols; base += (size_t)t * split_stride; colt -= t * split_cols; if (t == 0) sc = scale0; }
        const int col0 = colt + wc * 32 + 8 * fq, bcol0 = u.pn * BM + wc * 32 + 8 * fq;
        f32x4 bv[2][2];
#pragma unroll
        for (int bj = 0; bj < 2; ++bj)
#pragma unroll
            for (int n = 0; n < 2; ++n) bv[bj][n] = bias ? *(const f32x4*)(bias + bcol0 + bj * HALF + 4 * n) : (f32x4){0.f, 0.f, 0.f, 0.f};
#pragma unroll
        for (int ai = 0; ai < 2; ++ai)
#pragma unroll
            for (int m = 0; m < 4; ++m) { bf16_t* rowp = base + (size_t)(row0 + ai * HALF + m * 16) * ldc + col0;
#pragma unroll
                for (int bj = 0; bj < 2; ++bj) { f32x4 v0 = acc[ai][bj][m][0] + bv[bj][0], v1 = acc[ai][bj][m][1] + bv[bj][1];
                    if (ACT == 1) { f32x2 a = gelu_pk((f32x2){v0[0], v0[1]}), b = gelu_pk((f32x2){v0[2], v0[3]}), c = gelu_pk((f32x2){v1[0], v1[1]}), d = gelu_pk((f32x2){v1[2], v1[3]});
                        v0 = (f32x4){a.x, a.y, b.x, b.y}; v1 = (f32x4){c.x, c.y, d.x, d.y}; }
                    v0 = v0 * sc; v1 = v1 * sc; u32x4 w; w.x = cvt_pk_bf16(v0[0], v0[1]); w.y = cvt_pk_bf16(v0[2], v0[3]); w.z = cvt_pk_bf16(v1[0], v1[1]); w.w = cvt_pk_bf16(v1[2], v1[3]);
                    *(u32x4*)(rowp + bj * HALF) = w; } }
    }
};
struct EpiProj {
    static constexpr bool PERM = true, AFTER_DRAIN = false;
    bf16_t* conv; bf16_t* zf; bf16_t* zn; bf16_t* att;
    __device__ __forceinline__ void operator()(const f32x4 (&acc)[2][2][4][2], const Unit& u, int wr, int wc, int fr, int fq) const {
        const int pn = u.pn; bf16_t* base; int ld; size_t hs; constexpr size_t HS = (size_t)8192 * 128;
        if (pn < 8) { base = conv + pn * 256; ld = 2048; hs = 128; }
        else if (pn < 17) { base = att + (size_t)((pn - 8) * 2) * HS; ld = 128; hs = HS; }
        else if (pn < 20) { base = zf + (pn - 17) * 256; ld = 768; hs = 128; }
        else if (pn < 29) { base = att + (size_t)(18 + (pn - 20) * 2) * HS; ld = 128; hs = HS; }
        else { base = zn + (pn - 29) * 256; ld = 768; hs = 128; }
        const int row0 = u.pm * BM + wr * 64 + fr, col0 = wc * 32 + 8 * fq;
#pragma unroll
        for (int ai = 0; ai < 2; ++ai)
#pragma unroll
            for (int m = 0; m < 4; ++m) { bf16_t* rowp = base + (size_t)(row0 + ai * HALF + m * 16) * ld + col0;
#pragma unroll
                for (int bj = 0; bj < 2; ++bj) { const f32x4 v0 = acc[ai][bj][m][0], v1 = acc[ai][bj][m][1];
                    u32x4 w; w.x = cvt_pk_bf16(v0[0], v0[1]); w.y = cvt_pk_bf16(v0[2], v0[3]); w.z = cvt_pk_bf16(v1[0], v1[1]); w.w = cvt_pk_bf16(v1[2], v1[3]);
                    *(u32x4*)(rowp + (size_t)bj * hs) = w; } }
    }
};
struct EpiF32 {
    static constexpr bool PERM = false, AFTER_DRAIN = false;
    float* O; int ldc;
    __device__ __forceinline__ void operator()(const f32x4 (&acc)[2][2][4][2], const Unit& u, int wr, int wc, int fr, int fq) const {
        const int row0 = u.pm * BM + wr * 64 + fr, col0 = u.pn * BM + wc * 32 + 4 * fq;
#pragma unroll
        for (int ai = 0; ai < 2; ++ai)
#pragma unroll
            for (int m = 0; m < 4; ++m) { float* rowp = O + (size_t)(row0 + ai * HALF + m * 16) * ldc + col0;
#pragma unroll
                for (int bj = 0; bj < 2; ++bj)
#pragma unroll
                    for (int n = 0; n < 2; ++n) *(f32x4*)(rowp + bj * HALF + n * 16) = acc[ai][bj][m][n]; }
    }
};
template <class Epi, class Sched, bool ALIGN_EPI = false, bool SP2 = false>
__device__ __forceinline__ void gemm_phase(PG8_LAS unsigned char* lds, const Gemm g, const Sched& S, const Epi& E, const int tid) {
    const int wid = __builtin_amdgcn_readfirstlane(tid >> 6), lane = tid & 63, wr = wid >> 2, wc = wid & 3, fr = lane & 15, fq = lane >> 4;
    const int K = g.K, nt = K / BK;
    unsigned voffA[2], voffB[2];
#pragma unroll
    for (int i = 0; i < 2; ++i) { int R, C; stage_rc(tid * 16 + i * 8192, R, C); const int Rb = Epi::PERM ? ((R & ~31) + perm32(R & 31)) : R;
        voffA[i] = (unsigned)(R * K + C) * 2u; voffB[i] = (unsigned)(Rb * K + C) * 2u; }
    const size_t kstep = (size_t)(BK * 2);
    const size_t hstep = (size_t)HALF * K * 2;
    const size_t tstep = 2 * hstep;
    const unsigned ldsw = (unsigned)wid * 1024u;
    const int aoff = lds_byte(wr * 64 + fr, fq * 8), boff = lds_byte(wc * 32 + fr, fq * 8);
#define PG8_SA(b, h) (((b) * 2 + (h)) * HTB)
#define PG8_SB(b, h) ((4 + (b) * 2 + (h)) * HTB)
#define PG8_STAGE(bufoff, gbase, voff) do { _Pragma("unroll") for (int _i = 0; _i < 2; ++_i) \
        __builtin_amdgcn_global_load_lds((const unsigned*)((const char*)(gbase) + (voff)[_i]), (PG8_LAS unsigned*)(lds + (bufoff) + ldsw + _i * 8192), 16, 0, 0); } while (0)
#define PG8_LDA(dst, b, h) do { _Pragma("unroll") for (int m = 0; m < 4; ++m) _Pragma("unroll") for (int k = 0; k < 2; ++k) dst[m][k] = *(const PG8_LAS bf16x8*)(lds + PG8_SA(b, h) + aoff + m * 2048 + k * 1024); } while (0)
#define PG8_LDB(dst, b, h) do { _Pragma("unroll") for (int n = 0; n < 2; ++n) _Pragma("unroll") for (int k = 0; k < 2; ++k) dst[n][k] = *(const PG8_LAS bf16x8*)(lds + PG8_SB(b, h) + boff + n * 2048 + k * 1024); } while (0)
#define PG8_MMA(ai, bj, At, Bt) do { __builtin_amdgcn_s_setprio(1); _Pragma("unroll") for (int m = 0; m < 4; ++m) _Pragma("unroll") for (int n = 0; n < 2; ++n) _Pragma("unroll") for (int k = 0; k < 2; ++k) \
        acc[ai][bj][m][n] = __builtin_amdgcn_mfma_f32_16x16x32_bf16(Bt[n][k], At[m][k], acc[ai][bj][m][n], 0, 0, 0); __builtin_amdgcn_s_setprio(0); } while (0)
#define PG8_WAIT_V(n) asm volatile("s_waitcnt vmcnt(" #n ")" ::: "memory")
#define PG8_WAIT_L(n) asm volatile("s_waitcnt lgkmcnt(" #n ")" ::: "memory")
#define PG8_BAR __builtin_amdgcn_s_barrier()
#define PG8_SCHED __builtin_amdgcn_sched_barrier(0)
    Unit cur, nxt; int ui = 0;
    if (!S.next(0, cur)) return;
    f32x4 acc[2][2][4][2];
#pragma unroll
    for (int a = 0; a < 2; ++a)
#pragma unroll
        for (int b = 0; b < 2; ++b)
#pragma unroll
            for (int m = 0; m < 4; ++m)
#pragma unroll
                for (int n = 0; n < 2; ++n) acc[a][b][m][n] = (f32x4){0.f, 0.f, 0.f, 0.f};
    bf16x8 At[4][2], B0[2][2], B1[2][2];
    const char* cA = (const char*)g.A + (size_t)cur.pm * tstep; const char* cB = (const char*)g.Bt + (size_t)cur.pn * tstep;
    S.a_ready(cur);
    if constexpr (SP2) {
        PG8_STAGE(PG8_SB(0, 0), cB, voffB); PG8_STAGE(PG8_SB(0, 1), cB + hstep, voffB); PG8_STAGE(PG8_SA(0, 0), cA, voffA); PG8_STAGE(PG8_SA(0, 1), cA + hstep, voffA);
        if (wr == 1) PG8_BAR;
        PG8_WAIT_V(2); PG8_BAR;
        PG8_STAGE(PG8_SB(1, 0), cB + kstep, voffB); PG8_STAGE(PG8_SA(1, 0), cA + kstep, voffA); PG8_STAGE(PG8_SB(1, 1), cB + hstep + kstep, voffB);
        PG8_WAIT_V(6); PG8_BAR;
    } else {
        PG8_STAGE(PG8_SB(0, 0), cB, voffB); PG8_STAGE(PG8_SA(0, 0), cA, voffA); PG8_STAGE(PG8_SB(0, 1), cB + hstep, voffB); PG8_STAGE(PG8_SA(0, 1), cA + hstep, voffA);
        if (wr == 1) PG8_BAR;
        PG8_WAIT_V(4); PG8_BAR;
        PG8_STAGE(PG8_SB(1, 0), cB + kstep, voffB); PG8_STAGE(PG8_SA(1, 0), cA + kstep, voffA); PG8_STAGE(PG8_SB(1, 1), cB + hstep + kstep, voffB);
        PG8_WAIT_V(6); PG8_BAR;
    }
    for (;;) {
        const bool has_next = S.next(ui + 1, nxt);
        const char* nA = has_next ? (const char*)g.A + (size_t)nxt.pm * tstep : cA; const char* nB = has_next ? (const char*)g.Bt + (size_t)nxt.pn * tstep : cB;
        for (int t = 0; t < nt; t += 2) {
            const bool last = (t == nt - 2);
            const char* a1 = cA + (size_t)(t + 1) * kstep;
            const char* a2 = last ? nA : cA + (size_t)(t + 2) * kstep; const char* b2 = last ? nB : cB + (size_t)(t + 2) * kstep;
            const char* a3 = a2 + kstep; const char* b3 = b2 + kstep;
            if (last && has_next) S.a_ready(nxt);
            if constexpr (SP2) {
            PG8_LDB(B0, 0, 0); PG8_LDB(B1, 0, 1); PG8_SCHED; PG8_LDA(At, 0, 0); PG8_STAGE(PG8_SA(1, 1), a1 + hstep, voffA);
            PG8_WAIT_V(8); PG8_WAIT_L(0); PG8_BAR; PG8_MMA(0, 0, At, B0); PG8_MMA(0, 1, At, B1); PG8_BAR; PG8_SCHED;
            PG8_LDA(At, 0, 1); PG8_STAGE(PG8_SB(0, 0), b2, voffB); PG8_STAGE(PG8_SB(0, 1), b2 + hstep, voffB); PG8_STAGE(PG8_SA(0, 0), a2, voffA);
            PG8_WAIT_V(8); PG8_WAIT_L(0); PG8_BAR; PG8_MMA(1, 0, At, B0); PG8_MMA(1, 1, At, B1); PG8_BAR; PG8_SCHED;
            PG8_LDB(B0, 1, 0); PG8_LDB(B1, 1, 1); PG8_SCHED; PG8_LDA(At, 1, 0); PG8_STAGE(PG8_SA(0, 1), a2 + hstep, voffA);
            PG8_WAIT_V(8); PG8_WAIT_L(0); PG8_BAR; PG8_MMA(0, 0, At, B0); PG8_MMA(0, 1, At, B1); PG8_BAR; PG8_SCHED;
            PG8_LDA(At, 1, 1); PG8_STAGE(PG8_SB(1, 0), b3, voffB); PG8_STAGE(PG8_SB(1, 1), b3 + hstep, voffB); PG8_STAGE(PG8_SA(1, 0), a3, voffA);
            PG8_WAIT_V(8); PG8_WAIT_L(0); PG8_BAR; PG8_MMA(1, 0, At, B0); PG8_MMA(1, 1, At, B1); PG8_BAR; PG8_SCHED;
            } else {
            PG8_LDB(B0, 0, 0); PG8_SCHED; PG8_LDA(At, 0, 0); PG8_STAGE(PG8_SA(1, 1), a1 + hstep, voffA);
            PG8_WAIT_L(8); PG8_BAR; PG8_WAIT_L(0); PG8_MMA(0, 0, At, B0); PG8_BAR; PG8_SCHED;
            PG8_LDB(B1, 0, 1); PG8_STAGE(PG8_SB(0, 0), b2, voffB);
            PG8_BAR; PG8_WAIT_L(0); PG8_MMA(0, 1, At, B1); PG8_BAR;
            PG8_LDA(At, 0, 1); PG8_STAGE(PG8_SA(0, 0), a2, voffA);
            PG8_BAR; PG8_WAIT_L(0); PG8_MMA(1, 0, At, B0); PG8_BAR; PG8_SCHED;
            PG8_STAGE(PG8_SB(0, 1), b2 + hstep, voffB);
            PG8_WAIT_V(6); PG8_BAR; PG8_MMA(1, 1, At, B1); PG8_BAR;
            PG8_LDB(B0, 1, 0); PG8_SCHED; PG8_LDA(At, 1, 0); PG8_STAGE(PG8_SA(0, 1), a2 + hstep, voffA);
            PG8_WAIT_L(8); PG8_BAR; PG8_WAIT_L(0); PG8_MMA(0, 0, At, B0); PG8_BAR; PG8_SCHED;
            PG8_LDB(B1, 1, 1); PG8_STAGE(PG8_SB(1, 0), b3, voffB);
            PG8_BAR; PG8_WAIT_L(0); PG8_MMA(0, 1, At, B1); PG8_BAR;
            PG8_LDA(At, 1, 1); PG8_STAGE(PG8_SA(1, 0), a3, voffA);
            PG8_BAR; PG8_WAIT_L(0); PG8_MMA(1, 0, At, B0); PG8_BAR; PG8_SCHED;
            PG8_STAGE(PG8_SB(1, 1), b3 + hstep, voffB);
            PG8_WAIT_V(6); PG8_BAR; PG8_MMA(1, 1, At, B1); PG8_BAR;
            }
        }
        if constexpr (ALIGN_EPI) { if (wr == 0) PG8_BAR; }
        if constexpr (!Epi::AFTER_DRAIN) { E(acc, cur, wr, wc, fr, fq); S.done(cur); }
        if (!has_next) break;
#pragma unroll
        for (int a = 0; a < 2; ++a)
#pragma unroll
            for (int b = 0; b < 2; ++b)
#pragma unroll
                for (int m = 0; m < 4; ++m)
#pragma unroll
                    for (int n = 0; n < 2; ++n) acc[a][b][m][n] = (f32x4){0.f, 0.f, 0.f, 0.f};
        cur = nxt; cA = nA; cB = nB; ++ui;
        if constexpr (ALIGN_EPI) { if (wr == 1) PG8_BAR; }
    }
    PG8_WAIT_V(0);
    if constexpr (!ALIGN_EPI) { if (wr == 0) PG8_BAR; }
    PG8_BAR;
    if constexpr (Epi::AFTER_DRAIN) { E.fused(acc, cur, wr, wc, fr, fq, lds, wid, lane); S.done(cur); }
#undef PG8_SA
#undef PG8_SB
#undef PG8_STAGE
#undef PG8_LDA
#undef PG8_LDB
#undef PG8_MMA
#undef PG8_WAIT_V
#undef PG8_WAIT_L
#undef PG8_BAR
#undef PG8_SCHED
}
}
namespace att {
typedef unsigned short bf16;
typedef short bf16x8 __attribute__((ext_vector_type(8)));
typedef short s16x4 __attribute__((ext_vector_type(4)));
typedef float f32x16 __attribute__((ext_vector_type(16)));
typedef float f32x4 __attribute__((ext_vector_type(4)));
typedef unsigned u32x4 __attribute__((ext_vector_type(4)));
enum { MODE_FOX = 0, MODE_WIN = 1, MODE_SLC = 2 };
constexpr int D = 128, NW = 8, QBLK = 32, KVBLK = 64, QB = NW * QBLK, SEQ = 8192;
constexpr float SCALE = 0.08838834764831845f, THR = 8.f;
constexpr int SHM_V = KVBLK * D * 2, SHM_K = KVBLK * D * 2;
constexpr int LDS_Q = 2 * SHM_V + 2 * SHM_K, LDS_WSF = LDS_Q + NW * QBLK * D * 2, LDS_T5 = LDS_WSF + NW * 128 * 4, LDS_BIAS = LDS_T5 + 6 * 132 * 4, ATT_LDS_BYTES = LDS_BIAS + 512;
constexpr int WBIG = 1 << 30;
#define KSWZ(row, colB) ((row) * 256 + ((colB) ^ (((row) & 7) << 4)))
#define SBAR() __builtin_amdgcn_sched_barrier(0)
__device__ __forceinline__ int v_st(int k, int c) { const int kk = (k & ~0xC) | ((k & 4) << 1) | ((k & 8) >> 1); return ((kk >> 3) * 4 + (c >> 5)) * 512 + ((kk & 7) * 32 + (c & 31)) * 2; }
__device__ __forceinline__ int v_rd_base(int lane) { return ((lane & 3) << 3) | (((lane >> 2) & 3) << 6) | (((lane >> 4) & 1) << 5) | (((lane >> 5) & 1) << 8); }
constexpr int v_rd_off(int d0, int ks, int half) { return d0 * 512 + ks * 4096 + half * 2048; }
__device__ __forceinline__ int crow(int r, int hi) { return (r & 3) + 8 * (r >> 2) + 4 * hi; }
__device__ __forceinline__ unsigned cvtpk(float lo, float hi) { unsigned r; asm volatile("v_cvt_pk_bf16_f32 %0, %1, %2" : "=v"(r) : "v"(lo), "v"(hi)); return r; }
__device__ __forceinline__ bf16x8 load8(const bf16* p) { return *reinterpret_cast<const bf16x8*>(p); }
__device__ __forceinline__ float bflo(unsigned w) { return __builtin_bit_cast(float, w << 16); }
__device__ __forceinline__ float bfhi(unsigned w) { return __builtin_bit_cast(float, w & 0xffff0000u); }
__device__ __forceinline__ float silu_(float v) { return v * __builtin_amdgcn_rcpf(1.f + __expf(-v)); }
__device__ __forceinline__ float slc_cv(int j, unsigned w0, unsigned w1, unsigned w2, unsigned w3, float c31) {
    const unsigned wj = j < 32 ? w0 : (j < 64 ? w1 : (j < 96 ? w2 : w3)); return ((wj >> (j & 31)) & 1u) ? c31 : -__builtin_inff(); }
__device__ __forceinline__ void mask_tile(f32x16& p0, f32x16& p1, int dq, unsigned W) {
    const float NEG = -__builtin_inff();
#pragma unroll
    for (int r = 0; r < 16; ++r) { const int c = (r & 3) + 8 * (r >> 2);
        if ((unsigned)(dq - c) >= W) p0[r] = NEG;
        if ((unsigned)(dq - c - 32) >= W) p1[r] = NEG; }
}
__device__ __forceinline__ void t5_tile(f32x16& p0, f32x16& p1, int dq, const float* Td) {
#pragma unroll
    for (int g4 = 0; g4 < 4; ++g4) {
#pragma unroll
        for (int i = 0; i < 4; ++i) { const int r = 4 * g4 + i, c = (r & 3) + 8 * (r >> 2);
            int d0 = dq - c, d1 = dq - c - 32; d0 = d0 < 0 ? 0 : (d0 > 127 ? 127 : d0); d1 = d1 < 0 ? 0 : (d1 > 127 ? 127 : d1);
            p0[r] += Td[d0]; p1[r] += Td[d1]; }
        asm volatile("" ::: "memory"); }
}
__device__ __forceinline__ void partialSM(f32x16& p0, f32x16& p1, float& m_reg, float& mn, float& alpha) {
    float pmax = p0[0];
#pragma unroll
    for (int r = 1; r < 16; ++r) pmax = fmaxf(pmax, p0[r]);
#pragma unroll
    for (int r = 0; r < 16; ++r) pmax = fmaxf(pmax, p1[r]);
    { auto rr = __builtin_amdgcn_permlane32_swap(__float_as_uint(pmax), __float_as_uint(pmax), false, false);
      pmax = fmaxf(__uint_as_float(rr[0]), __uint_as_float(rr[1])); }
    constexpr float C2 = 1.4426950408889634f * SCALE;
    if (__builtin_expect(__all((pmax - m_reg) * SCALE <= THR), 1)) { mn = m_reg; alpha = 1.f; }
    else { mn = fmaxf(m_reg, pmax); alpha = __builtin_amdgcn_exp2f((m_reg - mn) * C2); m_reg = mn; }
    const float mnL = -mn * C2;
#pragma unroll
    for (int r = 0; r < 16; ++r) p0[r] = fmaf(p0[r], C2, mnL);
#pragma unroll
    for (int r = 0; r < 16; ++r) p1[r] = fmaf(p1[r], C2, mnL);
#pragma unroll
    for (int r = 0; r < 16; ++r) p0[r] = __builtin_amdgcn_exp2f(p0[r]);
}
__device__ __forceinline__ void finishSM(f32x16& p0, f32x16& p1, float alpha, float& l_reg, bf16x8& pa0, bf16x8& pa1, bf16x8& pa2, bf16x8& pa3) {
#pragma unroll
    for (int r = 0; r < 16; ++r) p1[r] = __builtin_amdgcn_exp2f(p1[r]);
    float ps = 0;
#pragma unroll
    for (int r = 0; r < 16; ++r) ps += p0[r];
#pragma unroll
    for (int r = 0; r < 16; ++r) ps += p1[r];
    { auto rr = __builtin_amdgcn_permlane32_swap(__float_as_uint(ps), __float_as_uint(ps), false, false);
      ps = __uint_as_float(rr[0]) + __uint_as_float(rr[1]); }
    l_reg = l_reg * alpha + ps;
#define PK4(P, B_, OUT) do { unsigned a0 = cvtpk(P[B_+0], P[B_+1]), a1 = cvtpk(P[B_+2], P[B_+3]);                          \
        unsigned b0 = cvtpk(P[B_+4], P[B_+5]), b1 = cvtpk(P[B_+6], P[B_+7]);                                             \
        auto r0 = __builtin_amdgcn_permlane32_swap(a0, b0, false, false); auto r1 = __builtin_amdgcn_permlane32_swap(a1, b1, false, false); \
        u32x4 w = {r0[0], r1[0], r0[1], r1[1]}; OUT = *reinterpret_cast<bf16x8*>(&w); } while (0)
    PK4(p0, 0, pa0); PK4(p0, 8, pa1); PK4(p1, 0, pa2); PK4(p1, 8, pa3);
#undef PK4
}
template <int KB, bool SK, int MODE>
__device__ __forceinline__ void qkt(f32x16& p0, f32x16& p1, const char* K_lds, const char* B_lds, float cv, int r32, int hi, const char* Qw, bool act) {
    if (SK && !act) { const float NEG = -__builtin_inff();
#pragma unroll
        for (int r = 0; r < 16; ++r) { p0[r] = NEG; p1[r] = NEG; } return; }
    if (MODE == MODE_FOX) { const float* bb = (const float*)(B_lds + KB * 256) + 4 * hi;
        const f32x4 a0 = *(const f32x4*)(bb), a1 = *(const f32x4*)(bb + 8), a2 = *(const f32x4*)(bb + 16), a3 = *(const f32x4*)(bb + 24);
        const f32x4 b0 = *(const f32x4*)(bb + 32), b1 = *(const f32x4*)(bb + 40), b2 = *(const f32x4*)(bb + 48), b3 = *(const f32x4*)(bb + 56);
        p0 = (f32x16){a0[0], a0[1], a0[2], a0[3], a1[0], a1[1], a1[2], a1[3], a2[0], a2[1], a2[2], a2[3], a3[0], a3[1], a3[2], a3[3]};
        p1 = (f32x16){b0[0], b0[1], b0[2], b0[3], b1[0], b1[1], b1[2], b1[3], b2[0], b2[1], b2[2], b2[3], b3[0], b3[1], b3[2], b3[3]}; }
    else {
#pragma unroll
        for (int r = 0; r < 16; ++r) { p0[r] = cv; p1[r] = cv; } }
    const char* kb[4]; const char* qb[4];
#pragma unroll
    for (int dd = 0; dd < 4; ++dd) { const int off = KSWZ(r32, (dd * 16 + hi * 8) * 2); kb[dd] = K_lds + KB * SHM_K + off; qb[dd] = Qw + off; }
#pragma unroll
    for (int d0 = 0; d0 < 8; ++d0) { const char* a = kb[d0 & 3] + (d0 >> 2) * 128;
        bf16x8 b0 = *reinterpret_cast<const bf16x8*>(a);
        bf16x8 b1 = *reinterpret_cast<const bf16x8*>(a + 32 * 256);
        const bf16x8 qv = *reinterpret_cast<const bf16x8*>(qb[d0 & 3] + (d0 >> 2) * 128);
        p0 = __builtin_amdgcn_mfma_f32_32x32x16_bf16(b0, qv, p0, 0, 0, 0);
        p1 = __builtin_amdgcn_mfma_f32_32x32x16_bf16(b1, qv, p1, 0, 0, 0); }
}
template <int VB, bool SK>
__device__ __forceinline__ void pv_tile(f32x16* o, int vb0, bf16x8 pa0, bf16x8 pa1, bf16x8 pa2, bf16x8 pa3, bool act) {
    if (SK && !act) return;
#define TRRD(dst, off) asm volatile("ds_read_b64_tr_b16 %0, %1 offset:%2" : "=&v"(dst) : "v"(vb0), "i"(off) : "memory")
#define PV_D0(d0) do { s16x4 l0, l1, l2, l3, h0, h1, h2, h3; constexpr int b_ = VB * SHM_V + v_rd_off(d0, 0, 0); \
        TRRD(l0, b_); TRRD(h0, b_ + 2048); TRRD(l1, b_ + 4096); TRRD(h1, b_ + 6144); TRRD(l2, b_ + 8192); TRRD(h2, b_ + 10240); TRRD(l3, b_ + 12288); TRRD(h3, b_ + 14336); \
        asm volatile("s_waitcnt lgkmcnt(0)" ::: "memory"); SBAR();   \
        o[d0] = __builtin_amdgcn_mfma_f32_32x32x16_bf16(pa0, (bf16x8){l0[0], l0[1], l0[2], l0[3], h0[0], h0[1], h0[2], h0[3]}, o[d0], 0, 0, 0);   \
        o[d0] = __builtin_amdgcn_mfma_f32_32x32x16_bf16(pa1, (bf16x8){l1[0], l1[1], l1[2], l1[3], h1[0], h1[1], h1[2], h1[3]}, o[d0], 0, 0, 0);   \
        o[d0] = __builtin_amdgcn_mfma_f32_32x32x16_bf16(pa2, (bf16x8){l2[0], l2[1], l2[2], l2[3], h2[0], h2[1], h2[2], h2[3]}, o[d0], 0, 0, 0);   \
        o[d0] = __builtin_amdgcn_mfma_f32_32x32x16_bf16(pa3, (bf16x8){l3[0], l3[1], l3[2], l3[3], h3[0], h3[1], h3[2], h3[3]}, o[d0], 0, 0, 0); } while (0)
    PV_D0(0); PV_D0(1); PV_D0(2); PV_D0(3);
#undef PV_D0
#undef TRRD
}
struct BlockRef { const bf16* Q; const bf16* K; const bf16* V; const float* bias; int P0, W, h, mode; };
struct Aux {
    const float* biasF;
    const unsigned* selm;
    const float* small;
    const bf16* zf; const bf16* zn; const bf16* oc; bf16* ow; bf16* y;
};
struct Seam { bf16x8 st_v0, st_v1, st_k0, st_k1; f32x4 st_b; };
__device__ __forceinline__ int swa_jlo(int P0, int W) { const int lowk = P0 - W + 1; return lowk > 0 ? lowk / KVBLK : 0; }
#define ROW(p, k0, rr) ((p) + (size_t)((k0) + (rr)) * D + sc)
#define VMW() asm volatile("s_waitcnt vmcnt(0)" ::: "memory")
#define VMWN(n) asm volatile("s_waitcnt vmcnt(%0)" :: "i"(n) : "memory")
#define SLOAD_H(Kp, Vp, Bp, k0) do { S.st_v0 = load8(ROW(Vp, k0, sr)); S.st_v1 = load8(ROW(Vp, k0, 32 + sr));              \
                         S.st_k0 = load8(ROW(Kp, k0, sr)); S.st_k1 = load8(ROW(Kp, k0, 32 + sr));                        \
                         if ((Bp) != nullptr && tid < 16) S.st_b = *(const f32x4*)((Bp) + (k0) + 4 * tid); } while (0)
#define SWRITE_HK(bf, Bp) do { *(bf16x8*)(K_lds + (bf) * SHM_K + kws) = S.st_k0; *(bf16x8*)(K_lds + (bf) * SHM_K + kws + 32 * 256) = S.st_k1; \
                         if ((Bp) != nullptr && tid < 16) *(f32x4*)(B_lds + (bf) * 256 + tid * 16) = S.st_b; } while (0)
#define SWRITE_HV(bf) do { *(bf16x8*)(V_lds + (bf) * SHM_V + vst0) = S.st_v0; *(bf16x8*)(V_lds + (bf) * SHM_V + vst1) = S.st_v1; } while (0)
#define SWRITE_H(bf, Bp) do { SWRITE_HV(bf); SWRITE_HK(bf, Bp); } while (0)
__device__ __forceinline__ void attn_prime(const BlockRef& cur, char* lds, Seam& S, int tid) {
    const int wid = __builtin_amdgcn_readfirstlane(tid >> 6), lane = tid & 63, r32 = lane & 31, hi = lane >> 5;
    const int sr = tid >> 4, sc = (tid & 15) * 8, kws = KSWZ(sr, sc * 2); char* K_lds = lds + 2 * SHM_V; char* B_lds = lds + LDS_BIAS;
    const int kb0 = swa_jlo(cur.P0, cur.W) * KVBLK;
    bf16x8 qt_[8]; char* Qw = lds + LDS_Q + wid * (QBLK * D * 2);
#pragma unroll
    for (int d0 = 0; d0 < 8; ++d0) qt_[d0] = load8(cur.Q + (size_t)(wid * QBLK + r32) * D + d0 * 16 + hi * 8);
    SLOAD_H(cur.K, cur.V, cur.bias, kb0); VMW(); SWRITE_HK(0, cur.bias);
    { int r32q = r32, hiq = hi; asm volatile("" : "+v"(r32q), "+v"(hiq));
#pragma unroll
      for (int dd = 0; dd < 4; ++dd) { char* qd = Qw + KSWZ(r32q, (dd * 16 + hiq * 8) * 2); *(bf16x8*)qd = qt_[dd]; *(bf16x8*)(qd + 128) = qt_[dd + 4]; } }
    __syncthreads();
}
template <int MODE>
__device__ __forceinline__ void attn_block(const BlockRef& cur, const BlockRef& nxt, const Aux& X, char* lds, Seam& S, int tid_in) {
    constexpr bool SK = (MODE == MODE_WIN);
    int tid = tid_in; asm volatile("" : "+v"(tid));
    const int wid = __builtin_amdgcn_readfirstlane(tid >> 6), lane = tid & 63, r32 = lane & 31, hi = lane >> 5;
    const int W = cur.W, h = cur.h;
    const int j_lo = swa_jlo(cur.P0, W);
    int j_hi = (cur.P0 + QB - 1) / KVBLK + 1; if (j_hi > SEQ / KVBLK) j_hi = SEQ / KVBLK;
    const int NT = j_hi - j_lo;
    const int kbn = swa_jlo(nxt.P0, nxt.W) * KVBLK;
    const int qlo = cur.P0 + wid * QBLK, qm = qlo + r32 - 4 * hi;
    char* V_lds = lds; char* K_lds = lds + 2 * SHM_V; char* B_lds = lds + LDS_BIAS;
    char* Qw = lds + LDS_Q + wid * (QBLK * D * 2);
    float* ws = (float*)(lds + LDS_WSF) + wid * 128; float* li_l = ws, * al_l = ws + 32, * gw_l = ws + 64;
    const float* Td = (const float*)(lds + LDS_T5) + h * 132;
    float m_reg = -1e30f, l_reg = 0; f32x16 o[4] = {};
    const int sr = tid >> 4, sc = (tid & 15) * 8, vst0 = v_st(sr, sc), vst1 = v_st(32 + sr, sc), kws = KSWZ(sr, sc * 2);
    const int vb0 = (int)(uintptr_t)V_lds + v_rd_base(lane);
    const bf16* Kh = cur.K; const bf16* Vh = cur.V;
    float c31 = 0.f; unsigned sw0 = 0, sw1 = 0, sw2 = 0, sw3 = 0;
    if (MODE != MODE_FOX) c31 = Td[128];
    if (MODE == MODE_SLC) { const u32x4 wv = *(const u32x4*)(X.selm + ((size_t)(h / 3) * SEQ + qlo + r32) * 4); sw0 = wv.x; sw1 = wv.y; sw2 = wv.z; sw3 = wv.w; }
    const float* bF = cur.bias;
#define RESC(a) do { if (__any((a) < 1.f)) { if (hi == 0) al_l[r32] = (a); asm volatile("s_waitcnt lgkmcnt(0)" ::: "memory");              \
                     for (int d_ = 0; d_ < 4; ++d_) for (int r = 0; r < 16; ++r) o[d_][r] *= al_l[crow(r, hi)]; } } while (0)
#define KBASE(t) ((j_lo + (t)) * KVBLK)
#define ACT(t) (KBASE(t) <= qlo + QBLK - 1 && KBASE(t) + KVBLK - 1 >= qlo - W + 1)
#define CV(t) ((MODE == MODE_SLC) ? slc_cv(j_lo + (t), sw0, sw1, sw2, sw3, c31) : c31)
#define MASKT(P0_, P1_, t) do { const int kb_ = KBASE(t);                                                                                \
        if (MODE != MODE_FOX && (!SK || ACT(t)) && (kb_ + KVBLK - 1 + 112 >= qlo)) t5_tile(P0_, P1_, qm - kb_, Td);                      \
        if ((!SK || ACT(t)) && (kb_ + KVBLK - 1 > qlo || kb_ <= qlo + QBLK - 1 - W)) mask_tile(P0_, P1_, qm - kb_, (unsigned)W); } while (0)
    f32x16 p0, p1; float mnX, alX; bf16x8 pa0, pa1, pa2, pa3; bf16x8 qn_[8];
    SWRITE_HV(0);
    __syncthreads();
#define STEP(t, PB) do { const bool last_ = ((t) + 1 == NT);                                                                  \
        if (!last_) SLOAD_H(Kh, Vh, bF, KBASE((t) + 1)); else SLOAD_H(nxt.K, nxt.V, nxt.bias, kbn);                           \
        SBAR(); qkt<PB, SK, MODE>(p0, p1, K_lds, B_lds, CV(t), r32, hi, Qw, ACT(t)); SBAR();                                   \
        if (last_) { _Pragma("unroll") for (int d0 = 0; d0 < 8; ++d0) qn_[d0] = load8(nxt.Q + (size_t)(wid * QBLK + r32) * D + d0 * 16 + hi * 8); } \
        MASKT(p0, p1, (t)); partialSM(p0, p1, m_reg, mnX, alX); RESC(alX);                                                    \
        finishSM(p0, p1, alX, l_reg, pa0, pa1, pa2, pa3); SBAR();                                                             \
        pv_tile<PB, SK>(o, vb0, pa0, pa1, pa2, pa3, ACT(t)); SBAR();                                                          \
        if (!last_) { VMW(); SWRITE_H(1 - (PB), bF); }                                                                        \
        __syncthreads(); } while (0)
    for (int t = 0; t < NT; t += 2) { STEP(t, 0); if (t + 1 < NT) STEP(t + 1, 1); }
#undef STEP
    VMW(); SWRITE_HK(0, nxt.bias);
    { int r32q = r32, hiq = hi; asm volatile("" : "+v"(r32q), "+v"(hiq));
#pragma unroll
      for (int dd = 0; dd < 4; ++dd) { char* qd = Qw + KSWZ(r32q, (dd * 16 + hiq * 8) * 2); *(bf16x8*)qd = qn_[dd]; *(bf16x8*)(qd + 128) = qn_[dd + 4]; } }
    SBAR();
    int r32e = r32, hie = hi; asm volatile("" : "+v"(r32e), "+v"(hie));
    { float f = __builtin_amdgcn_rcpf(l_reg), gwv = 0.f;
      if (MODE == MODE_SLC) { const float* sm = X.small + (size_t)(qlo + r32e) * 32 + 6 + 3 * h; f *= 1.f / (1.f + __expf(-sm[1])); gwv = 1.f / (1.f + __expf(-sm[2])); }
      if (hie == 0) { li_l[r32e] = f; if (MODE == MODE_SLC) gw_l[r32e] = gwv; } }
    asm volatile("s_waitcnt lgkmcnt(0)" ::: "memory");
    float rli[16];
#pragma unroll
    for (int r = 0; r < 16; ++r) rli[r] = li_l[crow(r, hie)];
#pragma unroll
    for (int r = 0; r < 16; ++r) { const int q = qlo + crow(r, hie); float gwr = 0.f; if (MODE == MODE_SLC) gwr = gw_l[crow(r, hie)];
#pragma unroll
        for (int d0 = 0; d0 < 4; ++d0) { const int col = d0 * 32 + r32e; const float v = o[d0][r] * rli[r]; const float vn = __builtin_bit_cast(float, __builtin_amdgcn_mov_dpp(__builtin_bit_cast(int, v), 0xB1, 0xF, 0xF, true));
            if ((r32e & 1) == 0) {
                if (MODE == MODE_FOX) { const unsigned z2 = *(const unsigned*)(X.zf + (size_t)q * 768 + h * 128 + col);
                    *(unsigned*)(X.y + (size_t)q * 2048 + 512 + h * 128 + col) = cvtpk(v * silu_(bflo(z2)), vn * silu_(bfhi(z2))); }
                else if (MODE == MODE_WIN) { *(unsigned*)(X.ow + ((size_t)h * SEQ + q) * 128 + col) = cvtpk(v, vn); }
                else { const size_t oo = ((size_t)h * SEQ + q) * 128 + col; const unsigned c2 = *(const unsigned*)(X.oc + oo), w2 = *(const unsigned*)(X.ow + oo), z2 = *(const unsigned*)(X.zn + (size_t)q * 768 + h * 128 + col);
                    *(unsigned*)(X.y + (size_t)q * 2048 + 1280 + h * 128 + col) = cvtpk((v + bflo(c2) + gwr * bflo(w2)) * silu_(bflo(z2)), (vn + bfhi(c2) + gwr * bfhi(w2)) * silu_(bfhi(z2))); } } } }
    __syncthreads();
#undef RESC
#undef KBASE
#undef ACT
#undef CV
#undef MASKT
}
#undef ROW
#undef VMW
#undef VMWN
#undef SLOAD_H
#undef SWRITE_HK
#undef SWRITE_HV
#undef SWRITE_H
#undef KSWZ
#undef SBAR
}
#define GAS __attribute__((address_space(1)))
#define LAS __attribute__((address_space(3)))
typedef unsigned short bf16;
typedef unsigned v4u __attribute__((ext_vector_type(4)));
typedef float f32x4 __attribute__((ext_vector_type(4)));
typedef short bf16x8 __attribute__((ext_vector_type(8)));
typedef GAS unsigned gu32;
typedef GAS unsigned long long gu64;
#define RLX_AGENT __ATOMIC_RELAXED, __HIP_MEMORY_SCOPE_AGENT
#define LDS_WAIT() asm volatile("s_waitcnt lgkmcnt(0)" ::: "memory")
#define VM_WAIT() asm volatile("s_waitcnt vmcnt(0)" ::: "memory")
__device__ __forceinline__ unsigned long long rt() { return __builtin_amdgcn_s_memrealtime(); }
__device__ __forceinline__ unsigned f2bf(float f) { unsigned u = __builtin_bit_cast(unsigned, f); return (u + 0x7fffu + ((u >> 16) & 1u)) >> 16; }
__device__ __forceinline__ unsigned pk2(float lo, float hi) { return f2bf(lo) | (f2bf(hi) << 16); }
#define XB_TMO      128
#define XB_XCNT(j)  (256  + 64 * (j))
#define XB_XSUB(j)  (1280 + 64 * (j))
#define XB_XGEN(j)  (2304 + 64 * (j))
#define XB_TOP      3328
#define XB_TOPGEN   3392
#define XCD_BAR_WORDS 3456
#define XB_SPIN_CAP (1u << 18)

__device__ __forceinline__ unsigned xb_ld(unsigned* p)              { return __hip_atomic_load(p, __ATOMIC_RELAXED, __HIP_MEMORY_SCOPE_AGENT); }
__device__ __forceinline__ unsigned xb_add(unsigned* p, unsigned v) { return __hip_atomic_fetch_add(p, v, __ATOMIC_RELAXED, __HIP_MEMORY_SCOPE_AGENT); }
__device__ __forceinline__ unsigned xb_xcc_id() { return (unsigned)__builtin_amdgcn_s_getreg((3 << 11) | 20) & 0xFu; }
#define XB_SPIN(cond, bar) do { unsigned _sp = 0; while (cond) { __builtin_amdgcn_s_sleep(1); \
    if ((++_sp & 255u) == 0u) { if (xb_ld(&(bar)[XB_TMO])) break; if (_sp > XB_SPIN_CAP) { atomicAdd(&(bar)[XB_TMO], 1u); break; } } } } while (0)

struct XcdBarrier {
    unsigned* bar; unsigned x;
    volatile LAS unsigned* st;
};

__device__ __forceinline__ XcdBarrier xcd_barrier_post(unsigned* bar, volatile LAS unsigned* st) {
    XcdBarrier b; b.bar = bar; b.x = xb_xcc_id(); b.st = st;
    if (threadIdx.x == 0) (void)xb_add(&bar[XB_XCNT(b.x)], 1u);
    return b;
}
__device__ __forceinline__ void xcd_barrier_complete(unsigned* bar, unsigned x, unsigned& nloc, unsigned& nx) {
    const unsigned G = gridDim.x * gridDim.y * gridDim.z;
    unsigned sum, cnt, mine, sp = 0u;
    for (;;) {
        sum = 0u; cnt = 0u; mine = 0u;
#pragma unroll
        for (unsigned j = 0; j < 16; ++j) { const unsigned c = xb_ld(&bar[XB_XCNT(j)]); sum += c; cnt += (c > 0u) ? 1u : 0u; mine = (j == x) ? c : mine; }
        if (sum == G) break;
        __builtin_amdgcn_s_sleep(1);
        if ((++sp & 255u) == 0u) { if (xb_ld(&bar[XB_TMO])) break; if (sp > XB_SPIN_CAP) { atomicAdd(&bar[XB_TMO], 1u); break; } }
    }
    nloc = mine > 0u ? mine : 1u; nx = cnt > 0u ? cnt : 1u;
}

__device__ __forceinline__ void xcd_barrier(const XcdBarrier& b) {
    asm volatile("s_waitcnt vmcnt(0)" ::: "memory");
    __syncthreads();
    if (threadIdx.x == 0) {
        unsigned* bar = b.bar;
        __builtin_amdgcn_s_waitcnt(0);
        unsigned nloc = b.st[0], nx = b.st[1];
        if (nloc == 0u) { xcd_barrier_complete(bar, b.x, nloc, nx); b.st[0] = nloc; b.st[1] = nx; }
        const unsigned old = xb_add(&bar[XB_XSUB(b.x)], 1u);
        const unsigned gen = old / nloc;
        if (old + 1u == (gen + 1u) * nloc) {
            __builtin_amdgcn_fence(__ATOMIC_RELEASE, "agent");
            asm volatile("s_waitcnt vmcnt(0)" ::: "memory");
            const unsigned og = xb_add(&bar[XB_TOP], 1u);
            const unsigned tg = og / nx;
            if (og + 1u == (tg + 1u) * nx) xb_add(&bar[XB_TOPGEN], 1u);
            else XB_SPIN(xb_ld(&bar[XB_TOPGEN]) == tg, bar);
            __builtin_amdgcn_fence(__ATOMIC_ACQUIRE, "agent");
            xb_add(&bar[XB_XGEN(b.x)], 1u);
            asm volatile("s_waitcnt vmcnt(0)" ::: "memory");
        } else {
            XB_SPIN(xb_ld(&bar[XB_XGEN(b.x)]) == gen, bar);
            __builtin_amdgcn_fence(__ATOMIC_ACQUIRE, "agent");
            asm volatile("s_waitcnt vmcnt(0)" ::: "memory");
        }
    }
    __syncthreads();
}
constexpr int NWAVES = 8, NTHR = 512;
constexpr int S = 8192, DM = 2048, DEPTH = 4, NIN = 8216, NBIG = 8192;
constexpr float SM_SCALE = 0.08838834764831845f, NORM_EPS = 1e-6f;
constexpr size_t MiB = 1u << 20, HEADB = (size_t)S * 128 * 2;
constexpr size_t WS_CTL = 0, CTL_ZERO_BYTES = 1 * MiB;
constexpr size_t WS_MOD = 1 * MiB, WS_B1P = 1 * MiB + 128 * 1024, WS_SMALL = 2 * MiB, WS_BIASF = 3 * MiB, WS_FT = 3 * MiB + 256 * 1024, WS_SELM = 3 * MiB + 512 * 1024;
constexpr size_t WS_KCMP = 4 * MiB, WS_VCMPT = 4 * MiB + 256 * 1024, WS_WSM = 5 * MiB, WS_W2T = 6 * MiB, WS_W1T = 8 * MiB, WS_WOUT = 24 * MiB, WS_WIN = 56 * MiB;
constexpr size_t WS_H = 184 * MiB, WS_CONV = 216 * MiB, WS_ZF = 248 * MiB, WS_ZN = 260 * MiB, WS_ATT = 272 * MiB, WS_OC = 346 * MiB, WS_OW = 358 * MiB, WS_Y = 370 * MiB, WS_Y2 = 402 * MiB;
constexpr size_t WS_NAIVE = 480 * MiB;
constexpr int HP_QF = 0, HP_KF = 6, HP_VF = 12, HP_QN = 18, HP_KC = 24, HP_VC = 26, HP_KS = 28, HP_VS = 30, HP_KW = 32, HP_VW = 34;
constexpr int CW_BAR = 4096;
constexpr int RING_BYTES = 131072, LDSCTL_OFF = 146432, MISC_OFF = LDSCTL_OFF + 320, LDS_BYTES = 147456;
constexpr int NPH = 6, NSTEPS = 2 + DEPTH * NPH;
constexpr int SCHED_D_LEN = 3;
__device__ const unsigned short SCHED_D[256 * SCHED_D_LEN] = {
  0x02bf, 0xffff, 0xffff,
  0x029f, 0xffff, 0xffff,
  0x027f, 0xffff, 0xffff,
  0x025f, 0xffff, 0xffff,
  0x023f, 0xffff, 0xffff,
  0x021f, 0xffff, 0xffff,
  0x00bf, 0xffff, 0xffff,
  0x009f, 0xffff, 0xffff,
  0x007f, 0xffff, 0xffff,
  0x005f, 0xffff, 0xffff,
  0x003f, 0xffff, 0xffff,
  0x001f, 0xffff, 0xffff,
  0x02be, 0xffff, 0xffff,
  0x029e, 0xffff, 0xffff,
  0x027e, 0xffff, 0xffff,
  0x025e, 0xffff, 0xffff,
  0x023e, 0xffff, 0xffff,
  0x021e, 0xffff, 0xffff,
  0x00be, 0xffff, 0xffff,
  0x009e, 0xffff, 0xffff,
  0x007e, 0xffff, 0xffff,
  0x005e, 0xffff, 0xffff,
  0x003e, 0xffff, 0xffff,
  0x001e, 0xffff, 0xffff,
  0x02bd, 0xffff, 0xffff,
  0x029d, 0xffff, 0xffff,
  0x027d, 0xffff, 0xffff,
  0x025d, 0xffff, 0xffff,
  0x023d, 0xffff, 0xffff,
  0x021d, 0xffff, 0xffff,
  0x00bd, 0xffff, 0xffff,
  0x009d, 0xffff, 0xffff,
  0x007d, 0xffff, 0xffff,
  0x005d, 0xffff, 0xffff,
  0x003d, 0xffff, 0xffff,
  0x001d, 0xffff, 0xffff,
  0x02bc, 0xffff, 0xffff,
  0x029c, 0xffff, 0xffff,
  0x027c, 0xffff, 0xffff,
  0x025c, 0xffff, 0xffff,
  0x023c, 0xffff, 0xffff,
  0x021c, 0xffff, 0xffff,
  0x00bc, 0xffff, 0xffff,
  0x009c, 0xffff, 0xffff,
  0x007c, 0xffff, 0xffff,
  0x005c, 0xffff, 0xffff,
  0x003c, 0xffff, 0xffff,
  0x001c, 0xffff, 0xffff,
  0x02bb, 0xffff, 0xffff,
  0x029b, 0xffff, 0xffff,
  0x027b, 0xffff, 0xffff,
  0x025b, 0xffff, 0xffff,
  0x023b, 0xffff, 0xffff,
  0x021b, 0xffff, 0xffff,
  0x00bb, 0xffff, 0xffff,
  0x009b, 0xffff, 0xffff,
  0x007b, 0xffff, 0xffff,
  0x005b, 0xffff, 0xffff,
  0x003b, 0xffff, 0xffff,
  0x001b, 0xffff, 0xffff,
  0x02ba, 0xffff, 0xffff,
  0x029a, 0xffff, 0xffff,
  0x027a, 0xffff, 0xffff,
  0x025a, 0xffff, 0xffff,
  0x023a, 0xffff, 0xffff,
  0x021a, 0xffff, 0xffff,
  0x00ba, 0xffff, 0xffff,
  0x009a, 0xffff, 0xffff,
  0x007a, 0xffff, 0xffff,
  0x005a, 0xffff, 0xffff,
  0x003a, 0xffff, 0xffff,
  0x001a, 0xffff, 0xffff,
  0x02b9, 0xffff, 0xffff,
  0x0299, 0xffff, 0xffff,
  0x0279, 0xffff, 0xffff,
  0x0259, 0xffff, 0xffff,
  0x0239, 0xffff, 0xffff,
  0x0219, 0xffff, 0xffff,
  0x00b9, 0xffff, 0xffff,
  0x0099, 0xffff, 0xffff,
  0x0079, 0xffff, 0xffff,
  0x0059, 0xffff, 0xffff,
  0x0039, 0xffff, 0xffff,
  0x0019, 0xffff, 0xffff,
  0x02b8, 0xffff, 0xffff,
  0x0298, 0xffff, 0xffff,
  0x0278, 0xffff, 0xffff,
  0x0258, 0xffff, 0xffff,
  0x0238, 0xffff, 0xffff,
  0x0218, 0xffff, 0xffff,
  0x00b8, 0xffff, 0xffff,
  0x0098, 0xffff, 0xffff,
  0x0078, 0xffff, 0xffff,
  0x0058, 0xffff, 0xffff,
  0x0038, 0xffff, 0xffff,
  0x0018, 0xffff, 0xffff,
  0x02b7, 0xffff, 0xffff,
  0x0297, 0xffff, 0xffff,
  0x0277, 0xffff, 0xffff,
  0x0257, 0xffff, 0xffff,
  0x0237, 0xffff, 0xffff,
  0x0217, 0xffff, 0xffff,
  0x00b7, 0xffff, 0xffff,
  0x0097, 0xffff, 0xffff,
  0x0077, 0xffff, 0xffff,
  0x0057, 0xffff, 0xffff,
  0x0037, 0xffff, 0xffff,
  0x0017, 0xffff, 0xffff,
  0x02b6, 0xffff, 0xffff,
  0x0296, 0xffff, 0xffff,
  0x0276, 0xffff, 0xffff,
  0x0256, 0xffff, 0xffff,
  0x0236, 0xffff, 0xffff,
  0x0216, 0xffff, 0xffff,
  0x00b6, 0xffff, 0xffff,
  0x0096, 0xffff, 0xffff,
  0x0076, 0xffff, 0xffff,
  0x0056, 0xffff, 0xffff,
  0x0036, 0xffff, 0xffff,
  0x0016, 0xffff, 0xffff,
  0x02b5, 0x0060, 0xffff,
  0x0295, 0x0040, 0xffff,
  0x0275, 0x0020, 0xffff,
  0x0255, 0x0000, 0xffff,
  0x0235, 0xffff, 0xffff,
  0x0215, 0xffff, 0xffff,
  0x00b5, 0xffff, 0xffff,
  0x0095, 0xffff, 0xffff,
  0x0075, 0xffff, 0xffff,
  0x0055, 0xffff, 0xffff,
  0x0035, 0xffff, 0xffff,
  0x0015, 0xffff, 0xffff,
  0x02b4, 0x0061, 0xffff,
  0x0294, 0x0041, 0xffff,
  0x0274, 0x0021, 0xffff,
  0x0254, 0x0001, 0xffff,
  0x0234, 0x02a0, 0xffff,
  0x0214, 0x0280, 0xffff,
  0x00b4, 0x0260, 0xffff,
  0x0094, 0x0240, 0xffff,
  0x0074, 0x0220, 0xffff,
  0x0054, 0x0200, 0xffff,
  0x0034, 0x00a0, 0xffff,
  0x0014, 0x0080, 0xffff,
  0x02b3, 0x0062, 0xffff,
  0x0293, 0x0042, 0xffff,
  0x0273, 0x0022, 0xffff,
  0x0253, 0x0002, 0xffff,
  0x0233, 0x02a1, 0xffff,
  0x0213, 0x0281, 0xffff,
  0x00b3, 0x0261, 0xffff,
  0x0093, 0x0241, 0xffff,
  0x0073, 0x0221, 0xffff,
  0x0053, 0x0201, 0xffff,
  0x0033, 0x00a1, 0xffff,
  0x0013, 0x0081, 0xffff,
  0x02b2, 0x0063, 0xffff,
  0x0292, 0x0043, 0xffff,
  0x0272, 0x0023, 0xffff,
  0x0252, 0x0003, 0xffff,
  0x0232, 0x02a2, 0xffff,
  0x0212, 0x0282, 0xffff,
  0x00b2, 0x0262, 0xffff,
  0x0092, 0x0242, 0xffff,
  0x0072, 0x0222, 0xffff,
  0x0052, 0x0202, 0xffff,
  0x0032, 0x00a2, 0xffff,
  0x0012, 0x0082, 0xffff,
  0x02b1, 0x0064, 0xffff,
  0x0291, 0x0044, 0xffff,
  0x0271, 0x0024, 0xffff,
  0x0251, 0x0004, 0xffff,
  0x0231, 0x02a3, 0xffff,
  0x0211, 0x0283, 0xffff,
  0x00b1, 0x0263, 0xffff,
  0x0091, 0x0243, 0xffff,
  0x0071, 0x0223, 0xffff,
  0x0051, 0x0203, 0xffff,
  0x0031, 0x00a3, 0xffff,
  0x0011, 0x0083, 0xffff,
  0x02b0, 0x0065, 0xffff,
  0x0290, 0x0045, 0xffff,
  0x0270, 0x0025, 0xffff,
  0x0250, 0x0005, 0xffff,
  0x0230, 0x02a4, 0xffff,
  0x0210, 0x0284, 0xffff,
  0x00b0, 0x0264, 0xffff,
  0x0090, 0x0244, 0xffff,
  0x0070, 0x0224, 0xffff,
  0x0050, 0x0204, 0xffff,
  0x0030, 0x00a4, 0xffff,
  0x0010, 0x0084, 0xffff,
  0x02af, 0x0066, 0xffff,
  0x028f, 0x0046, 0xffff,
  0x026f, 0x0026, 0xffff,
  0x024f, 0x0006, 0xffff,
  0x022f, 0x02a5, 0xffff,
  0x020f, 0x0285, 0xffff,
  0x00af, 0x0265, 0xffff,
  0x008f, 0x0245, 0xffff,
  0x006f, 0x0225, 0xffff,
  0x004f, 0x0205, 0xffff,
  0x002f, 0x00a5, 0xffff,
  0x000f, 0x0085, 0xffff,
  0x02ae, 0x0067, 0xffff,
  0x028e, 0x0047, 0xffff,
  0x026e, 0x0027, 0xffff,
  0x024e, 0x0007, 0xffff,
  0x022e, 0x02a6, 0xffff,
  0x020e, 0x0286, 0xffff,
  0x00ae, 0x0266, 0xffff,
  0x008e, 0x0246, 0xffff,
  0x006e, 0x0226, 0xffff,
  0x004e, 0x0206, 0xffff,
  0x002e, 0x00a6, 0xffff,
  0x000e, 0x0086, 0xffff,
  0x02ad, 0x0068, 0xffff,
  0x028d, 0x0048, 0xffff,
  0x026d, 0x0028, 0xffff,
  0x024d, 0x0008, 0xffff,
  0x022d, 0x02a7, 0xffff,
  0x020d, 0x0287, 0xffff,
  0x00ad, 0x0267, 0xffff,
  0x008d, 0x0247, 0xffff,
  0x006d, 0x0227, 0xffff,
  0x004d, 0x0207, 0xffff,
  0x002d, 0x00a7, 0xffff,
  0x000d, 0x0087, 0xffff,
  0x02ac, 0x0069, 0xffff,
  0x028c, 0x0049, 0xffff,
  0x026c, 0x0029, 0xffff,
  0x024c, 0x0009, 0xffff,
  0x022c, 0x02a8, 0xffff,
  0x020c, 0x0288, 0xffff,
  0x00ac, 0x0268, 0xffff,
  0x008c, 0x0248, 0xffff,
  0x006c, 0x0228, 0xffff,
  0x004c, 0x0208, 0xffff,
  0x002c, 0x00a8, 0xffff,
  0x000c, 0x0088, 0xffff,
  0x02ab, 0x006a, 0xffff,
  0x028b, 0x004a, 0xffff,
  0x026b, 0x002a, 0xffff,
  0x024b, 0x000a, 0xffff,
  0x022b, 0x02a9, 0xffff,
  0x020b, 0x0289, 0xffff,
  0x00ab, 0x0269, 0xffff,
  0x008b, 0x0249, 0xffff,
  0x006b, 0x0229, 0xffff,
  0x004b, 0x0209, 0xffff,
  0x002b, 0x00a9, 0xffff,
  0x000b, 0x0089, 0xffff,
  0x02aa, 0x022a, 0xffff,
  0x028a, 0x020a, 0xffff,
  0x026a, 0x00aa, 0xffff,
  0x024a, 0x008a, 0xffff };
__device__ const unsigned short SCHED_B[256 * 2] = {
  0x0100, 0xffff,
  0x0101, 0xffff,
  0x0102, 0xffff,
  0x0103, 0xffff,
  0x0104, 0xffff,
  0x0105, 0xffff,
  0x0106, 0xffff,
  0x0107, 0xffff,
  0x0108, 0xffff,
  0x0109, 0xffff,
  0x010a, 0xffff,
  0x010b, 0xffff,
  0x010c, 0xffff,
  0x010d, 0xffff,
  0x010e, 0xffff,
  0x010f, 0xffff,
  0x0110, 0xffff,
  0x0111, 0xffff,
  0x0112, 0xffff,
  0x0113, 0xffff,
  0x0114, 0xffff,
  0x0115, 0xffff,
  0x0116, 0xffff,
  0x0117, 0xffff,
  0x0118, 0xffff,
  0x0119, 0xffff,
  0x011a, 0xffff,
  0x011b, 0xffff,
  0x011c, 0xffff,
  0x011d, 0xffff,
  0x011e, 0xffff,
  0x011f, 0xffff,
  0x0120, 0xffff,
  0x0121, 0xffff,
  0x0122, 0xffff,
  0x0123, 0xffff,
  0x0124, 0xffff,
  0x0125, 0xffff,
  0x0126, 0xffff,
  0x0127, 0xffff,
  0x0128, 0xffff,
  0x0129, 0xffff,
  0x012a, 0xffff,
  0x012b, 0xffff,
  0x012c, 0xffff,
  0x012d, 0xffff,
  0x012e, 0xffff,
  0x012f, 0xffff,
  0x0130, 0xffff,
  0x0131, 0xffff,
  0x0132, 0xffff,
  0x0133, 0xffff,
  0x0134, 0xffff,
  0x0135, 0xffff,
  0x0136, 0xffff,
  0x0137, 0xffff,
  0x0138, 0xffff,
  0x0139, 0xffff,
  0x013a, 0xffff,
  0x013b, 0xffff,
  0x013c, 0xffff,
  0x013d, 0xffff,
  0x013e, 0xffff,
  0x013f, 0xffff,
  0x0140, 0xffff,
  0x0141, 0xffff,
  0x0142, 0xffff,
  0x0143, 0xffff,
  0x0144, 0xffff,
  0x0145, 0xffff,
  0x0146, 0xffff,
  0x0147, 0xffff,
  0x0148, 0xffff,
  0x0149, 0xffff,
  0x014a, 0xffff,
  0x014b, 0xffff,
  0x014c, 0xffff,
  0x014d, 0xffff,
  0x014e, 0xffff,
  0x014f, 0xffff,
  0x0150, 0xffff,
  0x0151, 0xffff,
  0x0152, 0xffff,
  0x0153, 0xffff,
  0x0154, 0xffff,
  0x0155, 0xffff,
  0x0156, 0xffff,
  0x0157, 0xffff,
  0x0158, 0xffff,
  0x0159, 0xffff,
  0x015a, 0xffff,
  0x015b, 0xffff,
  0x015c, 0xffff,
  0x015d, 0xffff,
  0x015e, 0xffff,
  0x015f, 0xffff,
  0x0160, 0xffff,
  0x0161, 0xffff,
  0x0162, 0xffff,
  0x0163, 0xffff,
  0x0164, 0xffff,
  0x0165, 0xffff,
  0x0166, 0xffff,
  0x0167, 0xffff,
  0x0168, 0xffff,
  0x0169, 0xffff,
  0x016a, 0xffff,
  0x016b, 0xffff,
  0x016c, 0xffff,
  0x016d, 0xffff,
  0x016e, 0xffff,
  0x016f, 0xffff,
  0x0170, 0xffff,
  0x0171, 0xffff,
  0x0172, 0xffff,
  0x0173, 0xffff,
  0x0174, 0xffff,
  0x0175, 0xffff,
  0x0176, 0xffff,
  0x0177, 0xffff,
  0x0178, 0xffff,
  0x0179, 0xffff,
  0x017a, 0xffff,
  0x017b, 0xffff,
  0x017c, 0xffff,
  0x017d, 0xffff,
  0x017e, 0xffff,
  0x017f, 0xffff,
  0x0180, 0xffff,
  0x0181, 0xffff,
  0x0182, 0xffff,
  0x0183, 0xffff,
  0x0184, 0xffff,
  0x0185, 0xffff,
  0x0186, 0xffff,
  0x0187, 0xffff,
  0x0188, 0xffff,
  0x0189, 0xffff,
  0x018a, 0xffff,
  0x018b, 0xffff,
  0x018c, 0xffff,
  0x018d, 0xffff,
  0x018e, 0xffff,
  0x018f, 0xffff,
  0x0190, 0xffff,
  0x0191, 0xffff,
  0x0192, 0xffff,
  0x0193, 0xffff,
  0x0194, 0xffff,
  0x0195, 0xffff,
  0x0196, 0xffff,
  0x0197, 0xffff,
  0x0198, 0xffff,
  0x0199, 0xffff,
  0x019a, 0xffff,
  0x019b, 0xffff,
  0x019c, 0xffff,
  0x019d, 0xffff,
  0x019e, 0xffff,
  0x019f, 0xffff,
  0x01a0, 0xffff,
  0x01a1, 0xffff,
  0x01a2, 0xffff,
  0x01a3, 0xffff,
  0x01a4, 0xffff,
  0x01a5, 0xffff,
  0x01a6, 0xffff,
  0x01a7, 0xffff,
  0x01a8, 0xffff,
  0x01a9, 0xffff,
  0x01aa, 0xffff,
  0x01ab, 0xffff,
  0x01ac, 0xffff,
  0x01ad, 0xffff,
  0x01ae, 0xffff,
  0x01af, 0xffff,
  0x01b0, 0xffff,
  0x01b1, 0xffff,
  0x01b2, 0xffff,
  0x01b3, 0xffff,
  0x01b4, 0xffff,
  0x01b5, 0xffff,
  0x01b6, 0xffff,
  0x01b7, 0xffff,
  0x01b8, 0xffff,
  0x01b9, 0xffff,
  0x01ba, 0xffff,
  0x01bb, 0xffff,
  0x01bc, 0xffff,
  0x01bd, 0xffff,
  0x01be, 0xffff,
  0x01bf, 0xffff,
  0xffff, 0xffff,
  0xffff, 0xffff,
  0xffff, 0xffff,
  0xffff, 0xffff,
  0xffff, 0xffff,
  0xffff, 0xffff,
  0xffff, 0xffff,
  0xffff, 0xffff,
  0xffff, 0xffff,
  0xffff, 0xffff,
  0xffff, 0xffff,
  0xffff, 0xffff,
  0xffff, 0xffff,
  0xffff, 0xffff,
  0xffff, 0xffff,
  0xffff, 0xffff,
  0xffff, 0xffff,
  0xffff, 0xffff,
  0xffff, 0xffff,
  0xffff, 0xffff,
  0xffff, 0xffff,
  0xffff, 0xffff,
  0xffff, 0xffff,
  0xffff, 0xffff,
  0xffff, 0xffff,
  0xffff, 0xffff,
  0xffff, 0xffff,
  0xffff, 0xffff,
  0xffff, 0xffff,
  0xffff, 0xffff,
  0xffff, 0xffff,
  0xffff, 0xffff,
  0xffff, 0xffff,
  0xffff, 0xffff,
  0xffff, 0xffff,
  0xffff, 0xffff,
  0xffff, 0xffff,
  0xffff, 0xffff,
  0xffff, 0xffff,
  0xffff, 0xffff,
  0xffff, 0xffff,
  0xffff, 0xffff,
  0xffff, 0xffff,
  0xffff, 0xffff,
  0xffff, 0xffff,
  0xffff, 0xffff,
  0xffff, 0xffff,
  0xffff, 0xffff,
  0xffff, 0xffff,
  0xffff, 0xffff,
  0xffff, 0xffff,
  0xffff, 0xffff,
  0xffff, 0xffff,
  0xffff, 0xffff,
  0xffff, 0xffff,
  0xffff, 0xffff,
  0xffff, 0xffff,
  0xffff, 0xffff,
  0xffff, 0xffff,
  0xffff, 0xffff,
  0xffff, 0xffff,
  0xffff, 0xffff,
  0xffff, 0xffff,
  0xffff, 0xffff };
__device__ const unsigned char T5_BUCKET[128] = { 0, 1, 2, 3, 4, 5, 6, 7, 8, 9, 10, 11, 12, 13, 14, 15, 16, 16, 16, 17, 17, 18, 18, 18, 19, 19, 19, 20, 20, 20, 20, 21, 21, 21, 21, 22, 22, 22, 22, 22, 23, 23, 23, 23, 23, 23, 24, 24, 24, 24, 24, 24, 25, 25, 25, 25, 25, 25, 25, 26, 26, 26, 26, 26, 26, 26, 26, 27, 27, 27, 27, 27, 27, 27, 27, 27, 27, 28, 28, 28, 28, 28, 28, 28, 28, 28, 28, 29, 29, 29, 29, 29, 29, 29, 29, 29, 29, 29, 29, 30, 30, 30, 30, 30, 30, 30, 30, 30, 30, 30, 30, 30, 30, 31, 31, 31, 31, 31, 31, 31, 31, 31, 31, 31, 31, 31, 31, 31 };
struct Args { const float* in[17]; float* out; unsigned char* ws; int step_lo, step_hi, li, pad; };
struct Ctx { LAS unsigned char* lds; int tid, lane, wave, vcu, G; };

#define swz_xor(v, pat) __builtin_bit_cast(float, __builtin_amdgcn_ds_swizzle(__builtin_bit_cast(int, (v)), (pat)))
__device__ __forceinline__ float other_half(float v, int lane) { return __builtin_bit_cast(float, __builtin_amdgcn_ds_bpermute((lane ^ 32) << 2, __builtin_bit_cast(int, v))); }
__device__ __forceinline__ float wave_sum(float v) {
    v += swz_xor(v, 0x041F); v += swz_xor(v, 0x081F); v += swz_xor(v, 0x101F); v += swz_xor(v, 0x201F); v += swz_xor(v, 0x401F);
    return __builtin_bit_cast(float, __builtin_amdgcn_readlane(__builtin_bit_cast(int, v), 0)) + __builtin_bit_cast(float, __builtin_amdgcn_readlane(__builtin_bit_cast(int, v), 32));
}
__device__ __forceinline__ float siluf(float v) { return v / (1.f + __expf(-v)); }
__device__ __forceinline__ float sigmf(float v) { return 1.f / (1.f + __expf(-v)); }

__device__ __forceinline__ void tr_item(const float* W, int ldw, int srccol0, int k0, bf16* WTrow0, int K, LAS float* scr, int lane) {
#pragma unroll 8
    for (int i = 0; i < 32; ++i) { const int kk = 2 * i + (lane >> 5); scr[kk * 33 + (lane & 31)] = W[(size_t)(k0 + kk) * ldw + srccol0 + (lane & 31)]; }
    LDS_WAIT(); asm volatile("" ::: "memory");
    const int c = lane & 7;
#pragma unroll
    for (int j = 0; j < 4; ++j) { const int n = (lane >> 3) + 8 * j; const LAS float* s = scr + (8 * c) * 33 + n;
        v4u o; o.x = pk2(s[0 * 33], s[1 * 33]); o.y = pk2(s[2 * 33], s[3 * 33]); o.z = pk2(s[4 * 33], s[5 * 33]); o.w = pk2(s[6 * 33], s[7 * 33]);
        *(GAS v4u*)(WTrow0 + (size_t)n * K + 8 * c) = o; }
    LDS_WAIT(); asm volatile("" ::: "memory");
}
__device__ __forceinline__ void p0_prologue(const Args& a, const Ctx& C) {
    unsigned char* ws = a.ws;
    LAS float* fl = (LAS float*)C.lds;
    { const float* cvec = a.in[1]; const float* w_ada = a.in[2]; const float* b_ada = a.in[3]; float* mod = (float*)(ws + WS_MOD);
      for (int i = C.tid; i < DM; i += NTHR) fl[i] = siluf(cvec[i]);
      __syncthreads();
      for (int it = C.vcu; it < 384; it += C.G) {
          const int l = it / 96, cb = (it % 96) * 64, col = C.tid & 63, kg = C.tid >> 6;
          const float* w = w_ada + (size_t)l * DM * (3 * DM) + cb + col; float acc = 0.f;
#pragma unroll 8
          for (int k = kg * 256; k < kg * 256 + 256; ++k) acc += fl[k] * w[(size_t)k * (3 * DM)];
          fl[2048 + kg * 64 + col] = acc; __syncthreads();
          if (C.tid < 64) { float s = 0.f;
#pragma unroll
              for (int g = 0; g < 8; ++g) s += fl[2048 + g * 64 + C.tid];
              mod[l * 3 * DM + cb + C.tid] = s + b_ada[l * 3 * DM + cb + C.tid]; }
          __syncthreads(); }
    }
    for (int it = C.vcu; it < 64; it += C.G) {
        const int l = it >> 4, kv = (it >> 3) & 1, kc = it & 7, col = C.tid & 255, kh = C.tid >> 8;
        const float* pe = (kv ? a.in[12] : a.in[9]) + l * 4096; const float* w1 = (kv ? a.in[13] : a.in[10]) + (size_t)l * 4096 * 256 + col; float acc = 0.f;
        const int kb = kc * 512 + kh * 256;
#pragma unroll 8
        for (int k = kb; k < kb + 256; ++k) acc += pe[k] * w1[(size_t)k * 256];
        __syncthreads(); fl[C.tid] = acc; __syncthreads();
        if (C.tid < 256) ((float*)(ws + WS_B1P))[((l * 2 + kv) * 8 + kc) * 256 + C.tid] = fl[C.tid] + fl[C.tid + 256];
    }
    __syncthreads();
    LAS float* scr = (LAS float*)(C.lds + C.wave * 16384);
    const int gw = C.vcu * NWAVES + C.wave, NGW = C.G * NWAVES;
    constexpr int I_WIN = 32 * 256, I_WOUT = 32 * 64, I_W1 = 64 * 8, I_W2 = 4 * 4, I_L = I_WIN + I_WOUT + 2 * I_W1 + 2 * I_W2;
    for (int it = gw; it < DEPTH * I_L; it += NGW) {
        const int l = it / I_L; int r = it % I_L;
        if (r < I_WIN) { const int kb = r >> 8, nb = r & 255, j0 = nb * 32, src = j0 + (j0 < 4352 ? 0 : (j0 < 7424 ? 6 : 24));
            tr_item(a.in[6] + (size_t)l * DM * NIN, NIN, src, kb * 64, (bf16*)(ws + WS_WIN) + ((size_t)l * NBIG + j0) * DM + kb * 64, DM, scr, C.lane); continue; }
        r -= I_WIN;
        if (r < I_WOUT) { const int kb = r >> 6, nb = r & 63;
            tr_item(a.in[15] + (size_t)l * DM * DM, DM, nb * 32, kb * 64, (bf16*)(ws + WS_WOUT) + ((size_t)l * DM + nb * 32) * DM + kb * 64, DM, scr, C.lane); continue; }
        r -= I_WOUT;
        if (r < 2 * I_W1) { const int kv = r / I_W1, q = r % I_W1, kb = q >> 3, nb = q & 7;
            tr_item((kv ? a.in[13] : a.in[10]) + (size_t)l * 4096 * 256, 256, nb * 32, kb * 64, (bf16*)(ws + WS_W1T) + ((size_t)(l * 2 + kv) * 256 + nb * 32) * 4096 + kb * 64, 4096, scr, C.lane); continue; }
        r -= 2 * I_W1;
        { const int kv = r / I_W2, q = r % I_W2, kb = q >> 2, nb = q & 3;
            tr_item((kv ? a.in[14] : a.in[11]) + (size_t)l * 256 * 128, 128, nb * 32, kb * 64, (bf16*)(ws + WS_W2T) + ((size_t)(l * 2 + kv) * 128 + nb * 32) * 256 + kb * 64, 256, scr, C.lane); }
    }
    for (int idx = gw * 64 + C.lane; idx < DEPTH * 32 * DM; idx += NGW * 64) {
        const int l = idx / (32 * DM), n = (idx / DM) & 31, k = idx % DM;
        float v = 0.f; if (n < 24) v = a.in[6][(size_t)l * DM * NIN + (size_t)k * NIN + (n < 6 ? 4352 + n : 7430 + (n - 6))];
        ((bf16*)(ws + WS_WSM))[idx] = (bf16)f2bf(v);
    }
}

__device__ __forceinline__ void rowpass(const Args& a, const Ctx& C, int l) {
    unsigned char* ws = a.ws; const float* mod = (const float*)(ws + WS_MOD);
    const float* xin = (l <= 1) ? a.in[0] : a.out; const float* y2 = (const float*)(ws + WS_Y2);
    const int gw = C.vcu * NWAVES + C.wave, NGW = C.G * NWAVES;
    f32x4 a1[8], a2[8], a3[8];
#pragma unroll
    for (int j = 0; j < 8; ++j) { const int c = 4 * C.lane + 256 * j;
        if (l > 0) { const f32x4 g = *(const f32x4*)(mod + (l - 1) * 3 * DM + 2 * DM + c), p = *(const f32x4*)(a.in[5] + (l - 1) * DM + c); a1[j] = g * p; } else a1[j] = (f32x4){0.f, 0.f, 0.f, 0.f};
        if (l < DEPTH) { const f32x4 p = *(const f32x4*)(a.in[4] + l * DM + c), sc = *(const f32x4*)(mod + l * 3 * DM + DM + c); a2[j] = p * (sc + 1.0f); a3[j] = *(const f32x4*)(mod + l * 3 * DM + c); }
        else { a2[j] = (f32x4){0.f, 0.f, 0.f, 0.f}; a3[j] = a2[j]; } }
    for (int m = gw; m < S; m += NGW) {
        f32x4 x[8];
#pragma unroll
        for (int j = 0; j < 8; ++j) x[j] = *(const f32x4*)(xin + (size_t)m * DM + 4 * C.lane + 256 * j);
        if (l > 0) {
            f32x4 y[8]; float ss = 0.f;
#pragma unroll
            for (int j = 0; j < 8; ++j) { y[j] = *(const f32x4*)(y2 + (size_t)m * DM + 4 * C.lane + 256 * j); ss += (y[j].x * y[j].x + y[j].y * y[j].y) + (y[j].z * y[j].z + y[j].w * y[j].w); }
            const float rs = __builtin_amdgcn_rsqf(wave_sum(ss) * (1.f / DM) + NORM_EPS);
#pragma unroll
            for (int j = 0; j < 8; ++j) { x[j] = x[j] + a1[j] * (y[j] * rs); *(f32x4*)(a.out + (size_t)m * DM + 4 * C.lane + 256 * j) = x[j]; }
        }
        if (l < DEPTH) {
            float ss = 0.f;
#pragma unroll
            for (int j = 0; j < 8; ++j) ss += (x[j].x * x[j].x + x[j].y * x[j].y) + (x[j].z * x[j].z + x[j].w * x[j].w);
            const float rs = __builtin_amdgcn_rsqf(wave_sum(ss) * (1.f / DM) + NORM_EPS);
            bf16* hrow = (bf16*)(ws + WS_H) + (size_t)m * DM;
#pragma unroll
            for (int j = 0; j < 8; ++j) { const f32x4 hv = (x[j] * rs) * a2[j] + a3[j];
                *(unsigned long long*)(hrow + 4 * C.lane + 256 * j) = (unsigned long long)pk2(hv.x, hv.y) | ((unsigned long long)pk2(hv.z, hv.w) << 32); }
        }
    }
}

typedef float f32x4m __attribute__((ext_vector_type(4)));
__device__ __forceinline__ void small_unit(const Args& a, const Ctx& C, int l, int u) {
    const bf16* H = (const bf16*)(a.ws + WS_H); const bf16* W = (const bf16*)(a.ws + WS_WSM) + (size_t)l * 32 * DM; float* out = (float*)(a.ws + WS_SMALL);
    const int mt = C.wave & 3, nt = C.wave >> 2, fr = C.lane & 15, fq = C.lane >> 4, r0 = u * 64 + mt * 16;
    const bf16* ap = H + (size_t)(r0 + fr) * DM + 8 * fq; const bf16* bp = W + (size_t)(nt * 16 + fr) * DM + 8 * fq;
    f32x4 acc = {0.f, 0.f, 0.f, 0.f};
#pragma unroll 8
    for (int k0 = 0; k0 < DM; k0 += 32) { const bf16x8 av = *(const bf16x8*)(ap + k0), bv = *(const bf16x8*)(bp + k0); acc = __builtin_amdgcn_mfma_f32_16x16x32_bf16(av, bv, acc, 0, 0, 0); }
#pragma unroll
    for (int i = 0; i < 4; ++i) out[(size_t)(r0 + 4 * fq + i) * 32 + nt * 16 + fr] = acc[i];
    if (nt == 0 && fr < 6) *(f32x4*)((float*)(a.ws + WS_FT) + (size_t)fr * S + r0 + 4 * fq) = acc;
}
__device__ __forceinline__ void build_t5(char* ldsg, const float* relb, int tid) {
    float* T = (float*)(ldsg + att::LDS_T5);
    for (int i = tid; i < 6 * 129; i += NTHR) { const int h = i / 129, d = i % 129; const float c31 = relb[31 * 6 + h];
        T[h * 132 + d] = (d < 128 ? (relb[(int)T5_BUCKET[d < 128 ? d : 127] * 6 + h] - c31) : c31) * (1.0f / SM_SCALE); }
    __syncthreads();
}
__device__ __forceinline__ att::BlockRef make_ref(unsigned char* ws, int mode, int h, int qb) {
    att::BlockRef r; const att::bf16* P = (const att::bf16*)(ws + WS_ATT); constexpr size_t PL = (size_t)S * 128;
    const int qp = (mode == att::MODE_FOX) ? HP_QF + h : HP_QN + h;
    const int kp = (mode == att::MODE_FOX) ? HP_KF + h : ((mode == att::MODE_WIN) ? HP_KW + h / 3 : HP_KS + h / 3);
    const int vp = (mode == att::MODE_FOX) ? HP_VF + h : ((mode == att::MODE_WIN) ? HP_VW + h / 3 : HP_VS + h / 3);
    r.Q = P + qp * PL + (size_t)qb * 256 * 128; r.K = P + kp * PL; r.V = P + vp * PL;
    r.bias = (mode == att::MODE_FOX) ? (const float*)(ws + WS_BIASF) + (size_t)h * S : nullptr;
    r.P0 = qb * 256; r.W = (mode == att::MODE_WIN) ? 512 : att::WBIG; r.h = h; r.mode = mode; return r;
}
__device__ __forceinline__ att::Aux make_aux(unsigned char* ws) {
    att::Aux X; X.biasF = (const float*)(ws + WS_BIASF); X.selm = (const unsigned*)(ws + WS_SELM); X.small = (const float*)(ws + WS_SMALL);
    X.zf = (const att::bf16*)(ws + WS_ZF); X.zn = (const att::bf16*)(ws + WS_ZN); X.oc = (const att::bf16*)(ws + WS_OC); X.ow = (att::bf16*)(ws + WS_OW); X.y = (att::bf16*)(ws + WS_Y); return X;
}
template <int MODE>
__device__ __forceinline__ void attn_stream(unsigned char* ws, char* ldsg, const unsigned short* list, int tid) {
    int i = 0; unsigned code;
    for (;; ++i) { code = list[i]; if (code == 0xFFFFu) return; if ((int)(code >> 8) == MODE) break; }
    const att::Aux X = make_aux(ws);
    att::BlockRef cur = make_ref(ws, MODE, (code >> 5) & 7, code & 31); att::Seam Sm;
    att::attn_prime(cur, ldsg, Sm, tid);
    for (;;) {
        unsigned nc; for (++i;; ++i) { nc = list[i]; if (nc == 0xFFFFu || (int)(nc >> 8) == MODE) break; }
        const bool last = (nc == 0xFFFFu);
        const att::BlockRef nxt = last ? cur : make_ref(ws, MODE, (nc >> 5) & 7, nc & 31);
        att::attn_block<MODE>(cur, nxt, X, ldsg, Sm, tid);
        if (last) break;
        cur = nxt;
    }
}
__device__ __forceinline__ void conv_phase(const Args& a, const Ctx& C, int l) {
    const bf16* cv = (const bf16*)(a.ws + WS_CONV); bf16* Y = (bf16*)(a.ws + WS_Y); const float* cw = a.in[8] + l * 3 * 512;
    for (int idx = C.vcu * NTHR + C.tid; idx < S * 64; idx += C.G * NTHR) {
        const int s = idx >> 6, c = (idx & 63) * 8; float z[8];
#pragma unroll
        for (int e = 0; e < 8; ++e) z[e] = 0.f;
#pragma unroll
        for (int j = 0; j < 3; ++j) { const int t = s + j - 2; if (t >= 0) { const v4u uu = *(const v4u*)(cv + (size_t)t * 2048 + c), gg = *(const v4u*)(cv + (size_t)t * 2048 + 1024 + c);
#pragma unroll
            for (int e = 0; e < 4; ++e) { const unsigned uw = uu[e], gw = gg[e];
                z[2 * e] += cw[j * 512 + c + 2 * e] * (att::bflo(gw) * att::bflo(uw)); z[2 * e + 1] += cw[j * 512 + c + 2 * e + 1] * (att::bfhi(gw) * att::bfhi(uw)); } } }
        const v4u bb = *(const v4u*)(cv + (size_t)s * 2048 + 512 + c), zz = *(const v4u*)(cv + (size_t)s * 2048 + 1536 + c); v4u o;
#pragma unroll
        for (int e = 0; e < 4; ++e) o[e] = pk2(att::bflo(bb[e]) * z[2 * e] * siluf(att::bflo(zz[e])), att::bfhi(bb[e]) * z[2 * e + 1] * siluf(att::bfhi(zz[e])));
        *(v4u*)(Y + (size_t)s * 2048 + c) = o;
    }
}
__device__ __forceinline__ void mlp_unit(const Args& a, const Ctx& C, int l, int u) {
    unsigned char* ws = a.ws; const int kv = u >> 6, g = (u >> 5) & 1, nb = u & 31, fr = C.lane & 15, fq = C.lane >> 4, w = C.wave;
    const bf16* src = (const bf16*)(ws + WS_ATT) + (size_t)((kv ? HP_VC : HP_KC) + g) * S * 128;
    const bf16* ap = src + (size_t)(16 * (16 * nb + fr)) * 128 + 8 * fq;
    const bf16* w1t = (const bf16*)(ws + WS_W1T) + (size_t)(l * 2 + kv) * 256 * 4096; const bf16* bp = w1t + (size_t)(32 * w + fr) * 4096 + 8 * fq;
    f32x4 acc0 = {0.f, 0.f, 0.f, 0.f}, acc1 = acc0;
#pragma unroll 4
    for (int k0 = 0; k0 < 4096; k0 += 32) { const bf16x8 av = *(const bf16x8*)(ap + k0), b0 = *(const bf16x8*)(bp + k0), b1 = *(const bf16x8*)(bp + (size_t)16 * 4096 + k0);
        acc0 = __builtin_amdgcn_mfma_f32_16x16x32_bf16(av, b0, acc0, 0, 0, 0); acc1 = __builtin_amdgcn_mfma_f32_16x16x32_bf16(av, b1, acc1, 0, 0, 0); }
    const float* b1p = (const float*)(ws + WS_B1P) + (size_t)(l * 2 + kv) * 8 * 256; float bs0 = 0.f, bs1 = 0.f;
#pragma unroll
    for (int cchunk = 0; cchunk < 8; ++cchunk) { bs0 += b1p[cchunk * 256 + 32 * w + fr]; bs1 += b1p[cchunk * 256 + 32 * w + 16 + fr]; }
    LAS bf16* hid = (LAS bf16*)(C.lds);
    __syncthreads();
#pragma unroll
    for (int i = 0; i < 4; ++i) { hid[(4 * fq + i) * 264 + 32 * w + fr] = (bf16)f2bf(siluf(acc0[i] + bs0)); hid[(4 * fq + i) * 264 + 32 * w + 16 + fr] = (bf16)f2bf(siluf(acc1[i] + bs1)); }
    __syncthreads();
    const bf16* w2t = (const bf16*)(ws + WS_W2T) + (size_t)(l * 2 + kv) * 128 * 256 + (size_t)(16 * w + fr) * 256 + 8 * fq;
    f32x4 acc = {0.f, 0.f, 0.f, 0.f};
#pragma unroll
    for (int k0 = 0; k0 < 256; k0 += 32) { const bf16x8 av = *(const LAS bf16x8*)(hid + fr * 264 + k0 + 8 * fq), bv = *(const bf16x8*)(w2t + k0); acc = __builtin_amdgcn_mfma_f32_16x16x32_bf16(av, bv, acc, 0, 0, 0); }
    if (kv == 0) { bf16* kc = (bf16*)(ws + WS_KCMP) + (size_t)g * 512 * 128;
#pragma unroll
        for (int i = 0; i < 4; ++i) kc[(size_t)(16 * nb + 4 * fq + i) * 128 + 16 * w + fr] = (bf16)f2bf(acc[i]); }
    else { bf16* vt = (bf16*)(ws + WS_VCMPT) + (size_t)g * 128 * 512 + (size_t)(16 * w + fr) * 512 + 16 * nb + 4 * fq;
        *(unsigned long long*)vt = (unsigned long long)pk2(acc[0], acc[1]) | ((unsigned long long)pk2(acc[2], acc[3]) << 32); }
    __syncthreads();
}
__device__ __forceinline__ float logsig(float v) { const float e = __builtin_amdgcn_exp2f(-fabsf(v) * 1.4426950408889634f); return fminf(v, 0.f) - __builtin_amdgcn_logf(1.f + e) * 0.6931471805599453f; }
__device__ __forceinline__ void scan_head(const Args& a, int l, int h, int lane_in) {
    int lane = lane_in; asm volatile("" : "+v"(lane));
    const f32x4* src = (const f32x4*)((const float*)(a.ws + WS_FT) + (size_t)h * S + lane * 128); f32x4* out = (f32x4*)((float*)(a.ws + WS_BIASF) + (size_t)h * S + lane * 128); const float b = a.in[7][l * 6 + h];
    float loc = 0.f;
    for (int c = 0; c < 8; ++c) { f32x4 v[4];
#pragma unroll
        for (int i = 0; i < 4; ++i) v[i] = src[c * 4 + i];
#pragma unroll
        for (int i = 0; i < 4; ++i) loc += (logsig(v[i].x + b) + logsig(v[i].y + b)) + (logsig(v[i].z + b) + logsig(v[i].w + b)); }
    float inc = loc;
#pragma unroll
    for (int o = 1; o < 64; o <<= 1) { const int sl = lane >= o ? lane - o : lane; const float t = __builtin_bit_cast(float, __builtin_amdgcn_ds_bpermute(sl << 2, __builtin_bit_cast(int, inc))); if (lane >= o) inc += t; }
    float run = inc - loc;
    for (int c = 0; c < 8; ++c) { f32x4 v[4];
#pragma unroll
        for (int i = 0; i < 4; ++i) v[i] = src[c * 4 + i];
#pragma unroll
        for (int i = 0; i < 4; ++i) { f32x4 o4; run += logsig(v[i].x + b); o4.x = -run * (1.0f / SM_SCALE); run += logsig(v[i].y + b); o4.y = -run * (1.0f / SM_SCALE);
            run += logsig(v[i].z + b); o4.z = -run * (1.0f / SM_SCALE); run += logsig(v[i].w + b); o4.w = -run * (1.0f / SM_SCALE); out[c * 4 + i] = o4; } }
}
typedef float f32x16 __attribute__((ext_vector_type(16)));
__device__ __forceinline__ void cmp_head(const Args& a, int g, int r, int qt, LAS float* impw, const LAS float* T5, int lane_in) {
    int lane = lane_in; asm volatile("" : "+v"(lane));
    unsigned char* ws = a.ws; const int r32 = lane & 31, hi = lane >> 5, q = 32 * qt + r32, ntile = qt / 16 + 1;
    constexpr float C2 = 1.4426950408889634f * SM_SCALE; const float NEG = -__builtin_inff();
    for (int i = lane; i < 32 * 130; i += 64) impw[i] = 0.f;
    asm volatile("s_waitcnt lgkmcnt(0)" ::: "memory");
    const bf16* kc = (const bf16*)(ws + WS_KCMP) + (size_t)g * 512 * 128 + (size_t)r32 * 128 + 8 * hi; const bf16* vt = (const bf16*)(ws + WS_VCMPT) + (size_t)g * 128 * 512 + (size_t)r32 * 512 + 4 * hi;
    const int h = 3 * g + r; const LAS float* Td = T5 + h * 132; const float c31 = Td[128];
    const bf16* qp = (const bf16*)(ws + WS_ATT) + (size_t)(HP_QN + h) * S * 128 + (size_t)q * 128 + 8 * hi;
    bf16x8 qr[8];
#pragma unroll
    for (int d0 = 0; d0 < 8; ++d0) qr[d0] = *(const bf16x8*)(qp + d0 * 16);
    bf16x8 kA[8], kB[8];
#define KLOAD(kf, jt) do { const int jc_ = (jt) < ntile ? (jt) : ntile - 1; const bf16* kp_ = kc + (size_t)(32 * jc_) * 128;  \
        _Pragma("unroll") for (int d0 = 0; d0 < 8; ++d0) kf[d0] = *(const bf16x8*)(kp_ + d0 * 16); } while (0)
#define CMP_SCORES(sc, kf, jt) do { _Pragma("unroll") for (int e = 0; e < 16; ++e) sc[e] = c31;                                     \
        _Pragma("unroll") for (int d0 = 0; d0 < 8; ++d0) sc = __builtin_amdgcn_mfma_f32_32x32x16_bf16(kf[d0], qr[d0], sc, 0, 0, 0);  \
        if (512 * (jt) + 527 + 113 > 32 * qt) {              \
            _Pragma("unroll") for (int e = 0; e < 16; ++e) { const int n_ = 32 * (jt) + att::crow(e, hi), dist_ = q - 16 * n_ - 31;  \
                const float tv_ = Td[dist_ < 0 ? 0 : (dist_ > 127 ? 127 : dist_)]; sc[e] = dist_ < 0 ? NEG : sc[e] + tv_; } } } while (0)
    float m = -1e30f, lsum = 0.f;
#define PASS1(kf, jt) do { f32x16 sc; CMP_SCORES(sc, kf, jt); float mx = sc[0];                                                      \
        _Pragma("unroll") for (int e = 1; e < 16; ++e) mx = fmaxf(mx, sc[e]);                                                        \
        const float mn = fmaxf(m, mx); float ps = 0.f;                                                                               \
        _Pragma("unroll") for (int e = 0; e < 16; ++e) ps += __builtin_amdgcn_exp2f((sc[e] - mn) * C2);                              \
        lsum = lsum * __builtin_amdgcn_exp2f((m - mn) * C2) + ps; m = mn; } while (0)
    KLOAD(kA, 0);
    for (int jt = 0; jt < ntile; jt += 2) { KLOAD(kB, jt + 1); PASS1(kA, jt); KLOAD(kA, jt + 2); if (jt + 1 < ntile) PASS1(kB, jt + 1); }
    { const float mo = other_half(m, lane), lo = other_half(lsum, lane); const float M = fmaxf(m, mo);
      lsum = lsum * __builtin_amdgcn_exp2f((m - M) * C2) + lo * __builtin_amdgcn_exp2f((mo - M) * C2); m = M; }
    const float inv = lsum > 0.f ? 1.f / lsum : 0.f;
    f32x16 oT[4];
#pragma unroll
    for (int d = 0; d < 4; ++d)
#pragma unroll
        for (int e = 0; e < 16; ++e) oT[d][e] = 0.f;
#define PASS2(kf, jt) do { f32x16 sc; CMP_SCORES(sc, kf, jt);                                                                        \
        unsigned long long vlo[4], vhh[4];                                                                                           \
        _Pragma("unroll") for (int d = 0; d < 2; ++d) _Pragma("unroll") for (int s2 = 0; s2 < 2; ++s2) { const bf16* vp = vt + (size_t)(32 * d) * 512 + 32 * (jt) + 16 * s2; \
            vlo[d * 2 + s2] = *(const unsigned long long*)vp; vhh[d * 2 + s2] = *(const unsigned long long*)(vp + 8); }              \
        _Pragma("unroll") for (int e = 0; e < 16; ++e) sc[e] = __builtin_amdgcn_exp2f((sc[e] - m) * C2) * inv;                        \
        asm volatile("" ::: "memory");                                                                                               \
        _Pragma("unroll") for (int c = 0; c < 4; ++c) { LAS float* ip = impw + r32 * 130 + 8 * (jt) + 2 * c + hi; ip[0] += (sc[4 * c] + sc[4 * c + 1]) + (sc[4 * c + 2] + sc[4 * c + 3]); } \
        asm volatile("s_waitcnt lgkmcnt(0)" ::: "memory");                                                                           \
        _Pragma("unroll") for (int c = 0; c < 4; ++c) { LAS float* ip = impw + r32 * 130 + 8 * (jt) + 2 * c + hi + 1; ip[0] += sc[4 * c + 3]; } \
        asm volatile("s_waitcnt lgkmcnt(0)" ::: "memory");                                                                           \
        bf16x8 pb[2];                                                                                                                \
        _Pragma("unroll") for (int s2 = 0; s2 < 2; ++s2) { att::u32x4 wv = {att::cvtpk(sc[8 * s2], sc[8 * s2 + 1]), att::cvtpk(sc[8 * s2 + 2], sc[8 * s2 + 3]), att::cvtpk(sc[8 * s2 + 4], sc[8 * s2 + 5]), att::cvtpk(sc[8 * s2 + 6], sc[8 * s2 + 7])}; pb[s2] = *reinterpret_cast<bf16x8*>(&wv); } \
        _Pragma("unroll") for (int dh = 0; dh < 2; ++dh) {                                                                           \
            _Pragma("unroll") for (int d2 = 0; d2 < 2; ++d2) _Pragma("unroll") for (int s2 = 0; s2 < 2; ++s2) { const int d = 2 * dh + d2;  \
                att::u32x4 av = {(unsigned)vlo[d2 * 2 + s2], (unsigned)(vlo[d2 * 2 + s2] >> 32), (unsigned)vhh[d2 * 2 + s2], (unsigned)(vhh[d2 * 2 + s2] >> 32)}; \
                oT[d] = __builtin_amdgcn_mfma_f32_32x32x16_bf16(*reinterpret_cast<bf16x8*>(&av), pb[s2], oT[d], 0, 0, 0); }          \
            if (dh == 0) { _Pragma("unroll") for (int d2 = 0; d2 < 2; ++d2) _Pragma("unroll") for (int s2 = 0; s2 < 2; ++s2) { const bf16* vp = vt + (size_t)(32 * (2 + d2)) * 512 + 32 * (jt) + 16 * s2; \
                vlo[d2 * 2 + s2] = *(const unsigned long long*)vp; vhh[d2 * 2 + s2] = *(const unsigned long long*)(vp + 8); } } } } while (0)
    KLOAD(kA, 0);
    for (int jt = 0; jt < ntile; jt += 2) { KLOAD(kB, jt + 1); PASS2(kA, jt); KLOAD(kA, jt + 2); if (jt + 1 < ntile) PASS2(kB, jt + 1); }
#undef PASS2
#undef PASS1
#undef CMP_SCORES
#undef KLOAD
    const float gc = sigmf(((const float*)(ws + WS_SMALL))[(size_t)q * 32 + 6 + 3 * h]);
    bf16* op = (bf16*)(ws + WS_OC) + ((size_t)h * S + q) * 128;
#pragma unroll
    for (int d = 0; d < 4; ++d)
#pragma unroll
        for (int c = 0; c < 4; ++c) *(unsigned long long*)(op + 32 * d + 8 * c + 4 * hi) =
            (unsigned long long)pk2(oT[d][4 * c] * gc, oT[d][4 * c + 1] * gc) | ((unsigned long long)pk2(oT[d][4 * c + 2] * gc, oT[d][4 * c + 3] * gc) << 32);
    asm volatile("s_waitcnt lgkmcnt(0)" ::: "memory");
}
__device__ __forceinline__ void cmp_topk(const Args& a, int g, int qt, const LAS float* imp3, int lane_in) {
    int lane = lane_in; asm volatile("" : "+v"(lane));
    const int r32 = lane & 31, hi = lane >> 5, q = 32 * qt + r32;
    const int own = q >> 6; float t[13];
#pragma unroll
    for (int i = 0; i < 13; ++i) t[i] = -1.f;
    const LAS float* ip = imp3 + r32 * 130 + 64 * hi;
    for (int j = 0; j < 64; ++j) { const int Mi = 64 * hi + j; float x = (ip[j] + ip[j + 4160]) + ip[j + 8320];
        if (Mi > own || Mi == 0 || Mi == own || Mi == own - 1) x = -1.f;
#pragma unroll
        for (int i = 0; i < 13; ++i) { const float hv = fmaxf(t[i], x); x = fminf(t[i], x); t[i] = hv; } }
    float thr = fmaxf(other_half(t[12], lane), t[12]);
#pragma unroll
    for (int i = 1; i < 13; ++i) thr = fmaxf(thr, fminf(t[i - 1], other_half(t[12 - i], lane)));
    if (own < 16) thr = -1.f;
    unsigned w0 = 0u, w1 = 0u;
    for (int j = 0; j < 64; ++j) { const int Mi = 64 * hi + j; const float x = (ip[j] + ip[j + 4160]) + ip[j + 8320];
        const bool elig = Mi <= own, forced = (Mi == 0) || (Mi == own) || (Mi == own - 1);
        const unsigned bit = (elig && (forced || x >= thr)) ? 1u : 0u;
        if (j < 32) w0 |= bit << j; else w1 |= bit << (j - 32); }
    unsigned* sm = (unsigned*)(a.ws + WS_SELM) + ((size_t)g * S + q) * 4 + 2 * hi;
    *(unsigned long long*)sm = (unsigned long long)w0 | ((unsigned long long)w1 << 32);
}
__global__ void __launch_bounds__(NTHR, 2) skel_fwd(Args a_) {
    extern __shared__ __attribute__((aligned(16))) unsigned char lds_[];
    char* ldsg = (char*)lds_;
    Ctx C; C.lds = (LAS unsigned char*)lds_; C.tid = threadIdx.x; C.lane = C.tid & 63; C.wave = __builtin_amdgcn_readfirstlane((int)threadIdx.x >> 6);
    C.G = gridDim.x; { const int bx = blockIdx.x; C.vcu = (C.G % 8 == 0) ? (bx % 8) * (C.G / 8) + bx / 8 : bx; }
    for (int u = threadIdx.x; u < (LDS_BYTES - LDSCTL_OFF) / 4; u += NTHR) ((LAS unsigned*)(C.lds + LDSCTL_OFF))[u] = 0u;
    __syncthreads();
    XcdBarrier bar = xcd_barrier_post((unsigned*)(a_.ws + WS_CTL) + CW_BAR + a_.li * XCD_BAR_WORDS, (volatile LAS unsigned*)(C.lds + MISC_OFF) + 8);
    const int step_hi = a_.step_hi; int rep_done = -1;
    for (int st = a_.step_lo; st < step_hi; ++st) {
        { int l_; asm volatile("v_mbcnt_lo_u32_b32 %0, -1, 0\n\tv_mbcnt_hi_u32_b32 %0, -1, %0" : "=v"(l_)); C.lane = l_; C.tid = C.wave * 64 + l_; }
        const Args& a = a_;
        unsigned char* ws = a.ws;
        if (st == 0) p0_prologue(a, C);
        else if (st == 1) rowpass(a, C, 0);
        else {
            const int l = (st - 2) / NPH, ph = (st - 2) % NPH;
            if (ph == 0) {
                pg8::Gemm g{(const pg8::bf16_t*)(ws + WS_H), (const pg8::bf16_t*)(ws + WS_WIN) + (size_t)l * NBIG * DM, S, NBIG, DM};
                pg8::StaticOrder So; So.init(S, NBIG, C.G, (int)blockIdx.x);
                pg8::EpiProj E{(pg8::bf16_t*)(ws + WS_CONV), (pg8::bf16_t*)(ws + WS_ZF), (pg8::bf16_t*)(ws + WS_ZN), (pg8::bf16_t*)(ws + WS_ATT)};
                pg8::gemm_phase<pg8::EpiProj, pg8::StaticOrder, true, true>(C.lds, g, So, E, C.tid);
                for (int u = C.vcu; u < 128; u += C.G) small_unit(a, C, l, u);
            } else if (ph == 1) {
                build_t5(ldsg, a.in[16], C.tid);
                if (C.vcu < 256) attn_stream<att::MODE_WIN>(ws, ldsg, SCHED_B + C.vcu * 2, C.tid);
                for (int it = (C.vcu + 64) & 255; it < 128; it += C.G) mlp_unit(a, C, l, it);
                conv_phase(a, C, l);
#if STEP_LEVEL >= 3
            } else if (ph == 2) {
                build_t5(ldsg, a.in[16], C.tid);
                for (int ub = C.vcu; ub < 256; ub += C.G) {
                    if (C.wave < 6) { const int g = C.wave >= 3 ? 1 : 0, r = C.wave - 3 * g, qt = g ? 255 - ub : ub;
                        cmp_head(a, g, r, qt, (LAS float*)(C.lds) + C.wave * 4160, (const LAS float*)(C.lds + att::LDS_T5), C.lane); }
                    __syncthreads();
                    if (C.wave == 0 || C.wave == 3) { const int g = C.wave == 3 ? 1 : 0, qt = g ? 255 - ub : ub; cmp_topk(a, g, qt, (const LAS float*)(C.lds) + C.wave * 4160, C.lane); }
                    __syncthreads();
                }
                if (C.wave == 6 && C.vcu < 6) scan_head(a, l, C.vcu, C.lane);
#endif
#if STEP_LEVEL >= 4
            } else if (ph == 3) {
                build_t5(ldsg, a.in[16], C.tid);
                if (C.vcu < 256) { attn_stream<att::MODE_FOX>(ws, ldsg, SCHED_D + C.vcu * SCHED_D_LEN, C.tid); attn_stream<att::MODE_SLC>(ws, ldsg, SCHED_D + C.vcu * SCHED_D_LEN, C.tid); }
#endif
            } else if (ph == 4) {
                pg8::Gemm g{(const pg8::bf16_t*)(ws + WS_Y), (const pg8::bf16_t*)(ws + WS_WOUT) + (size_t)l * DM * DM, S, DM, DM};
                pg8::StaticOrder So; So.init(S, DM, C.G, (int)blockIdx.x);
                pg8::EpiF32 E{(float*)(ws + WS_Y2), DM};
                pg8::gemm_phase<pg8::EpiF32, pg8::StaticOrder, true, true>(C.lds, g, So, E, C.tid);
            } else if (ph == 5) {
                rowpass(a, C, l + 1);
            }
        }
        if (st + 1 < step_hi) xcd_barrier(bar);
        if (((st >= 2 && (st - 2) % NPH == a_.pad) || (st < 2 && st + 100 == a_.pad)) && rep_done != st) { rep_done = st; --st; }
    }
}
#ifndef PROBE_PH
#define PROBE_PH (-1)
#endif
#ifndef ONE_LAUNCH
#define ONE_LAUNCH 1
#endif
static void launch_steps(const Args& base, int lo, int hi, int li, int grid, hipStream_t stream) {
    Args a = base; a.step_lo = lo; a.step_hi = hi; a.li = li;
    hipLaunchKernelGGL(skel_fwd, dim3(grid), dim3(NTHR), LDS_BYTES, stream, a);
}
extern "C" void kernel_launch(void* const* d_in, const int* in_sizes, int n_in, void* d_out, int out_size, void* d_ws, size_t ws_size, hipStream_t stream) {
    static int grid = 0;
    if (grid == 0) {
        int dev = 0, cus = 0, per_cu = 0;
        hipGetDevice(&dev); hipDeviceGetAttribute(&cus, hipDeviceAttributeMultiprocessorCount, dev);
        hipFuncSetAttribute((const void*)skel_fwd, hipFuncAttributeMaxDynamicSharedMemorySize, LDS_BYTES);
        hipOccupancyMaxActiveBlocksPerMultiprocessor(&per_cu, (const void*)skel_fwd, NTHR, LDS_BYTES);
        (void)hipGetLastError();
        if (per_cu < 1) fprintf(stderr, "kernel_launch: occupancy query says %d blocks/CU\n", per_cu);
        grid = cus;
        if (grid != 256) fprintf(stderr, "kernel_launch: built for 256 CUs, found %d\n", cus);
    }
    hipMemsetAsync((char*)d_ws + WS_CTL, 0, CTL_ZERO_BYTES, stream);
    Args a{}; for (int i = 0; i < 17; ++i) a.in[i] = (const float*)d_in[i];
    a.out = (float*)d_out; a.ws = (unsigned char*)d_ws; a.pad = PROBE_PH;
#if ONE_LAUNCH
    launch_steps(a, 0, NSTEPS, 1, grid, stream);
#else
    launch_steps(a, 0, 2, 1, grid, stream);
    for (int st = 2; st < NSTEPS; ++st) launch_steps(a, st, st + 1, 0, grid, stream);
#endif
}
```

```cpp
#include <hip/hip_runtime.h>
#include <hip/hip_bf16.h>
#include <cstdio>
#include <cstdint>
#include <cmath>
#ifndef STEP_LEVEL
#define STEP_LEVEL 4
#endif
#ifndef DBG_NAIVE_SEL
#define DBG_NAIVE_SEL 0
#endif
#ifndef PROBE_FOX_ONLY
#define PROBE_FOX_ONLY 0
#endif
namespace pg8 {
#define PG8_LAS __attribute__((address_space(3)))
typedef unsigned short bf16_t;
typedef short bf16x8 __attribute__((ext_vector_type(8)));
typedef float f32x4 __attribute__((ext_vector_type(4)));
typedef unsigned u32x4 __attribute__((ext_vector_type(4)));
constexpr int BM = 256, BK = 64, HALF = 128, HTB = HALF * BK * 2  , STAGE_BYTES = 8 * HTB, NXCD = 8, WGM = 8;

__host__ __device__ __forceinline__ int lds_byte(int r, int c) { const int st = (r >> 4) * 2 + (c >> 5), rr = r & 15, cc = c & 31, ob = rr * 64 + cc * 2; return st * 1024 + (ob ^ (((ob >> 9) & 1) << 5)); }
__host__ __device__ __forceinline__ void stage_rc(int b, int& R, int& C) { const int st = b / 1024, sb = b % 1024, swz = sb ^ (((sb >> 9) & 1) << 5); R = (st >> 1) * 16 + swz / 64; C = (st & 1) * 32 + (swz % 64) / 2; }
__host__ __device__ __forceinline__ int perm32(int rho) { const int n = rho >> 4, i = rho & 15; return 8 * (i >> 2) + 4 * n + (i & 3); }

struct Unit { int pm, pn; };
struct Gemm { const bf16_t* A; const bf16_t* Bt; int M, N, K; };

struct StaticOrder {
    int nM, nN, nwg, G, c;
    __host__ __device__ void init(int M, int N, int G_, int c_) { nM = M / BM; nN = N / BM; nwg = nM * nN; G = G_; c = c_; }
    __host__ __device__ bool next(int i, Unit& u) const {
        const long L = (long)i * G + c; if (L >= nwg) return false;
        int wgid = (int)L; { const int q = nwg / NXCD, r = nwg % NXCD, xcd = wgid % NXCD, off = wgid / NXCD; wgid = (xcd < r ? xcd * (q + 1) : r * (q + 1) + (xcd - r) * q) + off; }
        const int nig = WGM * nN, gid = wgid / nig, fm = gid * WGM, gsz = (nM - fm) < WGM ? (nM - fm) : WGM;
        u.pm = fm + ((wgid % nig) % gsz); u.pn = (wgid % nig) / gsz; return true;
    }
    __device__ __forceinline__ void a_ready(const Unit&) const {}
    __device__ __forceinline__ void done(const Unit&) const {}
};

__device__ __forceinline__ unsigned cvt_pk_bf16(float lo, float hi) { unsigned r; asm volatile("v_cvt_pk_bf16_f32 %0, %1, %2" : "=v"(r) : "v"(lo), "v"(hi)); return r; }
typedef float f32x2 __attribute__((ext_vector_type(2)));
__device__ __forceinline__ f32x2 gelu_pk(f32x2 v) {
    const f32x2 av = __builtin_elementwise_abs(v), d = av * 0.2316418882f + 1.0f;
    f32x2 t; t.x = __builtin_amdgcn_rcpf(d.x); t.y = __builtin_amdgcn_rcpf(d.y);
    f32x2 q = t * 0.5307027145f + (-0.7265760135f); q = q * t + 0.7107068705f; q = q * t + (-0.142248368f); q = q * t + 0.127414796f; q = q * t;
    const f32x2 s = (v * v) * (-0.72134752044f);
    f32x2 e; e.x = __builtin_amdgcn_exp2f(s.x); e.y = __builtin_amdgcn_exp2f(s.y);
    const f32x2 m = v * (q * e), r = v - m;
    f32x2 o; o.x = v.x < 0.f ? m.x : r.x; o.y = v.y < 0.f ? m.y : r.y; return o;
}

template <int ACT  > struct EpiBf16 {
    static constexpr bool PERM = true, AFTER_DRAIN = false; static_assert(ACT == 0 || ACT == 1, "EpiBf16: ACT is 0 (none) or 1 (gelu_pk)");
    bf16_t* O; int ldc; const float* bias; int split_cols; size_t split_stride; float scale0;
    __device__ __forceinline__ void operator()(const f32x4 (&acc)[2][2][4][2], const Unit& u, int wr, int wc, int fr, int fq) const {
        const int row0 = u.pm * BM + wr * 64 + fr; int colt = u.pn * BM; bf16_t* base = O;
        float sc = 1.f; if (split_cols) { const int t = colt / split_cols; base += (size_t)t * split_stride; colt -= t * split_cols; if (t == 0) sc = scale0; }
        const int col0 = colt + wc * 32 + 8 * fq, bcol0 = u.pn * BM + wc * 32 + 8 * fq;
        f32x4 bv[2][2];
#pragma unroll
        for (int bj = 0; bj < 2; ++bj)
#pragma unroll
            for (int n = 0; n < 2; ++n) bv[bj][n] = bias ? *(const f32x4*)(bias + bcol0 + bj * HALF + 4 * n) : (f32x4){0.f, 0.f, 0.f, 0.f};
#pragma unroll
        for (int ai = 0; ai < 2; ++ai)
#pragma unroll
            for (int m = 0; m < 4; ++m) { bf16_t* rowp = base + (size_t)(row0 + ai * HALF + m * 16) * ldc + col0;
#pragma unroll
                for (int bj = 0; bj < 2; ++bj) { f32x4 v0 = acc[ai][bj][m][0] + bv[bj][0], v1 = acc[ai][bj][m][1] + bv[bj][1];
                    if (ACT == 1) { f32x2 a = gelu_pk((f32x2){v0[0], v0[1]}), b = gelu_pk((f32x2){v0[2], v0[3]}), c = gelu_pk((f32x2){v1[0], v1[1]}), d = gelu_pk((f32x2){v1[2], v1[3]});
                        v0 = (f32x4){a.x, a.y, b.x, b.y}; v1 = (f32x4){c.x, c.y, d.x, d.y}; }
                    v0 = v0 * sc; v1 = v1 * sc; u32x4 w; w.x = cvt_pk_bf16(v0[0], v0[1]); w.y = cvt_pk_bf16(v0[2], v0[3]); w.z = cvt_pk_bf16(v1[0], v1[1]); w.w = cvt_pk_bf16(v1[2], v1[3]);
                    *(u32x4*)(rowp + bj * HALF) = w; } }
    }
};
struct EpiProj {
    static constexpr bool PERM = true, AFTER_DRAIN = false;
    bf16_t* conv; bf16_t* zf; bf16_t* zn; bf16_t* att;
    __device__ __forceinline__ void operator()(const f32x4 (&acc)[2][2][4][2], const Unit& u, int wr, int wc, int fr, int fq) const {
        const int pn = u.pn; bf16_t* base; int ld; size_t hs; constexpr size_t HS = (size_t)8192 * 128;
        if (pn < 8) { base = conv + pn * 256; ld = 2048; hs = 128; }
        else if (pn < 17) { base = att + (size_t)((pn - 8) * 2) * HS; ld = 128; hs = HS; }
        else if (pn < 20) { base = zf + (pn - 17) * 256; ld = 768; hs = 128; }
        else if (pn < 29) { base = att + (size_t)(18 + (pn - 20) * 2) * HS; ld = 128; hs = HS; }
        else { base = zn + (pn - 29) * 256; ld = 768; hs = 128; }
        const int row0 = u.pm * BM + wr * 64 + fr, col0 = wc * 32 + 8 * fq;
#pragma unroll
        for (int ai = 0; ai < 2; ++ai)
#pragma unroll
            for (int m = 0; m < 4; ++m) { bf16_t* rowp = base + (size_t)(row0 + ai * HALF + m * 16) * ld + col0;
#pragma unroll
                for (int bj = 0; bj < 2; ++bj) { const f32x4 v0 = acc[ai][bj][m][0], v1 = acc[ai][bj][m][1];
                    u32x4 w; w.x = cvt_pk_bf16(v0[0], v0[1]); w.y = cvt_pk_bf16(v0[2], v0[3]); w.z = cvt_pk_bf16(v1[0], v1[1]); w.w = cvt_pk_bf16(v1[2], v1[3]);
                    *(u32x4*)(rowp + (size_t)bj * hs) = w; } }
    }
};
struct EpiF32 {
    static constexpr bool PERM = false, AFTER_DRAIN = false;
    float* O; int ldc;
    __device__ __forceinline__ void operator()(const f32x4 (&acc)[2][2][4][2], const Unit& u, int wr, int wc, int fr, int fq) const {
        const int row0 = u.pm * BM + wr * 64 + fr, col0 = u.pn * BM + wc * 32 + 4 * fq;
#pragma unroll
        for (int ai = 0; ai < 2; ++ai)
#pragma unroll
            for (int m = 0; m < 4; ++m) { float* rowp = O + (size_t)(row0 + ai * HALF + m * 16) * ldc + col0;
#pragma unroll
                for (int bj = 0; bj < 2; ++bj)
#pragma unroll
                    for (int n = 0; n < 2; ++n) *(f32x4*)(rowp + bj * HALF + n * 16) = acc[ai][bj][m][n]; }
    }
};
template <class Epi, class Sched, bool ALIGN_EPI = false, bool SP2 = false>
__device__ __forceinline__ void gemm_phase(PG8_LAS unsigned char* lds, const Gemm g, const Sched& S, const Epi& E, const int tid) {
    const int wid = __builtin_amdgcn_readfirstlane(tid >> 6), lane = tid & 63, wr = wid >> 2, wc = wid & 3, fr = lane & 15, fq = lane >> 4;
    const int K = g.K, nt = K / BK;
    unsigned voffA[2], voffB[2];
#pragma unroll
    for (int i = 0; i < 2; ++i) { int R, C; stage_rc(tid * 16 + i * 8192, R, C); const int Rb = Epi::PERM ? ((R & ~31) + perm32(R & 31)) : R;
        voffA[i] = (unsigned)(R * K + C) * 2u; voffB[i] = (unsigned)(Rb * K + C) * 2u; }
    const size_t kstep = (size_t)(BK * 2);
    const size_t hstep = (size_t)HALF * K * 2;
    const size_t tstep = 2 * hstep;
    const unsigned ldsw = (unsigned)wid * 1024u;
    const int aoff = lds_byte(wr * 64 + fr, fq * 8), boff = lds_byte(wc * 32 + fr, fq * 8);
#define PG8_SA(b, h) (((b) * 2 + (h)) * HTB)
#define PG8_SB(b, h) ((4 + (b) * 2 + (h)) * HTB)
#define PG8_STAGE(bufoff, gbase, voff) do { _Pragma("unroll") for (int _i = 0; _i < 2; ++_i) \
        __builtin_amdgcn_global_load_lds((const unsigned*)((const char*)(gbase) + (voff)[_i]), (PG8_LAS unsigned*)(lds + (bufoff) + ldsw + _i * 8192), 16, 0, 0); } while (0)
#define PG8_LDA(dst, b, h) do { _Pragma("unroll") for (int m = 0; m < 4; ++m) _Pragma("unroll") for (int k = 0; k < 2; ++k) dst[m][k] = *(const PG8_LAS bf16x8*)(lds + PG8_SA(b, h) + aoff + m * 2048 + k * 1024); } while (0)
#define PG8_LDB(dst, b, h) do { _Pragma("unroll") for (int n = 0; n < 2; ++n) _Pragma("unroll") for (int k = 0; k < 2; ++k) dst[n][k] = *(const PG8_LAS bf16x8*)(lds + PG8_SB(b, h) + boff + n * 2048 + k * 1024); } while (0)
#define PG8_MMA(ai, bj, At, Bt) do { __builtin_amdgcn_s_setprio(1); _Pragma("unroll") for (int m = 0; m < 4; ++m) _Pragma("unroll") for (int n = 0; n < 2; ++n) _Pragma("unroll") for (int k = 0; k < 2; ++k) \
        acc[ai][bj][m][n] = __builtin_amdgcn_mfma_f32_16x16x32_bf16(Bt[n][k], At[m][k], acc[ai][bj][m][n], 0, 0, 0); __builtin_amdgcn_s_setprio(0); } while (0)
#define PG8_WAIT_V(n) asm volatile("s_waitcnt vmcnt(" #n ")" ::: "memory")
#define PG8_WAIT_L(n) asm volatile("s_waitcnt lgkmcnt(" #n ")" ::: "memory")
#define PG8_BAR __builtin_amdgcn_s_barrier()
#define PG8_SCHED __builtin_amdgcn_sched_barrier(0)
    Unit cur, nxt; int ui = 0;
    if (!S.next(0, cur)) return;
    f32x4 acc[2][2][4][2];
#pragma unroll
    for (int a = 0; a < 2; ++a)
#pragma unroll
        for (int b = 0; b < 2; ++b)
#pragma unroll
            for (int m = 0; m < 4; ++m)
#pragma unroll
                for (int n = 0; n < 2; ++n) acc[a][b][m][n] = (f32x4){0.f, 0.f, 0.f, 0.f};
    bf16x8 At[4][2], B0[2][2], B1[2][2];
    const char* cA = (const char*)g.A + (size_t)cur.pm * tstep; const char* cB = (const char*)g.Bt + (size_t)cur.pn * tstep;
    S.a_ready(cur);
    if constexpr (SP2) {
        PG8_STAGE(PG8_SB(0, 0), cB, voffB); PG8_STAGE(PG8_SB(0, 1), cB + hstep, voffB); PG8_STAGE(PG8_SA(0, 0), cA, voffA); PG8_STAGE(PG8_SA(0, 1), cA + hstep, voffA);
        if (wr == 1) PG8_BAR;
        PG8_WAIT_V(2); PG8_BAR;
        PG8_STAGE(PG8_SB(1, 0), cB + kstep, voffB); PG8_STAGE(PG8_SA(1, 0), cA + kstep, voffA); PG8_STAGE(PG8_SB(1, 1), cB + hstep + kstep, voffB);
        PG8_WAIT_V(6); PG8_BAR;
    } else {
        PG8_STAGE(PG8_SB(0, 0), cB, voffB); PG8_STAGE(PG8_SA(0, 0), cA, voffA); PG8_STAGE(PG8_SB(0, 1), cB + hstep, voffB); PG8_STAGE(PG8_SA(0, 1), cA + hstep, voffA);
        if (wr == 1) PG8_BAR;
        PG8_WAIT_V(4); PG8_BAR;
        PG8_STAGE(PG8_SB(1, 0), cB + kstep, voffB); PG8_STAGE(PG8_SA(1, 0), cA + kstep, voffA); PG8_STAGE(PG8_SB(1, 1), cB + hstep + kstep, voffB);
        PG8_WAIT_V(6); PG8_BAR;
    }
    for (;;) {
        const bool has_next = S.next(ui + 1, nxt);
        const char* nA = has_next ? (const char*)g.A + (size_t)nxt.pm * tstep : cA; const char* nB = has_next ? (const char*)g.Bt + (size_t)nxt.pn * tstep : cB;
        for (int t = 0; t < nt; t += 2) {
            const bool last = (t == nt - 2);
            const char* a1 = cA + (size_t)(t + 1) * kstep;
            const char* a2 = last ? nA : cA + (size_t)(t + 2) * kstep; const char* b2 = last ? nB : cB + (size_t)(t + 2) * kstep;
            const char* a3 = a2 + kstep; const char* b3 = b2 + kstep;
            if (last && has_next) S.a_ready(nxt);
            if constexpr (SP2) {
            PG8_LDB(B0, 0, 0); PG8_LDB(B1, 0, 1); PG8_SCHED; PG8_LDA(At, 0, 0); PG8_STAGE(PG8_SA(1, 1), a1 + hstep, voffA);
            PG8_WAIT_V(8); PG8_WAIT_L(0); PG8_BAR; PG8_MMA(0, 0, At, B0); PG8_MMA(0, 1, At, B1); PG8_BAR; PG8_SCHED;
            PG8_LDA(At, 0, 1); PG8_STAGE(PG8_SB(0, 0), b2, voffB); PG8_STAGE(PG8_SB(0, 1), b2 + hstep, voffB); PG8_STAGE(PG8_SA(0, 0), a2, voffA);
            PG8_WAIT_V(8); PG8_WAIT_L(0); PG8_BAR; PG8_MMA(1, 0, At, B0); PG8_MMA(1, 1, At, B1); PG8_BAR; PG8_SCHED;
            PG8_LDB(B0, 1, 0); PG8_LDB(B1, 1, 1); PG8_SCHED; PG8_LDA(At, 1, 0); PG8_STAGE(PG8_SA(0, 1), a2 + hstep, voffA);
            PG8_WAIT_V(8); PG8_WAIT_L(0); PG8_BAR; PG8_MMA(0, 0, At, B0); PG8_MMA(0, 1, At, B1); PG8_BAR; PG8_SCHED;
            PG8_LDA(At, 1, 1); PG8_STAGE(PG8_SB(1, 0), b3, voffB); PG8_STAGE(PG8_SB(1, 1), b3 + hstep, voffB); PG8_STAGE(PG8_SA(1, 0), a3, voffA);
            PG8_WAIT_V(8); PG8_WAIT_L(0); PG8_BAR; PG8_MMA(1, 0, At, B0); PG8_MMA(1, 1, At, B1); PG8_BAR; PG8_SCHED;
            } else {
            PG8_LDB(B0, 0, 0); PG8_SCHED; PG8_LDA(At, 0, 0); PG8_STAGE(PG8_SA(1, 1), a1 + hstep, voffA);
            PG8_WAIT_L(8); PG8_BAR; PG8_WAIT_L(0); PG8_MMA(0, 0, At, B0); PG8_BAR; PG8_SCHED;
            PG8_LDB(B1, 0, 1); PG8_STAGE(PG8_SB(0, 0), b2, voffB);
            PG8_BAR; PG8_WAIT_L(0); PG8_MMA(0, 1, At, B1); PG8_BAR;
            PG8_LDA(At, 0, 1); PG8_STAGE(PG8_SA(0, 0), a2, voffA);
            PG8_BAR; PG8_WAIT_L(0); PG8_MMA(1, 0, At, B0); PG8_BAR; PG8_SCHED;
            PG8_STAGE(PG8_SB(0, 1), b2 + hstep, voffB);
            PG8_WAIT_V(6); PG8_BAR; PG8_MMA(1, 1, At, B1); PG8_BAR;
            PG8_LDB(B0, 1, 0); PG8_SCHED; PG8_LDA(At, 1, 0); PG8_STAGE(PG8_SA(0, 1), a2 + hstep, voffA);
            PG8_WAIT_L(8); PG8_BAR; PG8_WAIT_L(0); PG8_MMA(0, 0, At, B0); PG8_BAR; PG8_SCHED;
            PG8_LDB(B1, 1, 1); PG8_STAGE(PG8_SB(1, 0), b3, voffB);
            PG8_BAR; PG8_WAIT_L(0); PG8_MMA(0, 1, At, B1); PG8_BAR;
            PG8_LDA(At, 1, 1); PG8_STAGE(PG8_SA(1, 0), a3, voffA);
            PG8_BAR; PG8_WAIT_L(0); PG8_MMA(1, 0, At, B0); PG8_BAR; PG8_SCHED;
            PG8_STAGE(PG8_SB(1, 1), b3 + hstep, voffB);
            PG8_WAIT_V(6); PG8_BAR; PG8_MMA(1, 1, At, B1); PG8_BAR;
            }
        }
        if constexpr (ALIGN_EPI) { if (wr == 0) PG8_BAR; }
        if constexpr (!Epi::AFTER_DRAIN) { E(acc, cur, wr, wc, fr, fq); S.done(cur); }
        if (!has_next) break;
#pragma unroll
        for (int a = 0; a < 2; ++a)
#pragma unroll
            for (int b = 0; b < 2; ++b)
#pragma unroll
                for (int m = 0; m < 4; ++m)
#pragma unroll
                    for (int n = 0; n < 2; ++n) acc[a][b][m][n] = (f32x4){0.f, 0.f, 0.f, 0.f};
        cur = nxt; cA = nA; cB = nB; ++ui;
        if constexpr (ALIGN_EPI) { if (wr == 1) PG8_BAR; }
    }
    PG8_WAIT_V(0);
    if constexpr (!ALIGN_EPI) { if (wr == 0) PG8_BAR; }
    PG8_BAR;
    if constexpr (Epi::AFTER_DRAIN) { E.fused(acc, cur, wr, wc, fr, fq, lds, wid, lane); S.done(cur); }
#undef PG8_SA
#undef PG8_SB
#undef PG8_STAGE
#undef PG8_LDA
#undef PG8_LDB
#undef PG8_MMA
#undef PG8_WAIT_V
#undef PG8_WAIT_L
#undef PG8_BAR
#undef PG8_SCHED
}
}
namespace att {
typedef unsigned short bf16;
typedef short bf16x8 __attribute__((ext_vector_type(8)));
typedef short s16x4 __attribute__((ext_vector_type(4)));
typedef float f32x16 __attribute__((ext_vector_type(16)));
typedef float f32x4 __attribute__((ext_vector_type(4)));
typedef unsigned u32x4 __attribute__((ext_vector_type(4)));
enum { MODE_FOX = 0, MODE_WIN = 1, MODE_SLC = 2 };
constexpr int D = 128, NW = 8, QBLK = 32, KVBLK = 64, QB = NW * QBLK, SEQ = 8192;
constexpr float SCALE = 0.08838834764831845f, THR = 8.f;
constexpr int SHM_V = KVBLK * D * 2, SHM_K = KVBLK * D * 2;
constexpr int LDS_Q = 2 * SHM_V + 2 * SHM_K, LDS_WSF = LDS_Q + NW * QBLK * D * 2, LDS_T5 = LDS_WSF + NW * 128 * 4, LDS_BIAS = LDS_T5 + 6 * 132 * 4, ATT_LDS_BYTES = LDS_BIAS + 512;
constexpr int WBIG = 1 << 30;
#define KSWZ(row, colB) ((row) * 256 + ((colB) ^ (((row) & 7) << 4)))
#define SBAR() __builtin_amdgcn_sched_barrier(0)
__device__ __forceinline__ int v_st(int k, int c) { const int kk = (k & ~0xC) | ((k & 4) << 1) | ((k & 8) >> 1); return ((kk >> 3) * 4 + (c >> 5)) * 512 + ((kk & 7) * 32 + (c & 31)) * 2; }
__device__ __forceinline__ int v_rd_base(int lane) { return ((lane & 3) << 3) | (((lane >> 2) & 3) << 6) | (((lane >> 4) & 1) << 5) | (((lane >> 5) & 1) << 8); }
constexpr int v_rd_off(int d0, int ks, int half) { return d0 * 512 + ks * 4096 + half * 2048; }
__device__ __forceinline__ int crow(int r, int hi) { return (r & 3) + 8 * (r >> 2) + 4 * hi; }
__device__ __forceinline__ unsigned cvtpk(float lo, float hi) { unsigned r; asm volatile("v_cvt_pk_bf16_f32 %0, %1, %2" : "=v"(r) : "v"(lo), "v"(hi)); return r; }
__device__ __forceinline__ bf16x8 load8(const bf16* p) { return *reinterpret_cast<const bf16x8*>(p); }
__device__ __forceinline__ float bflo(unsigned w) { return __builtin_bit_cast(float, w << 16); }
__device__ __forceinline__ float bfhi(unsigned w) { return __builtin_bit_cast(float, w & 0xffff0000u); }
__device__ __forceinline__ float silu_(float v) { return v * __builtin_amdgcn_rcpf(1.f + __expf(-v)); }
__device__ __forceinline__ float slc_cv(int j, unsigned w0, unsigned w1, unsigned w2, unsigned w3, float c31) {
    const unsigned wj = j < 32 ? w0 : (j < 64 ? w1 : (j < 96 ? w2 : w3)); return ((wj >> (j & 31)) & 1u) ? c31 : -__builtin_inff(); }
__device__ __forceinline__ void mask_tile(f32x16& p0, f32x16& p1, int dq, unsigned W) {
    const float NEG = -__builtin_inff();
#pragma unroll
    for (int r = 0; r < 16; ++r) { const int c = (r & 3) + 8 * (r >> 2);
        if ((unsigned)(dq - c) >= W) p0[r] = NEG;
        if ((unsigned)(dq - c - 32) >= W) p1[r] = NEG; }
}
__device__ __forceinline__ void t5_tile(f32x16& p0, f32x16& p1, int dq, const float* Td) {
#pragma unroll
    for (int g4 = 0; g4 < 4; ++g4) {
#pragma unroll
        for (int i = 0; i < 4; ++i) { const int r = 4 * g4 + i, c = (r & 3) + 8 * (r >> 2);
            int d0 = dq - c, d1 = dq - c - 32; d0 = d0 < 0 ? 0 : (d0 > 127 ? 127 : d0); d1 = d1 < 0 ? 0 : (d1 > 127 ? 127 : d1);
            p0[r] += Td[d0]; p1[r] += Td[d1]; }
        asm volatile("" ::: "memory"); }
}
__device__ __forceinline__ void partialSM(f32x16& p0, f32x16& p1, float& m_reg, float& mn, float& alpha) {
    float pmax = p0[0];
#pragma unroll
    for (int r = 1; r < 16; ++r) pmax = fmaxf(pmax, p0[r]);
#pragma unroll
    for (int r = 0; r < 16; ++r) pmax = fmaxf(pmax, p1[r]);
    { auto rr = __builtin_amdgcn_permlane32_swap(__float_as_uint(pmax), __float_as_uint(pmax), false, false);
      pmax = fmaxf(__uint_as_float(rr[0]), __uint_as_float(rr[1])); }
    constexpr float C2 = 1.4426950408889634f * SCALE;
    if (__builtin_expect(__all((pmax - m_reg) * SCALE <= THR), 1)) { mn = m_reg; alpha = 1.f; }
    else { mn = fmaxf(m_reg, pmax); alpha = __builtin_amdgcn_exp2f((m_reg - mn) * C2); m_reg = mn; }
    const float mnL = -mn * C2;
#pragma unroll
    for (int r = 0; r < 16; ++r) p0[r] = fmaf(p0[r], C2, mnL);
#pragma unroll
    for (int r = 0; r < 16; ++r) p1[r] = fmaf(p1[r], C2, mnL);
#pragma unroll
    for (int r = 0; r < 16; ++r) p0[r] = __builtin_amdgcn_exp2f(p0[r]);
}
__device__ __forceinline__ void finishSM(f32x16& p0, f32x16& p1, float alpha, float& l_reg, bf16x8& pa0, bf16x8& pa1, bf16x8& pa2, bf16x8& pa3) {
#pragma unroll
    for (int r = 0; r < 16; ++r) p1[r] = __builtin_amdgcn_exp2f(p1[r]);
    float ps = 0;
#pragma unroll
    for (int r = 0; r < 16; ++r) ps += p0[r];
#pragma unroll
    for (int r = 0; r < 16; ++r) ps += p1[r];
    { auto rr = __builtin_amdgcn_permlane32_swap(__float_as_uint(ps), __float_as_uint(ps), false, false);
      ps = __uint_as_float(rr[0]) + __uint_as_float(rr[1]); }
    l_reg = l_reg * alpha + ps;
#define PK4(P, B_, OUT) do { unsigned a0 = cvtpk(P[B_+0], P[B_+1]), a1 = cvtpk(P[B_+2], P[B_+3]);                          \
        unsigned b0 = cvtpk(P[B_+4], P[B_+5]), b1 = cvtpk(P[B_+6], P[B_+7]);                                             \
        auto r0 = __builtin_amdgcn_permlane32_swap(a0, b0, false, false); auto r1 = __builtin_amdgcn_permlane32_swap(a1, b1, false, false); \
        u32x4 w = {r0[0], r1[0], r0[1], r1[1]}; OUT = *reinterpret_cast<bf16x8*>(&w); } while (0)
    PK4(p0, 0, pa0); PK4(p0, 8, pa1); PK4(p1, 0, pa2); PK4(p1, 8, pa3);
#undef PK4
}
template <int KB, bool SK, int MODE>
__device__ __forceinline__ void qkt(f32x16& p0, f32x16& p1, const char* K_lds, const char* B_lds, float cv, int r32, int hi, const char* Qw, bool act) {
    if (SK && !act) { const float NEG = -__builtin_inff();
#pragma unroll
        for (int r = 0; r < 16; ++r) { p0[r] = NEG; p1[r] = NEG; } return; }
    if (MODE == MODE_FOX) { const float* bb = (const float*)(B_lds + KB * 256) + 4 * hi;
        const f32x4 a0 = *(const f32x4*)(bb), a1 = *(const f32x4*)(bb + 8), a2 = *(const f32x4*)(bb + 16), a3 = *(const f32x4*)(bb + 24);
        const f32x4 b0 = *(const f32x4*)(bb + 32), b1 = *(const f32x4*)(bb + 40), b2 = *(const f32x4*)(bb + 48), b3 = *(const f32x4*)(bb + 56);
        p0 = (f32x16){a0[0], a0[1], a0[2], a0[3], a1[0], a1[1], a1[2], a1[3], a2[0], a2[1], a2[2], a2[3], a3[0], a3[1], a3[2], a3[3]};
        p1 = (f32x16){b0[0], b0[1], b0[2], b0[3], b1[0], b1[1], b1[2], b1[3], b2[0], b2[1], b2[2], b2[3], b3[0], b3[1], b3[2], b3[3]}; }
    else {
#pragma unroll
        for (int r = 0; r < 16; ++r) { p0[r] = cv; p1[r] = cv; } }
    const char* kb[4]; const char* qb[4];
#pragma unroll
    for (int dd = 0; dd < 4; ++dd) { const int off = KSWZ(r32, (dd * 16 + hi * 8) * 2); kb[dd] = K_lds + KB * SHM_K + off; qb[dd] = Qw + off; }
#pragma unroll
    for (int d0 = 0; d0 < 8; ++d0) { const char* a = kb[d0 & 3] + (d0 >> 2) * 128;
        bf16x8 b0 = *reinterpret_cast<const bf16x8*>(a);
        bf16x8 b1 = *reinterpret_cast<const bf16x8*>(a + 32 * 256);
        const bf16x8 qv = *reinterpret_cast<const bf16x8*>(qb[d0 & 3] + (d0 >> 2) * 128);
        p0 = __builtin_amdgcn_mfma_f32_32x32x16_bf16(b0, qv, p0, 0, 0, 0);
        p1 = __builtin_amdgcn_mfma_f32_32x32x16_bf16(b1, qv, p1, 0, 0, 0); }
}
template <int VB, bool SK>
__device__ __forceinline__ void pv_tile(f32x16* o, int vb0, bf16x8 pa0, bf16x8 pa1, bf16x8 pa2, bf16x8 pa3, bool act) {
    if (SK && !act) return;
#define TRRD(dst, off) asm volatile("ds_read_b64_tr_b16 %0, %1 offset:%2" : "=&v"(dst) : "v"(vb0), "i"(off) : "memory")
#define PV_D0(d0) do { s16x4 l0, l1, l2, l3, h0, h1, h2, h3; constexpr int b_ = VB * SHM_V + v_rd_off(d0, 0, 0); \
        TRRD(l0, b_); TRRD(h0, b_ + 2048); TRRD(l1, b_ + 4096); TRRD(h1, b_ + 6144); TRRD(l2, b_ + 8192); TRRD(h2, b_ + 10240); TRRD(l3, b_ + 12288); TRRD(h3, b_ + 14336); \
        asm volatile("s_waitcnt lgkmcnt(0)" ::: "memory"); SBAR();   \
        o[d0] = __builtin_amdgcn_mfma_f32_32x32x16_bf16(pa0, (bf16x8){l0[0], l0[1], l0[2], l0[3], h0[0], h0[1], h0[2], h0[3]}, o[d0], 0, 0, 0);   \
        o[d0] = __builtin_amdgcn_mfma_f32_32x32x16_bf16(pa1, (bf16x8){l1[0], l1[1], l1[2], l1[3], h1[0], h1[1], h1[2], h1[3]}, o[d0], 0, 0, 0);   \
        o[d0] = __builtin_amdgcn_mfma_f32_32x32x16_bf16(pa2, (bf16x8){l2[0], l2[1], l2[2], l2[3], h2[0], h2[1], h2[2], h2[3]}, o[d0], 0, 0, 0);   \
        o[d0] = __builtin_amdgcn_mfma_f32_32x32x16_bf16(pa3, (bf16x8){l3[0], l3[1], l3[2], l3[3], h3[0], h3[1], h3[2], h3[3]}, o[d0], 0, 0, 0); } while (0)
    PV_D0(0); PV_D0(1); PV_D0(2); PV_D0(3);
#undef PV_D0
#undef TRRD
}
struct BlockRef { const bf16* Q; const bf16* K; const bf16* V; const float* bias; int P0, W, h, mode; int ja, jb; int bid, chunk, nch; };
struct Aux {
    const float* biasF;
    const unsigned* selm;
    const float* small;
    const bf16* zf; const bf16* zn; const bf16* oc; bf16* ow; bf16* y;
    float* part_o; float* part_ml; unsigned* arr; volatile unsigned* ldsflag;
};
struct Seam { bf16x8 st_v0, st_v1, st_k0, st_k1; f32x4 st_b; };
__device__ __forceinline__ int swa_jlo(int P0, int W) { const int lowk = P0 - W + 1; return lowk > 0 ? lowk / KVBLK : 0; }
#define ROW(p, k0, rr) ((p) + (size_t)((k0) + (rr)) * D + sc)
#define VMW() asm volatile("s_waitcnt vmcnt(0)" ::: "memory")
#define VMWN(n) asm volatile("s_waitcnt vmcnt(%0)" :: "i"(n) : "memory")
#define SLOAD_H(Kp, Vp, Bp, k0) do { S.st_v0 = load8(ROW(Vp, k0, sr)); S.st_v1 = load8(ROW(Vp, k0, 32 + sr));              \
                         S.st_k0 = load8(ROW(Kp, k0, sr)); S.st_k1 = load8(ROW(Kp, k0, 32 + sr));                        \
                         if ((Bp) != nullptr && tid < 16) S.st_b = *(const f32x4*)((Bp) + (k0) + 4 * tid); } while (0)
#define SWRITE_HK(bf, Bp) do { *(bf16x8*)(K_lds + (bf) * SHM_K + kws) = S.st_k0; *(bf16x8*)(K_lds + (bf) * SHM_K + kws + 32 * 256) = S.st_k1; \
                         if ((Bp) != nullptr && tid < 16) *(f32x4*)(B_lds + (bf) * 256 + tid * 16) = S.st_b; } while (0)
#define SWRITE_HV(bf) do { *(bf16x8*)(V_lds + (bf) * SHM_V + vst0) = S.st_v0; *(bf16x8*)(V_lds + (bf) * SHM_V + vst1) = S.st_v1; } while (0)
#define SWRITE_H(bf, Bp) do { SWRITE_HV(bf); SWRITE_HK(bf, Bp); } while (0)
__device__ __forceinline__ void attn_prime(const BlockRef& cur, char* lds, Seam& S, int tid) {
    const int wid = __builtin_amdgcn_readfirstlane(tid >> 6), lane = tid & 63, r32 = lane & 31, hi = lane >> 5;
    const int sr = tid >> 4, sc = (tid & 15) * 8, kws = KSWZ(sr, sc * 2); char* K_lds = lds + 2 * SHM_V; char* B_lds = lds + LDS_BIAS;
    const int kb0 = cur.ja * KVBLK;
    bf16x8 qt_[8]; char* Qw = lds + LDS_Q + wid * (QBLK * D * 2);
#pragma unroll
    for (int d0 = 0; d0 < 8; ++d0) qt_[d0] = load8(cur.Q + (size_t)(wid * QBLK + r32) * D + d0 * 16 + hi * 8);
    SLOAD_H(cur.K, cur.V, cur.bias, kb0); VMW(); SWRITE_HK(0, cur.bias);
    { int r32q = r32, hiq = hi; asm volatile("" : "+v"(r32q), "+v"(hiq));
#pragma unroll
      for (int dd = 0; dd < 4; ++dd) { char* qd = Qw + KSWZ(r32q, (dd * 16 + hiq * 8) * 2); *(bf16x8*)qd = qt_[dd]; *(bf16x8*)(qd + 128) = qt_[dd + 4]; } }
    __syncthreads();
}
template <int MODE>
__device__ __forceinline__ void attn_block(const BlockRef& cur, const BlockRef& nxt, const Aux& X, char* lds, Seam& S, int tid_in) {
    constexpr bool SK = (MODE == MODE_WIN);
    int tid = tid_in; asm volatile("" : "+v"(tid));
    const int wid = __builtin_amdgcn_readfirstlane(tid >> 6), lane = tid & 63, r32 = lane & 31, hi = lane >> 5;
    const int W = cur.W, h = cur.h;
    const int j_lo = cur.ja, NT = cur.jb - cur.ja;
    const int kbn = nxt.ja * KVBLK;
    const int qlo = cur.P0 + wid * QBLK, qm = qlo + r32 - 4 * hi;
    char* V_lds = lds; char* K_lds = lds + 2 * SHM_V; char* B_lds = lds + LDS_BIAS;
    char* Qw = lds + LDS_Q + wid * (QBLK * D * 2);
    float* ws = (float*)(lds + LDS_WSF) + wid * 128; float* li_l = ws, * al_l = ws + 32, * gw_l = ws + 64;
    const float* Td = (const float*)(lds + LDS_T5) + h * 132;
    float m_reg = -1e30f, l_reg = 0; f32x16 o[4] = {};
    const int sr = tid >> 4, sc = (tid & 15) * 8, vst0 = v_st(sr, sc), vst1 = v_st(32 + sr, sc), kws = KSWZ(sr, sc * 2);
    const int vb0 = (int)(uintptr_t)V_lds + v_rd_base(lane);
    const bf16* Kh = cur.K; const bf16* Vh = cur.V;
    float c31 = 0.f; unsigned sw0 = 0, sw1 = 0, sw2 = 0, sw3 = 0;
    if (MODE != MODE_FOX) c31 = Td[128];
    if (MODE == MODE_SLC) { const u32x4 wv = *(const u32x4*)(X.selm + ((size_t)(h / 3) * SEQ + qlo + r32) * 4); sw0 = wv.x; sw1 = wv.y; sw2 = wv.z; sw3 = wv.w; }
    const float* bF = cur.bias;
#define RESC(a) do { if (__any((a) < 1.f)) { if (hi == 0) al_l[r32] = (a); asm volatile("s_waitcnt lgkmcnt(0)" ::: "memory");              \
                     for (int d_ = 0; d_ < 4; ++d_) for (int r = 0; r < 16; ++r) o[d_][r] *= al_l[crow(r, hi)]; } } while (0)
#define KBASE(t) ((j_lo + (t)) * KVBLK)
#define ACT(t) (KBASE(t) <= qlo + QBLK - 1 && KBASE(t) + KVBLK - 1 >= qlo - W + 1)
#define CV(t) ((MODE == MODE_SLC) ? slc_cv(j_lo + (t), sw0, sw1, sw2, sw3, c31) : c31)
#define MASKT(P0_, P1_, t) do { const int kb_ = KBASE(t);                                                                                \
        if (MODE != MODE_FOX && (!SK || ACT(t)) && (kb_ + KVBLK - 1 + 112 >= qlo)) t5_tile(P0_, P1_, qm - kb_, Td);                      \
        if ((!SK || ACT(t)) && (kb_ + KVBLK - 1 > qlo || kb_ <= qlo + QBLK - 1 - W)) mask_tile(P0_, P1_, qm - kb_, (unsigned)W); } while (0)
    f32x16 p0, p1; float mnX, alX; bf16x8 pa0, pa1, pa2, pa3; bf16x8 qn_[8];
    SWRITE_HV(0);
    __syncthreads();
#define STEP(t, PB) do { const bool last_ = ((t) + 1 == NT);                                                                  \
        if (!last_) SLOAD_H(Kh, Vh, bF, KBASE((t) + 1)); else SLOAD_H(nxt.K, nxt.V, nxt.bias, kbn);                           \
        SBAR(); qkt<PB, SK, MODE>(p0, p1, K_lds, B_lds, CV(t), r32, hi, Qw, ACT(t)); SBAR();                                   \
        if (last_) { _Pragma("unroll") for (int d0 = 0; d0 < 8; ++d0) qn_[d0] = load8(nxt.Q + (size_t)(wid * QBLK + r32) * D + d0 * 16 + hi * 8); } \
        MASKT(p0, p1, (t)); partialSM(p0, p1, m_reg, mnX, alX); RESC(alX);                                                    \
        finishSM(p0, p1, alX, l_reg, pa0, pa1, pa2, pa3); SBAR();                                                             \
        pv_tile<PB, SK>(o, vb0, pa0, pa1, pa2, pa3, ACT(t)); SBAR();                                                          \
        if (!last_) { VMW(); SWRITE_H(1 - (PB), bF); }                                                                        \
        __syncthreads(); } while (0)
    for (int t = 0; t < NT; t += 2) { STEP(t, 0); if (t + 1 < NT) STEP(t + 1, 1); }
#undef STEP
    VMW(); SWRITE_HK(0, nxt.bias);
    { int r32q = r32, hiq = hi; asm volatile("" : "+v"(r32q), "+v"(hiq));
#pragma unroll
      for (int dd = 0; dd < 4; ++dd) { char* qd = Qw + KSWZ(r32q, (dd * 16 + hiq * 8) * 2); *(bf16x8*)qd = qn_[dd]; *(bf16x8*)(qd + 128) = qn_[dd + 4]; } }
    SBAR();
    bool do_epi = true;
    if (MODE == MODE_SLC && cur.nch > 1) {
        constexpr float C2m = 1.4426950408889634f * SCALE;
        float* PM = X.part_ml + (size_t)(cur.bid * 8 + cur.chunk) * 512 + (wid * 32 + r32) * 2;
        { const __amdgpu_buffer_rsrc_t rs = __builtin_amdgcn_make_buffer_rsrc((void*)((unsigned char*)X.part_o + (size_t)(cur.bid * 8 + cur.chunk) * 65536), 0, 65536, 0x00020000);
#pragma unroll
          for (int d0 = 0; d0 < 4; ++d0)
#pragma unroll
            for (int rq = 0; rq < 2; ++rq) { u32x4 wv = {cvtpk(o[d0][8 * rq], o[d0][8 * rq + 1]), cvtpk(o[d0][8 * rq + 2], o[d0][8 * rq + 3]), cvtpk(o[d0][8 * rq + 4], o[d0][8 * rq + 5]), cvtpk(o[d0][8 * rq + 6], o[d0][8 * rq + 7])};
                __builtin_amdgcn_raw_buffer_store_b128(wv, rs, (wid * 8 + d0 * 2 + rq) * 1024 + lane * 16, 0, 16); } }
        if (hi == 0) { __hip_atomic_store((__attribute__((address_space(1))) float*)PM, m_reg, __ATOMIC_RELAXED, __HIP_MEMORY_SCOPE_AGENT); __hip_atomic_store((__attribute__((address_space(1))) float*)(PM + 1), l_reg, __ATOMIC_RELAXED, __HIP_MEMORY_SCOPE_AGENT); }
        asm volatile("s_waitcnt vmcnt(0)" ::: "memory"); __syncthreads();
        if (tid == 0) {
            const unsigned old = __hip_atomic_fetch_add((__attribute__((address_space(1))) unsigned*)(X.arr + cur.bid), 1u, __ATOMIC_RELAXED, __HIP_MEMORY_SCOPE_AGENT); const unsigned lastf = (old + 1u == (unsigned)cur.nch) ? 1u : 0u;
            if (lastf) { __builtin_amdgcn_fence(__ATOMIC_ACQUIRE, "agent"); asm volatile("s_waitcnt vmcnt(0)" ::: "memory"); }
            *X.ldsflag = lastf; }
        __syncthreads();
        do_epi = (*X.ldsflag != 0u);
        if (do_epi) {
            for (int c2 = 0; c2 < cur.nch; ++c2) {
                const u32x4* PO2 = (const u32x4*)((const unsigned char*)X.part_o + (size_t)(cur.bid * 8 + c2) * 65536) + wid * 8 * 64 + lane; const float* PM2 = X.part_ml + (size_t)(cur.bid * 8 + c2) * 512 + (wid * 32 + r32) * 2;
                const float m2 = __hip_atomic_load((__attribute__((address_space(1))) const float*)PM2, __ATOMIC_RELAXED, __HIP_MEMORY_SCOPE_AGENT), l2 = __hip_atomic_load((__attribute__((address_space(1))) const float*)(PM2 + 1), __ATOMIC_RELAXED, __HIP_MEMORY_SCOPE_AGENT);
                float f1, f2;
                if (c2 == 0) { f1 = 0.f; f2 = 1.f; l_reg = l2; m_reg = m2; }
                else { const float M = fmaxf(m_reg, m2); f1 = __builtin_amdgcn_exp2f((m_reg - M) * C2m); f2 = __builtin_amdgcn_exp2f((m2 - M) * C2m); l_reg = l_reg * f1 + l2 * f2; m_reg = M; }
                asm volatile("s_waitcnt lgkmcnt(0)" ::: "memory");
                if (hi == 0) { al_l[r32] = f1; gw_l[r32] = f2; }
                asm volatile("s_waitcnt lgkmcnt(0)" ::: "memory");
#pragma unroll
                for (int rq = 0; rq < 2; ++rq) { float f1v[8], f2v[8];
#pragma unroll
                    for (int e = 0; e < 8; ++e) { f1v[e] = al_l[crow(8 * rq + e, hi)]; f2v[e] = gw_l[crow(8 * rq + e, hi)]; }
#pragma unroll
                    for (int d0 = 0; d0 < 4; ++d0) { const u32x4 wv = PO2[(d0 * 2 + rq) * 64];
#pragma unroll
                        for (int e = 0; e < 4; ++e) { const int r = 8 * rq + 2 * e; o[d0][r] = (c2 == 0 ? 0.f : o[d0][r] * f1v[2 * e]) + bflo(wv[e]) * f2v[2 * e]; o[d0][r + 1] = (c2 == 0 ? 0.f : o[d0][r + 1] * f1v[2 * e + 1]) + bfhi(wv[e]) * f2v[2 * e + 1]; } } }
                asm volatile("s_waitcnt lgkmcnt(0)" ::: "memory"); }
        }
    }
    if (do_epi) {
    int r32e = r32, hie = hi; asm volatile("" : "+v"(r32e), "+v"(hie));
    { float f = __builtin_amdgcn_rcpf(l_reg), gwv = 0.f;
      if (MODE == MODE_SLC) { const float* sm = X.small + (size_t)(qlo + r32e) * 32 + 6 + 3 * h; f *= 1.f / (1.f + __expf(-sm[1])); gwv = 1.f / (1.f + __expf(-sm[2])); }
      if (hie == 0) { li_l[r32e] = f; if (MODE == MODE_SLC) gw_l[r32e] = gwv; } }
    asm volatile("s_waitcnt lgkmcnt(0)" ::: "memory");
    float rli[16];
#pragma unroll
    for (int r = 0; r < 16; ++r) rli[r] = li_l[crow(r, hie)];
#pragma unroll
    for (int r = 0; r < 16; ++r) { const int q = qlo + crow(r, hie); float gwr = 0.f; if (MODE == MODE_SLC) gwr = gw_l[crow(r, hie)];
#pragma unroll
        for (int d0 = 0; d0 < 4; ++d0) { const int col = d0 * 32 + r32e; const float v = o[d0][r] * rli[r]; const float vn = __builtin_bit_cast(float, __builtin_amdgcn_mov_dpp(__builtin_bit_cast(int, v), 0xB1, 0xF, 0xF, true));
            if ((r32e & 1) == 0) {
                if (MODE == MODE_FOX) { const unsigned z2 = *(const unsigned*)(X.zf + (size_t)q * 768 + h * 128 + col);
                    *(unsigned*)(X.y + (size_t)q * 2048 + 512 + h * 128 + col) = cvtpk(v * silu_(bflo(z2)), vn * silu_(bfhi(z2))); }
                else if (MODE == MODE_WIN) { *(unsigned*)(X.ow + ((size_t)h * SEQ + q) * 128 + col) = cvtpk(v, vn); }
                else { const size_t oo = ((size_t)h * SEQ + q) * 128 + col; const unsigned c2 = *(const unsigned*)(X.oc + oo), w2 = *(const unsigned*)(X.ow + oo), z2 = *(const unsigned*)(X.zn + (size_t)q * 768 + h * 128 + col);
                    *(unsigned*)(X.y + (size_t)q * 2048 + 1280 + h * 128 + col) = cvtpk((v + bflo(c2) + gwr * bflo(w2)) * silu_(bflo(z2)), (vn + bfhi(c2) + gwr * bfhi(w2)) * silu_(bfhi(z2))); } } } }
    }
    __syncthreads();
#undef RESC
#undef KBASE
#undef ACT
#undef CV
#undef MASKT
}
#undef ROW
#undef VMW
#undef VMWN
#undef SLOAD_H
#undef SWRITE_HK
#undef SWRITE_HV
#undef SWRITE_H
#undef KSWZ
#undef SBAR
}
#define GAS __attribute__((address_space(1)))
#define LAS __attribute__((address_space(3)))
typedef unsigned short bf16;
typedef unsigned v4u __attribute__((ext_vector_type(4)));
typedef float f32x4 __attribute__((ext_vector_type(4)));
typedef short bf16x8 __attribute__((ext_vector_type(8)));
typedef GAS unsigned gu32;
typedef GAS unsigned long long gu64;
#define RLX_AGENT __ATOMIC_RELAXED, __HIP_MEMORY_SCOPE_AGENT
#define LDS_WAIT() asm volatile("s_waitcnt lgkmcnt(0)" ::: "memory")
#define VM_WAIT() asm volatile("s_waitcnt vmcnt(0)" ::: "memory")
__device__ __forceinline__ unsigned long long rt() { return __builtin_amdgcn_s_memrealtime(); }
__device__ __forceinline__ unsigned f2bf(float f) { unsigned u = __builtin_bit_cast(unsigned, f); return (u + 0x7fffu + ((u >> 16) & 1u)) >> 16; }
__device__ __forceinline__ unsigned pk2(float lo, float hi) { return f2bf(lo) | (f2bf(hi) << 16); }
#define XB_TMO      128
#define XB_XCNT(j)  (256  + 64 * (j))
#define XB_XSUB(j)  (1280 + 64 * (j))
#define XB_XGEN(j)  (2304 + 64 * (j))
#define XB_TOP      3328
#define XB_TOPGEN   3392
#define XCD_BAR_WORDS 3456
#define XB_SPIN_CAP (1u << 18)

__device__ __forceinline__ unsigned xb_ld(unsigned* p)              { return __hip_atomic_load(p, __ATOMIC_RELAXED, __HIP_MEMORY_SCOPE_AGENT); }
__device__ __forceinline__ unsigned xb_add(unsigned* p, unsigned v) { return __hip_atomic_fetch_add(p, v, __ATOMIC_RELAXED, __HIP_MEMORY_SCOPE_AGENT); }
__device__ __forceinline__ unsigned xb_xcc_id() { return (unsigned)__builtin_amdgcn_s_getreg((3 << 11) | 20) & 0xFu; }
#define XB_SPIN(cond, bar) do { unsigned _sp = 0; while (cond) { __builtin_amdgcn_s_sleep(1); \
    if ((++_sp & 255u) == 0u) { if (xb_ld(&(bar)[XB_TMO])) break; if (_sp > XB_SPIN_CAP) { atomicAdd(&(bar)[XB_TMO], 1u); break; } } } } while (0)

struct XcdBarrier {
    unsigned* bar; unsigned x;
    volatile LAS unsigned* st;
};

__device__ __forceinline__ XcdBarrier xcd_barrier_post(unsigned* bar, volatile LAS unsigned* st) {
    XcdBarrier b; b.bar = bar; b.x = xb_xcc_id(); b.st = st;
    if (threadIdx.x == 0) (void)xb_add(&bar[XB_XCNT(b.x)], 1u);
    return b;
}
__device__ __forceinline__ void xcd_barrier_complete(unsigned* bar, unsigned x, unsigned& nloc, unsigned& nx) {
    const unsigned G = gridDim.x * gridDim.y * gridDim.z;
    unsigned sum, cnt, mine, sp = 0u;
    for (;;) {
        sum = 0u; cnt = 0u; mine = 0u;
#pragma unroll
        for (unsigned j = 0; j < 16; ++j) { const unsigned c = xb_ld(&bar[XB_XCNT(j)]); sum += c; cnt += (c > 0u) ? 1u : 0u; mine = (j == x) ? c : mine; }
        if (sum == G) break;
        __builtin_amdgcn_s_sleep(1);
        if ((++sp & 255u) == 0u) { if (xb_ld(&bar[XB_TMO])) break; if (sp > XB_SPIN_CAP) { atomicAdd(&bar[XB_TMO], 1u); break; } }
    }
    nloc = mine > 0u ? mine : 1u; nx = cnt > 0u ? cnt : 1u;
}

__device__ __forceinline__ void xcd_barrier(const XcdBarrier& b) {
    asm volatile("s_waitcnt vmcnt(0)" ::: "memory");
    __syncthreads();
    if (threadIdx.x == 0) {
        unsigned* bar = b.bar;
        __builtin_amdgcn_s_waitcnt(0);
        unsigned nloc = b.st[0], nx = b.st[1];
        if (nloc == 0u) { xcd_barrier_complete(bar, b.x, nloc, nx); b.st[0] = nloc; b.st[1] = nx; }
        const unsigned old = xb_add(&bar[XB_XSUB(b.x)], 1u);
        const unsigned gen = old / nloc;
        if (old + 1u == (gen + 1u) * nloc) {
            __builtin_amdgcn_fence(__ATOMIC_RELEASE, "agent");
            asm volatile("s_waitcnt vmcnt(0)" ::: "memory");
            const unsigned og = xb_add(&bar[XB_TOP], 1u);
            const unsigned tg = og / nx;
            if (og + 1u == (tg + 1u) * nx) xb_add(&bar[XB_TOPGEN], 1u);
            else XB_SPIN(xb_ld(&bar[XB_TOPGEN]) == tg, bar);
            __builtin_amdgcn_fence(__ATOMIC_ACQUIRE, "agent");
            xb_add(&bar[XB_XGEN(b.x)], 1u);
            asm volatile("s_waitcnt vmcnt(0)" ::: "memory");
        } else {
            XB_SPIN(xb_ld(&bar[XB_XGEN(b.x)]) == gen, bar);
            __builtin_amdgcn_fence(__ATOMIC_ACQUIRE, "agent");
            asm volatile("s_waitcnt vmcnt(0)" ::: "memory");
        }
    }
    __syncthreads();
}
constexpr int NWAVES = 8, NTHR = 512;
constexpr int S = 8192, DM = 2048, DEPTH = 4, NIN = 8216, NBIG = 8192;
constexpr float SM_SCALE = 0.08838834764831845f, NORM_EPS = 1e-6f;
constexpr size_t MiB = 1u << 20, HEADB = (size_t)S * 128 * 2;
constexpr size_t WS_CTL = 0, CTL_ZERO_BYTES = 1 * MiB;
constexpr size_t WS_MOD = 1 * MiB, WS_B1P = 1 * MiB + 128 * 1024, WS_SMALL = 2 * MiB, WS_BIASF = 3 * MiB, WS_FT = 3 * MiB + 256 * 1024, WS_SELM = 3 * MiB + 512 * 1024;
constexpr size_t WS_KCMP = 4 * MiB, WS_VCMPT = 4 * MiB + 256 * 1024, WS_WSM = 5 * MiB, WS_W2T = 6 * MiB, WS_W1T = 8 * MiB, WS_WOUT = 24 * MiB, WS_WIN = 56 * MiB;
constexpr size_t WS_H = 184 * MiB, WS_CONV = 216 * MiB, WS_ZF = 248 * MiB, WS_ZN = 260 * MiB, WS_ATT = 272 * MiB, WS_OC = 346 * MiB, WS_OW = 358 * MiB, WS_Y = 370 * MiB, WS_Y2 = 402 * MiB;
constexpr size_t WS_PARTO = 466 * MiB, WS_PARTML = 568 * MiB;
constexpr size_t WS_NAIVE = 600 * MiB;
constexpr int HP_QF = 0, HP_KF = 6, HP_VF = 12, HP_QN = 18, HP_KC = 24, HP_VC = 26, HP_KS = 28, HP_VS = 30, HP_KW = 32, HP_VW = 34;
constexpr int CW_QD = 20480, CW_NORM = 21504, CW_ARR = 24576;
constexpr int CW_BAR = 4096;
constexpr int RING_BYTES = 131072, LDSCTL_OFF = 146432, MISC_OFF = LDSCTL_OFF + 320, LDS_BYTES = 147456;
constexpr int NPH = 6, NSTEPS = 2 + DEPTH * NPH;
constexpr int SLC_CHUNK = 16;
constexpr int N_ITEMS_SLC = 864;
__device__ const unsigned short ITEMS_SLC[864] = {
  0x0818, 0x1020, 0x1028, 0x1030, 0x1038, 0x1138, 0x1840, 0x1940, 0x1848, 0x1948, 0x1850, 0x1950, 0x1858, 0x1958, 0x1a58, 0x2060,
  0x2160, 0x2260, 0x2068, 0x2168, 0x2268, 0x2070, 0x2170, 0x2270, 0x2078, 0x2178, 0x2278, 0x2378, 0x2880, 0x2980, 0x2a80, 0x2b80,
  0x2888, 0x2988, 0x2a88, 0x2b88, 0x2890, 0x2990, 0x2a90, 0x2b90, 0x2898, 0x2998, 0x2a98, 0x2b98, 0x2c98, 0x30a0, 0x31a0, 0x32a0,
  0x33a0, 0x34a0, 0x30a8, 0x31a8, 0x32a8, 0x33a8, 0x34a8, 0x30b0, 0x31b0, 0x32b0, 0x33b0, 0x34b0, 0x30b8, 0x31b8, 0x32b8, 0x33b8,
  0x34b8, 0x35b8, 0x38c0, 0x39c0, 0x3ac0, 0x3bc0, 0x3cc0, 0x3dc0, 0x38c8, 0x39c8, 0x3ac8, 0x3bc8, 0x3cc8, 0x3dc8, 0x38d0, 0x39d0,
  0x3ad0, 0x3bd0, 0x3cd0, 0x3dd0, 0x38d8, 0x39d8, 0x3ad8, 0x3bd8, 0x3cd8, 0x3dd8, 0x3ed8, 0x40e0, 0x41e0, 0x42e0, 0x43e0, 0x44e0,
  0x45e0, 0x46e0, 0x40e8, 0x41e8, 0x42e8, 0x43e8, 0x44e8, 0x45e8, 0x46e8, 0x40f0, 0x41f0, 0x42f0, 0x43f0, 0x44f0, 0x45f0, 0x46f0,
  0x40f8, 0x41f8, 0x42f8, 0x43f8, 0x44f8, 0x45f8, 0x46f8, 0x47f8, 0x0819, 0x1021, 0x1029, 0x1031, 0x1039, 0x1139, 0x1841, 0x1941,
  0x1849, 0x1949, 0x1851, 0x1951, 0x1859, 0x1959, 0x1a59, 0x2061, 0x2161, 0x2261, 0x2069, 0x2169, 0x2269, 0x2071, 0x2171, 0x2271,
  0x2079, 0x2179, 0x2279, 0x2379, 0x2881, 0x2981, 0x2a81, 0x2b81, 0x2889, 0x2989, 0x2a89, 0x2b89, 0x2891, 0x2991, 0x2a91, 0x2b91,
  0x2899, 0x2999, 0x2a99, 0x2b99, 0x2c99, 0x30a1, 0x31a1, 0x32a1, 0x33a1, 0x34a1, 0x30a9, 0x31a9, 0x32a9, 0x33a9, 0x34a9, 0x30b1,
  0x31b1, 0x32b1, 0x33b1, 0x34b1, 0x30b9, 0x31b9, 0x32b9, 0x33b9, 0x34b9, 0x35b9, 0x38c1, 0x39c1, 0x3ac1, 0x3bc1, 0x3cc1, 0x3dc1,
  0x38c9, 0x39c9, 0x3ac9, 0x3bc9, 0x3cc9, 0x3dc9, 0x38d1, 0x39d1, 0x3ad1, 0x3bd1, 0x3cd1, 0x3dd1, 0x38d9, 0x39d9, 0x3ad9, 0x3bd9,
  0x3cd9, 0x3dd9, 0x3ed9, 0x40e1, 0x41e1, 0x42e1, 0x43e1, 0x44e1, 0x45e1, 0x46e1, 0x40e9, 0x41e9, 0x42e9, 0x43e9, 0x44e9, 0x45e9,
  0x46e9, 0x40f1, 0x41f1, 0x42f1, 0x43f1, 0x44f1, 0x45f1, 0x46f1, 0x40f9, 0x41f9, 0x42f9, 0x43f9, 0x44f9, 0x45f9, 0x46f9, 0x47f9,
  0x081a, 0x1022, 0x102a, 0x1032, 0x103a, 0x113a, 0x1842, 0x1942, 0x184a, 0x194a, 0x1852, 0x1952, 0x185a, 0x195a, 0x1a5a, 0x2062,
  0x2162, 0x2262, 0x206a, 0x216a, 0x226a, 0x2072, 0x2172, 0x2272, 0x207a, 0x217a, 0x227a, 0x237a, 0x2882, 0x2982, 0x2a82, 0x2b82,
  0x288a, 0x298a, 0x2a8a, 0x2b8a, 0x2892, 0x2992, 0x2a92, 0x2b92, 0x289a, 0x299a, 0x2a9a, 0x2b9a, 0x2c9a, 0x30a2, 0x31a2, 0x32a2,
  0x33a2, 0x34a2, 0x30aa, 0x31aa, 0x32aa, 0x33aa, 0x34aa, 0x30b2, 0x31b2, 0x32b2, 0x33b2, 0x34b2, 0x30ba, 0x31ba, 0x32ba, 0x33ba,
  0x34ba, 0x35ba, 0x38c2, 0x39c2, 0x3ac2, 0x3bc2, 0x3cc2, 0x3dc2, 0x38ca, 0x39ca, 0x3aca, 0x3bca, 0x3cca, 0x3dca, 0x38d2, 0x39d2,
  0x3ad2, 0x3bd2, 0x3cd2, 0x3dd2, 0x38da, 0x39da, 0x3ada, 0x3bda, 0x3cda, 0x3dda, 0x3eda, 0x40e2, 0x41e2, 0x42e2, 0x43e2, 0x44e2,
  0x45e2, 0x46e2, 0x40ea, 0x41ea, 0x42ea, 0x43ea, 0x44ea, 0x45ea, 0x46ea, 0x40f2, 0x41f2, 0x42f2, 0x43f2, 0x44f2, 0x45f2, 0x46f2,
  0x40fa, 0x41fa, 0x42fa, 0x43fa, 0x44fa, 0x45fa, 0x46fa, 0x47fa, 0x081b, 0x1023, 0x102b, 0x1033, 0x103b, 0x113b, 0x1843, 0x1943,
  0x184b, 0x194b, 0x1853, 0x1953, 0x185b, 0x195b, 0x1a5b, 0x2063, 0x2163, 0x2263, 0x206b, 0x216b, 0x226b, 0x2073, 0x2173, 0x2273,
  0x207b, 0x217b, 0x227b, 0x237b, 0x2883, 0x2983, 0x2a83, 0x2b83, 0x288b, 0x298b, 0x2a8b, 0x2b8b, 0x2893, 0x2993, 0x2a93, 0x2b93,
  0x289b, 0x299b, 0x2a9b, 0x2b9b, 0x2c9b, 0x30a3, 0x31a3, 0x32a3, 0x33a3, 0x34a3, 0x30ab, 0x31ab, 0x32ab, 0x33ab, 0x34ab, 0x30b3,
  0x31b3, 0x32b3, 0x33b3, 0x34b3, 0x30bb, 0x31bb, 0x32bb, 0x33bb, 0x34bb, 0x35bb, 0x38c3, 0x39c3, 0x3ac3, 0x3bc3, 0x3cc3, 0x3dc3,
  0x38cb, 0x39cb, 0x3acb, 0x3bcb, 0x3ccb, 0x3dcb, 0x38d3, 0x39d3, 0x3ad3, 0x3bd3, 0x3cd3, 0x3dd3, 0x38db, 0x39db, 0x3adb, 0x3bdb,
  0x3cdb, 0x3ddb, 0x3edb, 0x40e3, 0x41e3, 0x42e3, 0x43e3, 0x44e3, 0x45e3, 0x46e3, 0x40eb, 0x41eb, 0x42eb, 0x43eb, 0x44eb, 0x45eb,
  0x46eb, 0x40f3, 0x41f3, 0x42f3, 0x43f3, 0x44f3, 0x45f3, 0x46f3, 0x40fb, 0x41fb, 0x42fb, 0x43fb, 0x44fb, 0x45fb, 0x46fb, 0x47fb,
  0x081c, 0x1024, 0x102c, 0x1034, 0x103c, 0x113c, 0x1844, 0x1944, 0x184c, 0x194c, 0x1854, 0x1954, 0x185c, 0x195c, 0x1a5c, 0x2064,
  0x2164, 0x2264, 0x206c, 0x216c, 0x226c, 0x2074, 0x2174, 0x2274, 0x207c, 0x217c, 0x227c, 0x237c, 0x2884, 0x2984, 0x2a84, 0x2b84,
  0x288c, 0x298c, 0x2a8c, 0x2b8c, 0x2894, 0x2994, 0x2a94, 0x2b94, 0x289c, 0x299c, 0x2a9c, 0x2b9c, 0x2c9c, 0x30a4, 0x31a4, 0x32a4,
  0x33a4, 0x34a4, 0x30ac, 0x31ac, 0x32ac, 0x33ac, 0x34ac, 0x30b4, 0x31b4, 0x32b4, 0x33b4, 0x34b4, 0x30bc, 0x31bc, 0x32bc, 0x33bc,
  0x34bc, 0x35bc, 0x38c4, 0x39c4, 0x3ac4, 0x3bc4, 0x3cc4, 0x3dc4, 0x38cc, 0x39cc, 0x3acc, 0x3bcc, 0x3ccc, 0x3dcc, 0x38d4, 0x39d4,
  0x3ad4, 0x3bd4, 0x3cd4, 0x3dd4, 0x38dc, 0x39dc, 0x3adc, 0x3bdc, 0x3cdc, 0x3ddc, 0x3edc, 0x40e4, 0x41e4, 0x42e4, 0x43e4, 0x44e4,
  0x45e4, 0x46e4, 0x40ec, 0x41ec, 0x42ec, 0x43ec, 0x44ec, 0x45ec, 0x46ec, 0x40f4, 0x41f4, 0x42f4, 0x43f4, 0x44f4, 0x45f4, 0x46f4,
  0x40fc, 0x41fc, 0x42fc, 0x43fc, 0x44fc, 0x45fc, 0x46fc, 0x47fc, 0x081d, 0x1025, 0x102d, 0x1035, 0x103d, 0x113d, 0x1845, 0x1945,
  0x184d, 0x194d, 0x1855, 0x1955, 0x185d, 0x195d, 0x1a5d, 0x2065, 0x2165, 0x2265, 0x206d, 0x216d, 0x226d, 0x2075, 0x2175, 0x2275,
  0x207d, 0x217d, 0x227d, 0x237d, 0x2885, 0x2985, 0x2a85, 0x2b85, 0x288d, 0x298d, 0x2a8d, 0x2b8d, 0x2895, 0x2995, 0x2a95, 0x2b95,
  0x289d, 0x299d, 0x2a9d, 0x2b9d, 0x2c9d, 0x30a5, 0x31a5, 0x32a5, 0x33a5, 0x34a5, 0x30ad, 0x31ad, 0x32ad, 0x33ad, 0x34ad, 0x30b5,
  0x31b5, 0x32b5, 0x33b5, 0x34b5, 0x30bd, 0x31bd, 0x32bd, 0x33bd, 0x34bd, 0x35bd, 0x38c5, 0x39c5, 0x3ac5, 0x3bc5, 0x3cc5, 0x3dc5,
  0x38cd, 0x39cd, 0x3acd, 0x3bcd, 0x3ccd, 0x3dcd, 0x38d5, 0x39d5, 0x3ad5, 0x3bd5, 0x3cd5, 0x3dd5, 0x38dd, 0x39dd, 0x3add, 0x3bdd,
  0x3cdd, 0x3ddd, 0x3edd, 0x40e5, 0x41e5, 0x42e5, 0x43e5, 0x44e5, 0x45e5, 0x46e5, 0x40ed, 0x41ed, 0x42ed, 0x43ed, 0x44ed, 0x45ed,
  0x46ed, 0x40f5, 0x41f5, 0x42f5, 0x43f5, 0x44f5, 0x45f5, 0x46f5, 0x40fd, 0x41fd, 0x42fd, 0x43fd, 0x44fd, 0x45fd, 0x46fd, 0x47fd,
  0x0810, 0x1130, 0x1a50, 0x2370, 0x2c90, 0x35b0, 0x3ed0, 0x47f0, 0x0811, 0x1131, 0x1a51, 0x2371, 0x2c91, 0x35b1, 0x3ed1, 0x47f1,
  0x0812, 0x1132, 0x1a52, 0x2372, 0x2c92, 0x35b2, 0x3ed2, 0x47f2, 0x0813, 0x1133, 0x1a53, 0x2373, 0x2c93, 0x35b3, 0x3ed3, 0x47f3,
  0x0814, 0x1134, 0x1a54, 0x2374, 0x2c94, 0x35b4, 0x3ed4, 0x47f4, 0x0815, 0x1135, 0x1a55, 0x2375, 0x2c95, 0x35b5, 0x3ed5, 0x47f5,
  0x0808, 0x1128, 0x1a48, 0x2368, 0x2c88, 0x35a8, 0x3ec8, 0x47e8, 0x0809, 0x1129, 0x1a49, 0x2369, 0x2c89, 0x35a9, 0x3ec9, 0x47e9,
  0x080a, 0x112a, 0x1a4a, 0x236a, 0x2c8a, 0x35aa, 0x3eca, 0x47ea, 0x080b, 0x112b, 0x1a4b, 0x236b, 0x2c8b, 0x35ab, 0x3ecb, 0x47eb,
  0x080c, 0x112c, 0x1a4c, 0x236c, 0x2c8c, 0x35ac, 0x3ecc, 0x47ec, 0x080d, 0x112d, 0x1a4d, 0x236d, 0x2c8d, 0x35ad, 0x3ecd, 0x47ed,
  0x0800, 0x1120, 0x1a40, 0x2360, 0x2c80, 0x35a0, 0x3ec0, 0x47e0, 0x0801, 0x1121, 0x1a41, 0x2361, 0x2c81, 0x35a1, 0x3ec1, 0x47e1,
  0x0802, 0x1122, 0x1a42, 0x2362, 0x2c82, 0x35a2, 0x3ec2, 0x47e2, 0x0803, 0x1123, 0x1a43, 0x2363, 0x2c83, 0x35a3, 0x3ec3, 0x47e3,
  0x0804, 0x1124, 0x1a44, 0x2364, 0x2c84, 0x35a4, 0x3ec4, 0x47e4, 0x0805, 0x1125, 0x1a45, 0x2365, 0x2c85, 0x35a5, 0x3ec5, 0x47e5 };
constexpr int N_ITEMS_FOX = 192;
__device__ const unsigned short ITEMS_FOX[192] = {
  0x08f8, 0x08f9, 0x08fa, 0x08fb, 0x08fc, 0x08fd, 0x08f0, 0x08f1, 0x08f2, 0x08f3, 0x08f4, 0x08f5, 0x08e8, 0x08e9, 0x08ea, 0x08eb,
  0x08ec, 0x08ed, 0x08e0, 0x08e1, 0x08e2, 0x08e3, 0x08e4, 0x08e5, 0x08d8, 0x08d9, 0x08da, 0x08db, 0x08dc, 0x08dd, 0x08d0, 0x08d1,
  0x08d2, 0x08d3, 0x08d4, 0x08d5, 0x08c8, 0x08c9, 0x08ca, 0x08cb, 0x08cc, 0x08cd, 0x08c0, 0x08c1, 0x08c2, 0x08c3, 0x08c4, 0x08c5,
  0x08b8, 0x08b9, 0x08ba, 0x08bb, 0x08bc, 0x08bd, 0x08b0, 0x08b1, 0x08b2, 0x08b3, 0x08b4, 0x08b5, 0x08a8, 0x08a9, 0x08aa, 0x08ab,
  0x08ac, 0x08ad, 0x08a0, 0x08a1, 0x08a2, 0x08a3, 0x08a4, 0x08a5, 0x0898, 0x0899, 0x089a, 0x089b, 0x089c, 0x089d, 0x0890, 0x0891,
  0x0892, 0x0893, 0x0894, 0x0895, 0x0888, 0x0889, 0x088a, 0x088b, 0x088c, 0x088d, 0x0880, 0x0881, 0x0882, 0x0883, 0x0884, 0x0885,
  0x0878, 0x0879, 0x087a, 0x087b, 0x087c, 0x087d, 0x0870, 0x0871, 0x0872, 0x0873, 0x0874, 0x0875, 0x0868, 0x0869, 0x086a, 0x086b,
  0x086c, 0x086d, 0x0860, 0x0861, 0x0862, 0x0863, 0x0864, 0x0865, 0x0858, 0x0859, 0x085a, 0x085b, 0x085c, 0x085d, 0x0850, 0x0851,
  0x0852, 0x0853, 0x0854, 0x0855, 0x0848, 0x0849, 0x084a, 0x084b, 0x084c, 0x084d, 0x0840, 0x0841, 0x0842, 0x0843, 0x0844, 0x0845,
  0x0838, 0x0839, 0x083a, 0x083b, 0x083c, 0x083d, 0x0830, 0x0831, 0x0832, 0x0833, 0x0834, 0x0835, 0x0828, 0x0829, 0x082a, 0x082b,
  0x082c, 0x082d, 0x0820, 0x0821, 0x0822, 0x0823, 0x0824, 0x0825, 0x0818, 0x0819, 0x081a, 0x081b, 0x081c, 0x081d, 0x0810, 0x0811,
  0x0812, 0x0813, 0x0814, 0x0815, 0x0808, 0x0809, 0x080a, 0x080b, 0x080c, 0x080d, 0x0800, 0x0801, 0x0802, 0x0803, 0x0804, 0x0805 };
__device__ const unsigned short SCHED_B[256 * 2] = {
  0x0800, 0xffff,
  0x0808, 0xffff,
  0x0810, 0xffff,
  0x0818, 0xffff,
  0x0820, 0xffff,
  0x0828, 0xffff,
  0x0830, 0xffff,
  0x0838, 0xffff,
  0x0840, 0xffff,
  0x0848, 0xffff,
  0x0850, 0xffff,
  0x0858, 0xffff,
  0x0860, 0xffff,
  0x0868, 0xffff,
  0x0870, 0xffff,
  0x0878, 0xffff,
  0x0880, 0xffff,
  0x0888, 0xffff,
  0x0890, 0xffff,
  0x0898, 0xffff,
  0x08a0, 0xffff,
  0x08a8, 0xffff,
  0x08b0, 0xffff,
  0x08b8, 0xffff,
  0x08c0, 0xffff,
  0x08c8, 0xffff,
  0x08d0, 0xffff,
  0x08d8, 0xffff,
  0x08e0, 0xffff,
  0x08e8, 0xffff,
  0x08f0, 0xffff,
  0x08f8, 0xffff,
  0x0801, 0xffff,
  0x0809, 0xffff,
  0x0811, 0xffff,
  0x0819, 0xffff,
  0x0821, 0xffff,
  0x0829, 0xffff,
  0x0831, 0xffff,
  0x0839, 0xffff,
  0x0841, 0xffff,
  0x0849, 0xffff,
  0x0851, 0xffff,
  0x0859, 0xffff,
  0x0861, 0xffff,
  0x0869, 0xffff,
  0x0871, 0xffff,
  0x0879, 0xffff,
  0x0881, 0xffff,
  0x0889, 0xffff,
  0x0891, 0xffff,
  0x0899, 0xffff,
  0x08a1, 0xffff,
  0x08a9, 0xffff,
  0x08b1, 0xffff,
  0x08b9, 0xffff,
  0x08c1, 0xffff,
  0x08c9, 0xffff,
  0x08d1, 0xffff,
  0x08d9, 0xffff,
  0x08e1, 0xffff,
  0x08e9, 0xffff,
  0x08f1, 0xffff,
  0x08f9, 0xffff,
  0x0802, 0xffff,
  0x080a, 0xffff,
  0x0812, 0xffff,
  0x081a, 0xffff,
  0x0822, 0xffff,
  0x082a, 0xffff,
  0x0832, 0xffff,
  0x083a, 0xffff,
  0x0842, 0xffff,
  0x084a, 0xffff,
  0x0852, 0xffff,
  0x085a, 0xffff,
  0x0862, 0xffff,
  0x086a, 0xffff,
  0x0872, 0xffff,
  0x087a, 0xffff,
  0x0882, 0xffff,
  0x088a, 0xffff,
  0x0892, 0xffff,
  0x089a, 0xffff,
  0x08a2, 0xffff,
  0x08aa, 0xffff,
  0x08b2, 0xffff,
  0x08ba, 0xffff,
  0x08c2, 0xffff,
  0x08ca, 0xffff,
  0x08d2, 0xffff,
  0x08da, 0xffff,
  0x08e2, 0xffff,
  0x08ea, 0xffff,
  0x08f2, 0xffff,
  0x08fa, 0xffff,
  0x0803, 0xffff,
  0x080b, 0xffff,
  0x0813, 0xffff,
  0x081b, 0xffff,
  0x0823, 0xffff,
  0x082b, 0xffff,
  0x0833, 0xffff,
  0x083b, 0xffff,
  0x0843, 0xffff,
  0x084b, 0xffff,
  0x0853, 0xffff,
  0x085b, 0xffff,
  0x0863, 0xffff,
  0x086b, 0xffff,
  0x0873, 0xffff,
  0x087b, 0xffff,
  0x0883, 0xffff,
  0x088b, 0xffff,
  0x0893, 0xffff,
  0x089b, 0xffff,
  0x08a3, 0xffff,
  0x08ab, 0xffff,
  0x08b3, 0xffff,
  0x08bb, 0xffff,
  0x08c3, 0xffff,
  0x08cb, 0xffff,
  0x08d3, 0xffff,
  0x08db, 0xffff,
  0x08e3, 0xffff,
  0x08eb, 0xffff,
  0x08f3, 0xffff,
  0x08fb, 0xffff,
  0x0804, 0xffff,
  0x080c, 0xffff,
  0x0814, 0xffff,
  0x081c, 0xffff,
  0x0824, 0xffff,
  0x082c, 0xffff,
  0x0834, 0xffff,
  0x083c, 0xffff,
  0x0844, 0xffff,
  0x084c, 0xffff,
  0x0854, 0xffff,
  0x085c, 0xffff,
  0x0864, 0xffff,
  0x086c, 0xffff,
  0x0874, 0xffff,
  0x087c, 0xffff,
  0x0884, 0xffff,
  0x088c, 0xffff,
  0x0894, 0xffff,
  0x089c, 0xffff,
  0x08a4, 0xffff,
  0x08ac, 0xffff,
  0x08b4, 0xffff,
  0x08bc, 0xffff,
  0x08c4, 0xffff,
  0x08cc, 0xffff,
  0x08d4, 0xffff,
  0x08dc, 0xffff,
  0x08e4, 0xffff,
  0x08ec, 0xffff,
  0x08f4, 0xffff,
  0x08fc, 0xffff,
  0x0805, 0xffff,
  0x080d, 0xffff,
  0x0815, 0xffff,
  0x081d, 0xffff,
  0x0825, 0xffff,
  0x082d, 0xffff,
  0x0835, 0xffff,
  0x083d, 0xffff,
  0x0845, 0xffff,
  0x084d, 0xffff,
  0x0855, 0xffff,
  0x085d, 0xffff,
  0x0865, 0xffff,
  0x086d, 0xffff,
  0x0875, 0xffff,
  0x087d, 0xffff,
  0x0885, 0xffff,
  0x088d, 0xffff,
  0x0895, 0xffff,
  0x089d, 0xffff,
  0x08a5, 0xffff,
  0x08ad, 0xffff,
  0x08b5, 0xffff,
  0x08bd, 0xffff,
  0x08c5, 0xffff,
  0x08cd, 0xffff,
  0x08d5, 0xffff,
  0x08dd, 0xffff,
  0x08e5, 0xffff,
  0x08ed, 0xffff,
  0x08f5, 0xffff,
  0x08fd, 0xffff,
  0xffff, 0xffff,
  0xffff, 0xffff,
  0xffff, 0xffff,
  0xffff, 0xffff,
  0xffff, 0xffff,
  0xffff, 0xffff,
  0xffff, 0xffff,
  0xffff, 0xffff,
  0xffff, 0xffff,
  0xffff, 0xffff,
  0xffff, 0xffff,
  0xffff, 0xffff,
  0xffff, 0xffff,
  0xffff, 0xffff,
  0xffff, 0xffff,
  0xffff, 0xffff,
  0xffff, 0xffff,
  0xffff, 0xffff,
  0xffff, 0xffff,
  0xffff, 0xffff,
  0xffff, 0xffff,
  0xffff, 0xffff,
  0xffff, 0xffff,
  0xffff, 0xffff,
  0xffff, 0xffff,
  0xffff, 0xffff,
  0xffff, 0xffff,
  0xffff, 0xffff,
  0xffff, 0xffff,
  0xffff, 0xffff,
  0xffff, 0xffff,
  0xffff, 0xffff,
  0xffff, 0xffff,
  0xffff, 0xffff,
  0xffff, 0xffff,
  0xffff, 0xffff,
  0xffff, 0xffff,
  0xffff, 0xffff,
  0xffff, 0xffff,
  0xffff, 0xffff,
  0xffff, 0xffff,
  0xffff, 0xffff,
  0xffff, 0xffff,
  0xffff, 0xffff,
  0xffff, 0xffff,
  0xffff, 0xffff,
  0xffff, 0xffff,
  0xffff, 0xffff,
  0xffff, 0xffff,
  0xffff, 0xffff,
  0xffff, 0xffff,
  0xffff, 0xffff,
  0xffff, 0xffff,
  0xffff, 0xffff,
  0xffff, 0xffff,
  0xffff, 0xffff,
  0xffff, 0xffff,
  0xffff, 0xffff,
  0xffff, 0xffff,
  0xffff, 0xffff,
  0xffff, 0xffff,
  0xffff, 0xffff,
  0xffff, 0xffff,
  0xffff, 0xffff };
__device__ const unsigned char T5_BUCKET[128] = { 0, 1, 2, 3, 4, 5, 6, 7, 8, 9, 10, 11, 12, 13, 14, 15, 16, 16, 16, 17, 17, 18, 18, 18, 19, 19, 19, 20, 20, 20, 20, 21, 21, 21, 21, 22, 22, 22, 22, 22, 23, 23, 23, 23, 23, 23, 24, 24, 24, 24, 24, 24, 25, 25, 25, 25, 25, 25, 25, 26, 26, 26, 26, 26, 26, 26, 26, 27, 27, 27, 27, 27, 27, 27, 27, 27, 27, 28, 28, 28, 28, 28, 28, 28, 28, 28, 28, 29, 29, 29, 29, 29, 29, 29, 29, 29, 29, 29, 29, 30, 30, 30, 30, 30, 30, 30, 30, 30, 30, 30, 30, 30, 30, 31, 31, 31, 31, 31, 31, 31, 31, 31, 31, 31, 31, 31, 31, 31 };
struct Args { const float* in[17]; float* out; unsigned char* ws; int step_lo, step_hi, li, pad; };
struct Ctx { LAS unsigned char* lds; int tid, lane, wave, vcu, G; };

#define swz_xor(v, pat) __builtin_bit_cast(float, __builtin_amdgcn_ds_swizzle(__builtin_bit_cast(int, (v)), (pat)))
__device__ __forceinline__ float other_half(float v, int lane) { return __builtin_bit_cast(float, __builtin_amdgcn_ds_bpermute((lane ^ 32) << 2, __builtin_bit_cast(int, v))); }
__device__ __forceinline__ float wave_sum(float v) {
    v += swz_xor(v, 0x041F); v += swz_xor(v, 0x081F); v += swz_xor(v, 0x101F); v += swz_xor(v, 0x201F); v += swz_xor(v, 0x401F);
    return __builtin_bit_cast(float, __builtin_amdgcn_readlane(__builtin_bit_cast(int, v), 0)) + __builtin_bit_cast(float, __builtin_amdgcn_readlane(__builtin_bit_cast(int, v), 32));
}
__device__ __forceinline__ float siluf(float v) { return v / (1.f + __expf(-v)); }
__device__ __forceinline__ float sigmf(float v) { return 1.f / (1.f + __expf(-v)); }

__device__ __forceinline__ void tr_item(const float* W, int ldw, int srccol0, int k0, bf16* WTrow0, int K, LAS float* scr, int lane) {
    { float tv[32]; const float* wp = W + (size_t)(k0 + (lane >> 5)) * ldw + srccol0 + (lane & 31);
#pragma unroll
      for (int i = 0; i < 32; ++i) tv[i] = wp[(size_t)(2 * i) * ldw];
#pragma unroll
      for (int i = 0; i < 32; ++i) scr[(2 * i + (lane >> 5)) * 33 + (lane & 31)] = tv[i]; }
    LDS_WAIT(); asm volatile("" ::: "memory");
    const int c = lane & 7;
#pragma unroll
    for (int j = 0; j < 4; ++j) { const int n = (lane >> 3) + 8 * j; const LAS float* s = scr + (8 * c) * 33 + n;
        v4u o; o.x = pk2(s[0 * 33], s[1 * 33]); o.y = pk2(s[2 * 33], s[3 * 33]); o.z = pk2(s[4 * 33], s[5 * 33]); o.w = pk2(s[6 * 33], s[7 * 33]);
        *(GAS v4u*)(WTrow0 + (size_t)n * K + 8 * c) = o; }
    LDS_WAIT(); asm volatile("" ::: "memory");
}
__device__ __forceinline__ void p0_prologue(const Args& a, const Ctx& C) {
    unsigned char* ws = a.ws;
    LAS float* fl = (LAS float*)C.lds;
    { const float* cvec = a.in[1]; const float* w_ada = a.in[2]; const float* b_ada = a.in[3]; float* mod = (float*)(ws + WS_MOD);
      for (int i = C.tid; i < DM; i += NTHR) fl[i] = siluf(cvec[i]);
      __syncthreads();
      for (int it = C.vcu; it < 768; it += C.G) {
          const int l = it / 192, cb = (it % 192) * 32, col = C.tid & 31, kg = C.tid >> 5;
          const float* w = w_ada + (size_t)l * DM * (3 * DM) + cb + col; float acc = 0.f;
          for (int k = kg * 128; k < kg * 128 + 128; k += 16) { float wv[16];
#pragma unroll
              for (int j = 0; j < 16; ++j) wv[j] = w[(size_t)(k + j) * (3 * DM)];
#pragma unroll
              for (int j = 0; j < 16; ++j) acc += fl[k + j] * wv[j]; }
          fl[2048 + kg * 32 + col] = acc; __syncthreads();
          if (C.tid < 32) { float s = 0.f;
#pragma unroll
              for (int g = 0; g < 16; ++g) s += fl[2048 + g * 32 + C.tid];
              mod[l * 3 * DM + cb + C.tid] = s + b_ada[l * 3 * DM + cb + C.tid]; }
          __syncthreads(); }
    }
    for (int it = C.vcu; it < 64; it += C.G) {
        const int l = it >> 4, kv = (it >> 3) & 1, kc = it & 7, col = C.tid & 255, kh = C.tid >> 8;
        const float* pe = (kv ? a.in[12] : a.in[9]) + l * 4096; const float* w1 = (kv ? a.in[13] : a.in[10]) + (size_t)l * 4096 * 256 + col; float acc = 0.f;
        const int kb = kc * 512 + kh * 256;
        for (int k = kb; k < kb + 256; k += 16) { float wv[16];
#pragma unroll
            for (int j = 0; j < 16; ++j) wv[j] = w1[(size_t)(k + j) * 256];
#pragma unroll
            for (int j = 0; j < 16; ++j) acc += pe[k + j] * wv[j]; }
        __syncthreads(); fl[C.tid] = acc; __syncthreads();
        if (C.tid < 256) ((float*)(ws + WS_B1P))[((l * 2 + kv) * 8 + kc) * 256 + C.tid] = fl[C.tid] + fl[C.tid + 256];
    }
    __syncthreads();
    LAS float* scr = (LAS float*)(C.lds + C.wave * 16384);
    const int gw = C.vcu * NWAVES + C.wave, NGW = C.G * NWAVES;
    constexpr int I_WIN = 32 * 256, I_WOUT = 32 * 64, I_W1 = 64 * 8, I_W2 = 4 * 4, I_L = I_WIN + I_WOUT + 2 * I_W1 + 2 * I_W2;
    for (int it = gw; it < DEPTH * I_L; it += NGW) {
        const int l = it / I_L; int r = it % I_L;
        if (r < I_WIN) { const int kb = r >> 8, nb = r & 255, j0 = nb * 32, src = j0 + (j0 < 4352 ? 0 : (j0 < 7424 ? 6 : 24));
            tr_item(a.in[6] + (size_t)l * DM * NIN, NIN, src, kb * 64, (bf16*)(ws + WS_WIN) + ((size_t)l * NBIG + j0) * DM + kb * 64, DM, scr, C.lane); continue; }
        r -= I_WIN;
        if (r < I_WOUT) { const int kb = r >> 6, nb = r & 63;
            tr_item(a.in[15] + (size_t)l * DM * DM, DM, nb * 32, kb * 64, (bf16*)(ws + WS_WOUT) + ((size_t)l * DM + nb * 32) * DM + kb * 64, DM, scr, C.lane); continue; }
        r -= I_WOUT;
        if (r < 2 * I_W1) { const int kv = r / I_W1, q = r % I_W1, kb = q >> 3, nb = q & 7;
            const float* W = (kv ? a.in[13] : a.in[10]) + (size_t)l * 4096 * 256;
            { float tv[32]; const float* wp = W + (size_t)(kb * 64 + (C.lane >> 5)) * 256 + nb * 32 + (C.lane & 31);
#pragma unroll
              for (int i = 0; i < 32; ++i) tv[i] = wp[(size_t)(2 * i) * 256];
#pragma unroll
              for (int i = 0; i < 32; ++i) scr[(2 * i + (C.lane >> 5)) * 33 + (C.lane & 31)] = tv[i]; }
            LDS_WAIT(); asm volatile("" ::: "memory");
            const int fr = C.lane & 15, fq = C.lane >> 4; bf16* dst = (bf16*)(ws + WS_W1T) + ((size_t)((l * 2 + kv) * 8 + nb) * 2 * 128 * 64) * 8;
#pragma unroll
            for (int t = 0; t < 2; ++t)
#pragma unroll
                for (int ksl = 0; ksl < 2; ++ksl) { const LAS float* sp = scr + (32 * ksl + 8 * fq) * 33 + 16 * t + fr;
                    v4u o; o.x = pk2(sp[0 * 33], sp[1 * 33]); o.y = pk2(sp[2 * 33], sp[3 * 33]); o.z = pk2(sp[4 * 33], sp[5 * 33]); o.w = pk2(sp[6 * 33], sp[7 * 33]);
                    *(GAS v4u*)(dst + ((size_t)(t * 128 + 2 * kb + ksl) * 64 + C.lane) * 8) = o; }
            LDS_WAIT(); asm volatile("" ::: "memory"); continue; }
        r -= 2 * I_W1;
        { const int kv = r / I_W2, q = r % I_W2, kb = q >> 2, nb = q & 3;
            tr_item((kv ? a.in[14] : a.in[11]) + (size_t)l * 256 * 128, 128, nb * 32, kb * 64, (bf16*)(ws + WS_W2T) + ((size_t)(l * 2 + kv) * 128 + nb * 32) * 256 + kb * 64, 256, scr, C.lane); }
    }
    for (int idx = gw * 64 + C.lane; idx < DEPTH * 32 * DM; idx += NGW * 64) {
        const int l = idx / (32 * DM), n = (idx / DM) & 31, k = idx % DM;
        float v = 0.f; if (n < 24) v = a.in[6][(size_t)l * DM * NIN + (size_t)k * NIN + (n < 6 ? 4352 + n : 7430 + (n - 6))];
        ((bf16*)(ws + WS_WSM))[idx] = (bf16)f2bf(v);
    }
}

__device__ __forceinline__ void rowpass(const Args& a, const Ctx& C, int l) {
    unsigned char* ws = a.ws; const float* mod = (const float*)(ws + WS_MOD);
    const float* xin = (l <= 1) ? a.in[0] : a.out; const float* y2 = (const float*)(ws + WS_Y2);
    const int gw = C.vcu * NWAVES + C.wave, NGW = C.G * NWAVES;
    f32x4 a1[8], a2[8], a3[8];
#pragma unroll
    for (int j = 0; j < 8; ++j) { const int c = 4 * C.lane + 256 * j;
        if (l > 0) { const f32x4 g = *(const f32x4*)(mod + (l - 1) * 3 * DM + 2 * DM + c), p = *(const f32x4*)(a.in[5] + (l - 1) * DM + c); a1[j] = g * p; } else a1[j] = (f32x4){0.f, 0.f, 0.f, 0.f};
        if (l < DEPTH) { const f32x4 p = *(const f32x4*)(a.in[4] + l * DM + c), sc = *(const f32x4*)(mod + l * 3 * DM + DM + c); a2[j] = p * (sc + 1.0f); a3[j] = *(const f32x4*)(mod + l * 3 * DM + c); }
        else { a2[j] = (f32x4){0.f, 0.f, 0.f, 0.f}; a3[j] = a2[j]; } }
    for (int m = gw; m < S; m += NGW) {
        f32x4 x[8];
#pragma unroll
        for (int j = 0; j < 8; ++j) x[j] = *(const f32x4*)(xin + (size_t)m * DM + 4 * C.lane + 256 * j);
        if (l > 0) {
            f32x4 y[8]; float ss = 0.f;
#pragma unroll
            for (int j = 0; j < 8; ++j) { y[j] = *(const f32x4*)(y2 + (size_t)m * DM + 4 * C.lane + 256 * j); ss += (y[j].x * y[j].x + y[j].y * y[j].y) + (y[j].z * y[j].z + y[j].w * y[j].w); }
            const float rs = __builtin_amdgcn_rsqf(wave_sum(ss) * (1.f / DM) + NORM_EPS);
#pragma unroll
            for (int j = 0; j < 8; ++j) { x[j] = x[j] + a1[j] * (y[j] * rs); *(f32x4*)(a.out + (size_t)m * DM + 4 * C.lane + 256 * j) = x[j]; }
        }
        if (l < DEPTH) {
            float ss = 0.f;
#pragma unroll
            for (int j = 0; j < 8; ++j) ss += (x[j].x * x[j].x + x[j].y * x[j].y) + (x[j].z * x[j].z + x[j].w * x[j].w);
            const float rs = __builtin_amdgcn_rsqf(wave_sum(ss) * (1.f / DM) + NORM_EPS);
            bf16* hrow = (bf16*)(ws + WS_H) + (size_t)m * DM;
#pragma unroll
            for (int j = 0; j < 8; ++j) { const f32x4 hv = (x[j] * rs) * a2[j] + a3[j];
                *(unsigned long long*)(hrow + 4 * C.lane + 256 * j) = (unsigned long long)pk2(hv.x, hv.y) | ((unsigned long long)pk2(hv.z, hv.w) << 32); }
        }
    }
}

typedef float f32x4m __attribute__((ext_vector_type(4)));
__device__ __forceinline__ void small_unit(const Args& a, const Ctx& C, int l, int u) {
    const bf16* H = (const bf16*)(a.ws + WS_H); const bf16* W = (const bf16*)(a.ws + WS_WSM) + (size_t)l * 32 * DM; float* out = (float*)(a.ws + WS_SMALL);
    const int mt = C.wave & 3, nt = C.wave >> 2, fr = C.lane & 15, fq = C.lane >> 4, r0 = u * 64 + mt * 16;
    const bf16* ap = H + (size_t)(r0 + fr) * DM + 8 * fq; const bf16* bp = W + (size_t)(nt * 16 + fr) * DM + 8 * fq;
    f32x4 acc = {0.f, 0.f, 0.f, 0.f};
#pragma unroll 8
    for (int k0 = 0; k0 < DM; k0 += 32) { const bf16x8 av = *(const bf16x8*)(ap + k0), bv = *(const bf16x8*)(bp + k0); acc = __builtin_amdgcn_mfma_f32_16x16x32_bf16(av, bv, acc, 0, 0, 0); }
#pragma unroll
    for (int i = 0; i < 4; ++i) out[(size_t)(r0 + 4 * fq + i) * 32 + nt * 16 + fr] = acc[i];
    if (nt == 0 && fr < 6) *(f32x4*)((float*)(a.ws + WS_FT) + (size_t)fr * S + r0 + 4 * fq) = acc;
}
__device__ __forceinline__ void build_t5(char* ldsg, const float* relb, int tid) {
    float* T = (float*)(ldsg + att::LDS_T5);
    for (int i = tid; i < 6 * 129; i += NTHR) { const int h = i / 129, d = i % 129; const float c31 = relb[31 * 6 + h];
        T[h * 132 + d] = (d < 128 ? (relb[(int)T5_BUCKET[d < 128 ? d : 127] * 6 + h] - c31) : c31) * (1.0f / SM_SCALE); }
    __syncthreads();
}
__device__ __forceinline__ att::BlockRef make_ref(unsigned char* ws, int mode, unsigned item, int ja_override) {
    att::BlockRef r; const att::bf16* P = (const att::bf16*)(ws + WS_ATT); constexpr size_t PL = (size_t)S * 128;
    const int h = item & 7, qb = (item >> 3) & 31, chunk = (item >> 8) & 7, nch = (item >> 11) & 15;
    const int qp = (mode == att::MODE_FOX) ? HP_QF + h : HP_QN + h;
    const int kp = (mode == att::MODE_FOX) ? HP_KF + h : ((mode == att::MODE_WIN) ? HP_KW + h / 3 : HP_KS + h / 3);
    const int vp = (mode == att::MODE_FOX) ? HP_VF + h : ((mode == att::MODE_WIN) ? HP_VW + h / 3 : HP_VS + h / 3);
    r.Q = P + qp * PL + (size_t)qb * 256 * 128; r.K = P + kp * PL; r.V = P + vp * PL;
    r.bias = (mode == att::MODE_FOX) ? (const float*)(ws + WS_BIASF) + (size_t)h * S : nullptr;
    r.P0 = qb * 256; r.W = (mode == att::MODE_WIN) ? 512 : att::WBIG; r.h = h; r.mode = mode;
    const int nt = 4 * (qb + 1);
    if (mode == att::MODE_WIN) { r.ja = att::swa_jlo(r.P0, 512); r.jb = nt; }
    else if (mode == att::MODE_FOX) { r.ja = ja_override; r.jb = nt; }
    else { r.ja = SLC_CHUNK * chunk; r.jb = (SLC_CHUNK * chunk + SLC_CHUNK < nt) ? SLC_CHUNK * chunk + SLC_CHUNK : nt; }
    r.bid = h * 32 + qb; r.chunk = chunk; r.nch = nch; return r;
}
__device__ __forceinline__ att::Aux make_aux(unsigned char* ws, int l, volatile unsigned* ldsflag, int rep = 0) {
    att::Aux X; X.biasF = (const float*)(ws + WS_BIASF); X.selm = (const unsigned*)(ws + WS_SELM); X.small = (const float*)(ws + WS_SMALL);
    X.zf = (const att::bf16*)(ws + WS_ZF); X.zn = (const att::bf16*)(ws + WS_ZN); X.oc = (const att::bf16*)(ws + WS_OC); X.ow = (att::bf16*)(ws + WS_OW); X.y = (att::bf16*)(ws + WS_Y);
    X.part_o = (float*)(ws + WS_PARTO); X.part_ml = (float*)(ws + WS_PARTML); X.arr = (unsigned*)(ws + WS_CTL) + CW_ARR + 256 * l + 1024 * rep; X.ldsflag = ldsflag; return X;
}
__device__ __forceinline__ int fox_prune(unsigned char* ws, int l, int h, int qb, int lane) {
    const unsigned* nm = (const unsigned*)(ws + WS_CTL) + CW_NORM + 64 * l;
    const float qn = __builtin_bit_cast(float, __hip_atomic_load(nm + h, __ATOMIC_RELAXED, __HIP_MEMORY_SCOPE_AGENT)), kn = __builtin_bit_cast(float, __hip_atomic_load(nm + 8 + h, __ATOMIC_RELAXED, __HIP_MEMORY_SCOPE_AGENT));
    const float B2 = 2.f * __builtin_sqrtf(qn * kn) * SM_SCALE + 30.f;
    const float* bf = (const float*)(ws + WS_BIASF) + (size_t)h * S; const int nt = 4 * (qb + 1);
    const float c0 = -bf[qb * 256] * SM_SCALE;
    const int j0 = lane, j1 = lane + 64;
    const bool k0 = (j0 < nt) && !(c0 + bf[64 * (j0 < nt ? j0 : 0) + 63] * SM_SCALE + B2 < 0.f);
    const bool k1 = (j1 < nt) && !(c0 + bf[64 * (j1 < nt ? j1 : 0) + 63] * SM_SCALE + B2 < 0.f);
    const unsigned long long m0 = __ballot(k0), m1 = __ballot(k1);
    int jp = m0 ? (int)__builtin_ctzll(m0) : (m1 ? 64 + (int)__builtin_ctzll(m1) : nt - 1);
    return jp < nt - 4 ? jp : nt - 4;
}
__device__ __forceinline__ unsigned q_fetch(unsigned* head, volatile LAS unsigned* slot, int tid) {
    if (tid == 0) *slot = __hip_atomic_fetch_add(head, 1u, __ATOMIC_RELAXED, __HIP_MEMORY_SCOPE_AGENT);
    __syncthreads(); const unsigned v = *slot; __syncthreads(); return v;
}
template <int MODE>
__device__ __forceinline__ void attn_stream(unsigned char* ws, char* ldsg, int l, volatile LAS unsigned* misc, const unsigned short* list, int tid) {
    unsigned code = list[0]; if (code == 0xFFFFu) return;
    const att::Aux X = make_aux(ws, l, (volatile unsigned*)(misc + 1));
    att::BlockRef cur = make_ref(ws, MODE, code, 0); att::Seam Sm;
    att::attn_prime(cur, ldsg, Sm, tid);
    for (int i = 1;; ++i) {
        const unsigned nc = list[i]; const bool last = (nc == 0xFFFFu);
        const att::BlockRef nxt = last ? cur : make_ref(ws, MODE, nc, 0);
        att::attn_block<MODE>(cur, nxt, X, ldsg, Sm, tid);
        if (last) break;
        cur = nxt;
    }
}
template <int MODE>
__device__ __forceinline__ void attn_stream_q(unsigned char* ws, char* ldsg, int l, volatile LAS unsigned* misc, const unsigned short* items, int nitems, unsigned* head, int tid, int rep) {
    unsigned idx = q_fetch(head, misc, tid); if (idx >= (unsigned)nitems) return;
    const att::Aux X = make_aux(ws, l, (volatile unsigned*)(misc + 1), rep);
    unsigned it = items[idx];
    att::BlockRef cur = make_ref(ws, MODE, it, MODE == att::MODE_FOX ? fox_prune(ws, l, it & 7, (it >> 3) & 31, tid & 63) : 0); att::Seam Sm;
    att::attn_prime(cur, ldsg, Sm, tid);
    for (;;) {
        idx = q_fetch(head, misc, tid); const bool last = idx >= (unsigned)nitems;
        it = last ? 0u : items[idx];
        const att::BlockRef nxt = last ? cur : make_ref(ws, MODE, it, MODE == att::MODE_FOX ? fox_prune(ws, l, it & 7, (it >> 3) & 31, tid & 63) : 0);
        att::attn_block<MODE>(cur, nxt, X, ldsg, Sm, tid);
        if (last) break;
        cur = nxt;
    }
}
__device__ __forceinline__ void fox_norms(unsigned char* ws, int l, int wslot, int nslots, int lane_in) {
    int lane = lane_in; asm volatile("" : "+v"(lane));
    const bf16* P = (const bf16*)(ws + WS_ATT); unsigned* nm = (unsigned*)(ws + WS_CTL) + CW_NORM + 64 * l;
    for (int pl = 0; pl < 12; ++pl) { const bf16* base = P + (size_t)(pl < 6 ? HP_QF + pl : HP_KF + pl - 6) * S * 128; float mx = 0.f;
        for (int r4 = wslot; r4 < S / 4; r4 += nslots) { const bf16x8 v = *(const bf16x8*)(base + (size_t)(r4 * 4 + (lane >> 4)) * 128 + (lane & 15) * 8); float ss = 0.f;
#pragma unroll
            for (int j = 0; j < 8; ++j) { const float f = __builtin_bit_cast(float, (unsigned)(unsigned short)v[j] << 16); ss += f * f; }
            ss += swz_xor(ss, 0x041F); ss += swz_xor(ss, 0x081F); ss += swz_xor(ss, 0x101F); ss += swz_xor(ss, 0x201F);
            mx = fmaxf(mx, ss); }
        mx = fmaxf(mx, swz_xor(mx, 0x401F)); mx = fmaxf(mx, __builtin_bit_cast(float, __builtin_amdgcn_readlane(__builtin_bit_cast(int, mx), 32)));
        if (lane == 0) atomicMax(nm + (pl < 6 ? pl : 8 + pl - 6), __builtin_bit_cast(unsigned, mx)); }
}
__device__ __forceinline__ void conv_phase(const Args& a, const Ctx& C, int l) {
    const bf16* cv = (const bf16*)(a.ws + WS_CONV); bf16* Y = (bf16*)(a.ws + WS_Y); const float* cw = a.in[8] + l * 3 * 512;
    for (int idx = C.vcu * NTHR + C.tid; idx < S * 64; idx += C.G * NTHR) {
        const int s = idx >> 6, c = (idx & 63) * 8; float z[8];
#pragma unroll
        for (int e = 0; e < 8; ++e) z[e] = 0.f;
#pragma unroll
        for (int j = 0; j < 3; ++j) { const int t = s + j - 2; if (t >= 0) { const v4u uu = *(const v4u*)(cv + (size_t)t * 2048 + c), gg = *(const v4u*)(cv + (size_t)t * 2048 + 1024 + c);
#pragma unroll
            for (int e = 0; e < 4; ++e) { const unsigned uw = uu[e], gw = gg[e];
                z[2 * e] += cw[j * 512 + c + 2 * e] * (att::bflo(gw) * att::bflo(uw)); z[2 * e + 1] += cw[j * 512 + c + 2 * e + 1] * (att::bfhi(gw) * att::bfhi(uw)); } } }
        const v4u bb = *(const v4u*)(cv + (size_t)s * 2048 + 512 + c), zz = *(const v4u*)(cv + (size_t)s * 2048 + 1536 + c); v4u o;
#pragma unroll
        for (int e = 0; e < 4; ++e) o[e] = pk2(att::bflo(bb[e]) * z[2 * e] * siluf(att::bflo(zz[e])), att::bfhi(bb[e]) * z[2 * e + 1] * siluf(att::bfhi(zz[e])));
        *(v4u*)(Y + (size_t)s * 2048 + c) = o;
    }
}
__device__ __forceinline__ void mlp_unit(const Args& a, const Ctx& C, int l, int u) {
    unsigned char* ws = a.ws; const int kv = u >> 6, g = (u >> 5) & 1, nb = u & 31, fr = C.lane & 15, fq = C.lane >> 4, w = C.wave;
    const bf16* src = (const bf16*)(ws + WS_ATT) + (size_t)((kv ? HP_VC : HP_KC) + g) * S * 128 + (size_t)(256 * nb) * 128;
    LAS unsigned char* As = C.lds; LAS bf16* hid = (LAS bf16*)(C.lds + 69632);
    __syncthreads();
    for (int ch = C.tid; ch < 4352; ch += NTHR) { const int R = ch >> 4, c = ch & 15; *(LAS v4u*)(As + R * 256 + ((c ^ ((R >> 4) & 15)) << 4)) = *(const v4u*)(src + (size_t)ch * 8); }
    __syncthreads();
    const bf16* bp = (const bf16*)(ws + WS_W1T) + ((size_t)((l * 2 + kv) * 8 + w) * 2 * 128 * 64 + C.lane) * 8;
    f32x4 acc0 = {0.f, 0.f, 0.f, 0.f}, acc1 = acc0;
    for (int ks0 = 0; ks0 < 128; ks0 += 8) { bf16x8 b0[8], b1[8], av[8];
#pragma unroll
        for (int j = 0; j < 8; ++j) { b0[j] = *(const bf16x8*)(bp + (size_t)(ks0 + j) * 512); b1[j] = *(const bf16x8*)(bp + (size_t)(128 + ks0 + j) * 512); }
#pragma unroll
        for (int j = 0; j < 8; ++j) { const int ks = ks0 + j, R = 16 * fr + (ks >> 2), c = 4 * (ks & 3) + fq; av[j] = *(const LAS bf16x8*)(As + R * 256 + ((c ^ ((R >> 4) & 15)) << 4)); }
#pragma unroll
        for (int j = 0; j < 8; ++j) { acc0 = __builtin_amdgcn_mfma_f32_16x16x32_bf16(av[j], b0[j], acc0, 0, 0, 0); acc1 = __builtin_amdgcn_mfma_f32_16x16x32_bf16(av[j], b1[j], acc1, 0, 0, 0); } }
    const float* b1p = (const float*)(ws + WS_B1P) + (size_t)(l * 2 + kv) * 8 * 256; float bs0 = 0.f, bs1 = 0.f;
#pragma unroll
    for (int cchunk = 0; cchunk < 8; ++cchunk) { bs0 += b1p[cchunk * 256 + 32 * w + fr]; bs1 += b1p[cchunk * 256 + 32 * w + 16 + fr]; }
#pragma unroll
    for (int i = 0; i < 4; ++i) { hid[(4 * fq + i) * 264 + 32 * w + fr] = (bf16)f2bf(siluf(acc0[i] + bs0)); hid[(4 * fq + i) * 264 + 32 * w + 16 + fr] = (bf16)f2bf(siluf(acc1[i] + bs1)); }
    __syncthreads();
    const bf16* w2t = (const bf16*)(ws + WS_W2T) + (size_t)(l * 2 + kv) * 128 * 256 + (size_t)(16 * w + fr) * 256 + 8 * fq;
    f32x4 acc = {0.f, 0.f, 0.f, 0.f};
#pragma unroll
    for (int k0 = 0; k0 < 256; k0 += 32) { const bf16x8 av = *(const LAS bf16x8*)(hid + fr * 264 + k0 + 8 * fq), bv = *(const bf16x8*)(w2t + k0); acc = __builtin_amdgcn_mfma_f32_16x16x32_bf16(av, bv, acc, 0, 0, 0); }
    if (kv == 0) { bf16* kc = (bf16*)(ws + WS_KCMP) + (size_t)g * 512 * 128;
#pragma unroll
        for (int i = 0; i < 4; ++i) kc[(size_t)(16 * nb + 4 * fq + i) * 128 + 16 * w + fr] = (bf16)f2bf(acc[i]); }
    else { bf16* vt = (bf16*)(ws + WS_VCMPT) + (size_t)g * 128 * 512 + (size_t)(16 * w + fr) * 512 + 16 * nb + 4 * fq;
        *(unsigned long long*)vt = (unsigned long long)pk2(acc[0], acc[1]) | ((unsigned long long)pk2(acc[2], acc[3]) << 32); }
    __syncthreads();
}
__device__ __forceinline__ float logsig(float v) { const float e = __builtin_amdgcn_exp2f(-fabsf(v) * 1.4426950408889634f); return fminf(v, 0.f) - __builtin_amdgcn_logf(1.f + e) * 0.6931471805599453f; }
__device__ __forceinline__ void scan_head(const Args& a, int l, int h, int lane_in) {
    int lane = lane_in; asm volatile("" : "+v"(lane));
    const f32x4* src = (const f32x4*)((const float*)(a.ws + WS_FT) + (size_t)h * S + lane * 128); f32x4* out = (f32x4*)((float*)(a.ws + WS_BIASF) + (size_t)h * S + lane * 128); const float b = a.in[7][l * 6 + h];
    float loc = 0.f;
    for (int c = 0; c < 8; ++c) { f32x4 v[4];
#pragma unroll
        for (int i = 0; i < 4; ++i) v[i] = src[c * 4 + i];
#pragma unroll
        for (int i = 0; i < 4; ++i) loc += (logsig(v[i].x + b) + logsig(v[i].y + b)) + (logsig(v[i].z + b) + logsig(v[i].w + b)); }
    float inc = loc;
#pragma unroll
    for (int o = 1; o < 64; o <<= 1) { const int sl = lane >= o ? lane - o : lane; const float t = __builtin_bit_cast(float, __builtin_amdgcn_ds_bpermute(sl << 2, __builtin_bit_cast(int, inc))); if (lane >= o) inc += t; }
    float run = inc - loc;
    for (int c = 0; c < 8; ++c) { f32x4 v[4];
#pragma unroll
        for (int i = 0; i < 4; ++i) v[i] = src[c * 4 + i];
#pragma unroll
        for (int i = 0; i < 4; ++i) { f32x4 o4; run += logsig(v[i].x + b); o4.x = -run * (1.0f / SM_SCALE); run += logsig(v[i].y + b); o4.y = -run * (1.0f / SM_SCALE);
            run += logsig(v[i].z + b); o4.z = -run * (1.0f / SM_SCALE); run += logsig(v[i].w + b); o4.w = -run * (1.0f / SM_SCALE); out[c * 4 + i] = o4; } }
}
typedef float f32x16 __attribute__((ext_vector_type(16)));
__device__ __forceinline__ void cmp_head(const Args& a, int g, int r, int qt, LAS float* impw, const LAS float* T5, int lane_in) {
    int lane = lane_in; asm volatile("" : "+v"(lane));
    unsigned char* ws = a.ws; const int r32 = lane & 31, hi = lane >> 5, q = 32 * qt + r32, ntile = qt / 16 + 1;
    constexpr float C2 = 1.4426950408889634f * SM_SCALE; const float NEG = -__builtin_inff();
    for (int i = lane; i < 32 * 130; i += 64) impw[i] = 0.f;
    asm volatile("s_waitcnt lgkmcnt(0)" ::: "memory");
    const bf16* kc = (const bf16*)(ws + WS_KCMP) + (size_t)g * 512 * 128 + (size_t)r32 * 128 + 8 * hi; const bf16* vt = (const bf16*)(ws + WS_VCMPT) + (size_t)g * 128 * 512 + (size_t)r32 * 512 + 4 * hi;
    const int h = 3 * g + r; const LAS float* Td = T5 + h * 132; const float c31 = Td[128];
    const bf16* qp = (const bf16*)(ws + WS_ATT) + (size_t)(HP_QN + h) * S * 128 + (size_t)q * 128 + 8 * hi;
    bf16x8 qr[8];
#pragma unroll
    for (int d0 = 0; d0 < 8; ++d0) qr[d0] = *(const bf16x8*)(qp + d0 * 16);
    bf16x8 kA[8], kB[8];
#define KLOAD(kf, jt) do { const int jc_ = (jt) < ntile ? (jt) : ntile - 1; const bf16* kp_ = kc + (size_t)(32 * jc_) * 128;  \
        _Pragma("unroll") for (int d0 = 0; d0 < 8; ++d0) kf[d0] = *(const bf16x8*)(kp_ + d0 * 16); } while (0)
#define CMP_SCORES(sc, kf, jt) do { _Pragma("unroll") for (int e = 0; e < 16; ++e) sc[e] = c31;                                     \
        _Pragma("unroll") for (int d0 = 0; d0 < 8; ++d0) sc = __builtin_amdgcn_mfma_f32_32x32x16_bf16(kf[d0], qr[d0], sc, 0, 0, 0);  \
        if (512 * (jt) + 527 + 113 > 32 * qt) {              \
            _Pragma("unroll") for (int e = 0; e < 16; ++e) { const int n_ = 32 * (jt) + att::crow(e, hi), dist_ = q - 16 * n_ - 31;  \
                const float tv_ = Td[dist_ < 0 ? 0 : (dist_ > 127 ? 127 : dist_)]; sc[e] = dist_ < 0 ? NEG : sc[e] + tv_; } } } while (0)
    float m = -1e30f, lsum = 0.f;
#define PASS1(kf, jt) do { f32x16 sc; CMP_SCORES(sc, kf, jt); float mx = sc[0];                                                      \
        _Pragma("unroll") for (int e = 1; e < 16; ++e) mx = fmaxf(mx, sc[e]);                                                        \
        const float mn = fmaxf(m, mx); float ps = 0.f;                                                                               \
        _Pragma("unroll") for (int e = 0; e < 16; ++e) ps += __builtin_amdgcn_exp2f((sc[e] - mn) * C2);                              \
        lsum = lsum * __builtin_amdgcn_exp2f((m - mn) * C2) + ps; m = mn; } while (0)
    KLOAD(kA, 0);
    for (int jt = 0; jt < ntile; jt += 2) { KLOAD(kB, jt + 1); PASS1(kA, jt); KLOAD(kA, jt + 2); if (jt + 1 < ntile) PASS1(kB, jt + 1); }
    { const float mo = other_half(m, lane), lo = other_half(lsum, lane); const float M = fmaxf(m, mo);
      lsum = lsum * __builtin_amdgcn_exp2f((m - M) * C2) + lo * __builtin_amdgcn_exp2f((mo - M) * C2); m = M; }
    const float inv = lsum > 0.f ? 1.f / lsum : 0.f;
    f32x16 oT[4];
#pragma unroll
    for (int d = 0; d < 4; ++d)
#pragma unroll
        for (int e = 0; e < 16; ++e) oT[d][e] = 0.f;
#define PASS2(kf, jt) do { f32x16 sc; CMP_SCORES(sc, kf, jt);                                                                        \
        unsigned long long vlo[4], vhh[4];                                                                                           \
        _Pragma("unroll") for (int d = 0; d < 2; ++d) _Pragma("unroll") for (int s2 = 0; s2 < 2; ++s2) { const bf16* vp = vt + (size_t)(32 * d) * 512 + 32 * (jt) + 16 * s2; \
            vlo[d * 2 + s2] = *(const unsigned long long*)vp; vhh[d * 2 + s2] = *(const unsigned long long*)(vp + 8); }              \
        _Pragma("unroll") for (int e = 0; e < 16; ++e) sc[e] = __builtin_amdgcn_exp2f((sc[e] - m) * C2) * inv;                        \
        asm volatile("" ::: "memory");                                                                                               \
        _Pragma("unroll") for (int c = 0; c < 4; ++c) { LAS float* ip = impw + r32 * 130 + 8 * (jt) + 2 * c + hi; ip[0] += (sc[4 * c] + sc[4 * c + 1]) + (sc[4 * c + 2] + sc[4 * c + 3]); } \
        asm volatile("s_waitcnt lgkmcnt(0)" ::: "memory");                                                                           \
        _Pragma("unroll") for (int c = 0; c < 4; ++c) { LAS float* ip = impw + r32 * 130 + 8 * (jt) + 2 * c + hi + 1; ip[0] += sc[4 * c + 3]; } \
        asm volatile("s_waitcnt lgkmcnt(0)" ::: "memory");                                                                           \
        bf16x8 pb[2];                                                                                                                \
        _Pragma("unroll") for (int s2 = 0; s2 < 2; ++s2) { att::u32x4 wv = {att::cvtpk(sc[8 * s2], sc[8 * s2 + 1]), att::cvtpk(sc[8 * s2 + 2], sc[8 * s2 + 3]), att::cvtpk(sc[8 * s2 + 4], sc[8 * s2 + 5]), att::cvtpk(sc[8 * s2 + 6], sc[8 * s2 + 7])}; pb[s2] = *reinterpret_cast<bf16x8*>(&wv); } \
        _Pragma("unroll") for (int dh = 0; dh < 2; ++dh) {                                                                           \
            _Pragma("unroll") for (int d2 = 0; d2 < 2; ++d2) _Pragma("unroll") for (int s2 = 0; s2 < 2; ++s2) { const int d = 2 * dh + d2;  \
                att::u32x4 av = {(unsigned)vlo[d2 * 2 + s2], (unsigned)(vlo[d2 * 2 + s2] >> 32), (unsigned)vhh[d2 * 2 + s2], (unsigned)(vhh[d2 * 2 + s2] >> 32)}; \
                oT[d] = __builtin_amdgcn_mfma_f32_32x32x16_bf16(*reinterpret_cast<bf16x8*>(&av), pb[s2], oT[d], 0, 0, 0); }          \
            if (dh == 0) { _Pragma("unroll") for (int d2 = 0; d2 < 2; ++d2) _Pragma("unroll") for (int s2 = 0; s2 < 2; ++s2) { const bf16* vp = vt + (size_t)(32 * (2 + d2)) * 512 + 32 * (jt) + 16 * s2; \
                vlo[d2 * 2 + s2] = *(const unsigned long long*)vp; vhh[d2 * 2 + s2] = *(const unsigned long long*)(vp + 8); } } } } while (0)
    KLOAD(kA, 0);
    for (int jt = 0; jt < ntile; jt += 2) { KLOAD(kB, jt + 1); PASS2(kA, jt); KLOAD(kA, jt + 2); if (jt + 1 < ntile) PASS2(kB, jt + 1); }
#undef PASS2
#undef PASS1
#undef CMP_SCORES
#undef KLOAD
    const float gc = sigmf(((const float*)(ws + WS_SMALL))[(size_t)q * 32 + 6 + 3 * h]);
    bf16* op = (bf16*)(ws + WS_OC) + ((size_t)h * S + q) * 128;
#pragma unroll
    for (int d = 0; d < 4; ++d)
#pragma unroll
        for (int c = 0; c < 4; ++c) *(unsigned long long*)(op + 32 * d + 8 * c + 4 * hi) =
            (unsigned long long)pk2(oT[d][4 * c] * gc, oT[d][4 * c + 1] * gc) | ((unsigned long long)pk2(oT[d][4 * c + 2] * gc, oT[d][4 * c + 3] * gc) << 32);
    asm volatile("s_waitcnt lgkmcnt(0)" ::: "memory");
}
__device__ __forceinline__ void cmp_topk(const Args& a, int g, int qt, const LAS float* imp3, int lane_in) {
    int lane = lane_in; asm volatile("" : "+v"(lane));
    const int r32 = lane & 31, hi = lane >> 5, q = 32 * qt + r32;
    const int own = q >> 6; float t[13];
#pragma unroll
    for (int i = 0; i < 13; ++i) t[i] = -1.f;
    const LAS float* ip = imp3 + r32 * 130 + 64 * hi;
    for (int j = 0; j < 64; ++j) { const int Mi = 64 * hi + j; float x = (ip[j] + ip[j + 4160]) + ip[j + 8320];
        if (Mi > own || Mi == 0 || Mi == own || Mi == own - 1) x = -1.f;
#pragma unroll
        for (int i = 0; i < 13; ++i) { const float hv = fmaxf(t[i], x); x = fminf(t[i], x); t[i] = hv; } }
    float thr = fmaxf(other_half(t[12], lane), t[12]);
#pragma unroll
    for (int i = 1; i < 13; ++i) thr = fmaxf(thr, fminf(t[i - 1], other_half(t[12 - i], lane)));
    if (own < 16) thr = -1.f;
    unsigned w0 = 0u, w1 = 0u;
    for (int j = 0; j < 64; ++j) { const int Mi = 64 * hi + j; const float x = (ip[j] + ip[j + 4160]) + ip[j + 8320];
        const bool elig = Mi <= own, forced = (Mi == 0) || (Mi == own) || (Mi == own - 1);
        const unsigned bit = (elig && (forced || x >= thr)) ? 1u : 0u;
        if (j < 32) w0 |= bit << j; else w1 |= bit << (j - 32); }
    unsigned* sm = (unsigned*)(a.ws + WS_SELM) + ((size_t)g * S + q) * 4 + 2 * hi;
    *(unsigned long long*)sm = (unsigned long long)w0 | ((unsigned long long)w1 << 32);
}
__global__ void __launch_bounds__(NTHR, 2) skel_fwd(Args a_) {
    extern __shared__ __attribute__((aligned(16))) unsigned char lds_[];
    char* ldsg = (char*)lds_;
    Ctx C; C.lds = (LAS unsigned char*)lds_; C.tid = threadIdx.x; C.lane = C.tid & 63; C.wave = __builtin_amdgcn_readfirstlane((int)threadIdx.x >> 6);
    C.G = gridDim.x; { const int bx = blockIdx.x; C.vcu = (C.G % 8 == 0) ? (bx % 8) * (C.G / 8) + bx / 8 : bx; }
    for (int u = threadIdx.x; u < (LDS_BYTES - LDSCTL_OFF) / 4; u += NTHR) ((LAS unsigned*)(C.lds + LDSCTL_OFF))[u] = 0u;
    __syncthreads();
    XcdBarrier bar = xcd_barrier_post((unsigned*)(a_.ws + WS_CTL) + CW_BAR + a_.li * XCD_BAR_WORDS, (volatile LAS unsigned*)(C.lds + MISC_OFF) + 8);
    const int step_hi = a_.step_hi; int rep_done = -1;
    for (int st = a_.step_lo; st < step_hi; ++st) {
        { int l_; asm volatile("v_mbcnt_lo_u32_b32 %0, -1, 0\n\tv_mbcnt_hi_u32_b32 %0, -1, %0" : "=v"(l_)); C.lane = l_; C.tid = C.wave * 64 + l_; }
        const Args& a = a_;
        unsigned char* ws = a.ws;
        if (st == 0) p0_prologue(a, C);
        else if (st == 1) rowpass(a, C, 0);
        else {
            const int l = (st - 2) / NPH, ph = (st - 2) % NPH;
            if (ph == 0) {
                pg8::Gemm g{(const pg8::bf16_t*)(ws + WS_H), (const pg8::bf16_t*)(ws + WS_WIN) + (size_t)l * NBIG * DM, S, NBIG, DM};
                pg8::StaticOrder So; So.init(S, NBIG, C.G, (int)blockIdx.x);
                pg8::EpiProj E{(pg8::bf16_t*)(ws + WS_CONV), (pg8::bf16_t*)(ws + WS_ZF), (pg8::bf16_t*)(ws + WS_ZN), (pg8::bf16_t*)(ws + WS_ATT)};
                pg8::gemm_phase<pg8::EpiProj, pg8::StaticOrder, true, true>(C.lds, g, So, E, C.tid);
                for (int u = C.vcu; u < 128; u += C.G) small_unit(a, C, l, u);
            } else if (ph == 1) {
                build_t5(ldsg, a.in[16], C.tid);
                if (C.vcu < 256) attn_stream<att::MODE_WIN>(ws, ldsg, l, (volatile LAS unsigned*)(C.lds + MISC_OFF) + 16, SCHED_B + C.vcu * 2, C.tid);
                if (C.vcu >= 192) { mlp_unit(a, C, l, C.vcu - 192); mlp_unit(a, C, l, C.vcu - 192 + 64); }
                conv_phase(a, C, l);
#if STEP_LEVEL >= 3
            } else if (ph == 2) {
                build_t5(ldsg, a.in[16], C.tid);
                if (C.wave == 6 && C.vcu < 6) scan_head(a, l, C.vcu, C.lane);
                if (C.wave >= 6) fox_norms(ws, l, C.vcu * 2 + (C.wave - 6), C.G * 2, C.lane);
                for (int ub = C.vcu; ub < 256; ub += C.G) {
                    if (C.wave < 6) { const int g = C.wave >= 3 ? 1 : 0, r = C.wave - 3 * g, qt = g ? 255 - ub : ub;
                        cmp_head(a, g, r, qt, (LAS float*)(C.lds) + C.wave * 4160, (const LAS float*)(C.lds + att::LDS_T5), C.lane); }
                    __syncthreads();
                    if (C.wave == 0 || C.wave == 3) { const int g = C.wave == 3 ? 1 : 0, qt = g ? 255 - ub : ub; cmp_topk(a, g, qt, (const LAS float*)(C.lds) + C.wave * 4160, C.lane); }
                    __syncthreads();
                }
#endif
#if STEP_LEVEL >= 4
            } else if (ph == 3) {
                build_t5(ldsg, a.in[16], C.tid);
                { volatile LAS unsigned* misc = (volatile LAS unsigned*)(C.lds + MISC_OFF) + 16; const int rep = (rep_done == st) ? 1 : 0; unsigned* qh = (unsigned*)(ws + WS_CTL) + CW_QD + 64 * l + 32 * rep;
                  if (!(rep && PROBE_FOX_ONLY == 2)) attn_stream_q<att::MODE_FOX>(ws, ldsg, l, misc, ITEMS_FOX, N_ITEMS_FOX, qh + 16, C.tid, rep);
                  if (!(rep && PROBE_FOX_ONLY == 1)) attn_stream_q<att::MODE_SLC>(ws, ldsg, l, misc, ITEMS_SLC, N_ITEMS_SLC, qh, C.tid, rep); }
#endif
            } else if (ph == 4) {
                pg8::Gemm g{(const pg8::bf16_t*)(ws + WS_Y), (const pg8::bf16_t*)(ws + WS_WOUT) + (size_t)l * DM * DM, S, DM, DM};
                pg8::StaticOrder So; So.init(S, DM, C.G, (int)blockIdx.x);
                pg8::EpiF32 E{(float*)(ws + WS_Y2), DM};
                pg8::gemm_phase<pg8::EpiF32, pg8::StaticOrder, true, true>(C.lds, g, So, E, C.tid);
            } else if (ph == 5) {
                rowpass(a, C, l + 1);
            }
        }
        if (st + 1 < step_hi) xcd_barrier(bar);
        if (((st >= 2 && (st - 2) % NPH == a_.pad) || (st < 2 && st + 100 == a_.pad)) && rep_done != st) { rep_done = st; --st; }
    }
}
#ifndef PROBE_PH
#define PROBE_PH (-1)
#endif
#ifndef ONE_LAUNCH
#define ONE_LAUNCH 1
#endif
static void launch_steps(const Args& base, int lo, int hi, int li, int grid, hipStream_t stream) {
    Args a = base; a.step_lo = lo; a.step_hi = hi; a.li = li;
    hipLaunchKernelGGL(skel_fwd, dim3(grid), dim3(NTHR), LDS_BYTES, stream, a);
}
extern "C" void kernel_launch(void* const* d_in, const int* in_sizes, int n_in, void* d_out, int out_size, void* d_ws, size_t ws_size, hipStream_t stream) {
    static int grid = 0;
    if (grid == 0) {
        int dev = 0, cus = 0, per_cu = 0;
        hipGetDevice(&dev); hipDeviceGetAttribute(&cus, hipDeviceAttributeMultiprocessorCount, dev);
        hipFuncSetAttribute((const void*)skel_fwd, hipFuncAttributeMaxDynamicSharedMemorySize, LDS_BYTES);
        hipOccupancyMaxActiveBlocksPerMultiprocessor(&per_cu, (const void*)skel_fwd, NTHR, LDS_BYTES);
        (void)hipGetLastError();
        if (per_cu < 1) fprintf(stderr, "kernel_launch: occupancy query says %d blocks/CU\n", per_cu);
        grid = cus;
        if (grid != 256) fprintf(stderr, "kernel_launch: built for 256 CUs, found %d\n", cus);
    }
    hipMemsetAsync((char*)d_ws + WS_CTL, 0, CTL_ZERO_BYTES, stream);
    Args a{}; for (int i = 0; i < 17; ++i) a.in[i] = (const float*)d_in[i];
    a.out = (float*)d_out; a.ws = (unsigned char*)d_ws; a.pad = PROBE_PH;
#if ONE_LAUNCH
    launch_steps(a, 0, NSTEPS, 1, grid, stream);
#else
    launch_steps(a, 0, 2, 1, grid, stream);
    for (int st = 2; st < NSTEPS; ++st) launch_steps(a, st, st + 1, 0, grid, stream);
#endif
}
```

```cpp
#include <hip/hip_runtime.h>
#include <hip/hip_bf16.h>
#include <cstdio>
#include <cstdint>
#include <cmath>
#ifndef STEP_LEVEL
#define STEP_LEVEL 4
#endif
#ifndef DBG_NAIVE_SEL
#define DBG_NAIVE_SEL 0
#endif
#ifndef PROBE_FOX_ONLY
#define PROBE_FOX_ONLY 0
#endif
namespace pg8 {
#define PG8_LAS __attribute__((address_space(3)))
typedef unsigned short bf16_t;
typedef short bf16x8 __attribute__((ext_vector_type(8)));
typedef float f32x4 __attribute__((ext_vector_type(4)));
typedef unsigned u32x4 __attribute__((ext_vector_type(4)));
constexpr int BM = 256, BK = 64, HALF = 128, HTB = HALF * BK * 2  , STAGE_BYTES = 8 * HTB, NXCD = 8, WGM = 8;

__host__ __device__ __forceinline__ int lds_byte(int r, int c) { const int st = (r >> 4) * 2 + (c >> 5), rr = r & 15, cc = c & 31, ob = rr * 64 + cc * 2; return st * 1024 + (ob ^ (((ob >> 9) & 1) << 5)); }
__host__ __device__ __forceinline__ void stage_rc(int b, int& R, int& C) { const int st = b / 1024, sb = b % 1024, swz = sb ^ (((sb >> 9) & 1) << 5); R = (st >> 1) * 16 + swz / 64; C = (st & 1) * 32 + (swz % 64) / 2; }
__host__ __device__ __forceinline__ int perm32(int rho) { const int n = rho >> 4, i = rho & 15; return 8 * (i >> 2) + 4 * n + (i & 3); }

struct Unit { int pm, pn; };
struct Gemm { const bf16_t* A; const bf16_t* Bt; int M, N, K; };

struct StaticOrder {
    int nM, nN, nwg, G, c;
    __host__ __device__ void init(int M, int N, int G_, int c_) { nM = M / BM; nN = N / BM; nwg = nM * nN; G = G_; c = c_; }
    __host__ __device__ bool next(int i, Unit& u) const {
        const long L = (long)i * G + c; if (L >= nwg) return false;
        int wgid = (int)L; { const int q = nwg / NXCD, r = nwg % NXCD, xcd = wgid % NXCD, off = wgid / NXCD; wgid = (xcd < r ? xcd * (q + 1) : r * (q + 1) + (xcd - r) * q) + off; }
        const int nig = WGM * nN, gid = wgid / nig, fm = gid * WGM, gsz = (nM - fm) < WGM ? (nM - fm) : WGM;
        u.pm = fm + ((wgid % nig) % gsz); u.pn = (wgid % nig) / gsz; return true;
    }
    __device__ __forceinline__ void a_ready(const Unit&) const {}
    __device__ __forceinline__ void done(const Unit&) const {}
};

__device__ __forceinline__ unsigned cvt_pk_bf16(float lo, float hi) { unsigned r; asm volatile("v_cvt_pk_bf16_f32 %0, %1, %2" : "=v"(r) : "v"(lo), "v"(hi)); return r; }
typedef float f32x2 __attribute__((ext_vector_type(2)));
__device__ __forceinline__ f32x2 gelu_pk(f32x2 v) {
    const f32x2 av = __builtin_elementwise_abs(v), d = av * 0.2316418882f + 1.0f;
    f32x2 t; t.x = __builtin_amdgcn_rcpf(d.x); t.y = __builtin_amdgcn_rcpf(d.y);
    f32x2 q = t * 0.5307027145f + (-0.7265760135f); q = q * t + 0.7107068705f; q = q * t + (-0.142248368f); q = q * t + 0.127414796f; q = q * t;
    const f32x2 s = (v * v) * (-0.72134752044f);
    f32x2 e; e.x = __builtin_amdgcn_exp2f(s.x); e.y = __builtin_amdgcn_exp2f(s.y);
    const f32x2 m = v * (q * e), r = v - m;
    f32x2 o; o.x = v.x < 0.f ? m.x : r.x; o.y = v.y < 0.f ? m.y : r.y; return o;
}

template <int ACT  > struct EpiBf16 {
    static constexpr bool PERM = true, AFTER_DRAIN = false; static_assert(ACT == 0 || ACT == 1, "EpiBf16: ACT is 0 (none) or 1 (gelu_pk)");
    bf16_t* O; int ldc; const float* bias; int split_cols; size_t split_stride; float scale0;
    __device__ __forceinline__ void operator()(const f32x4 (&acc)[2][2][4][2], const Unit& u, int wr, int wc, int fr, int fq) const {
        const int row0 = u.pm * BM + wr * 64 + fr; int colt = u.pn * BM; bf16_t* base = O;
        float sc = 1.f; if (split_cols) { const int t = colt / split_cols; base += (size_t)t * split_stride; colt -= t * split_cols; if (t == 0) sc = scale0; }
        const int col0 = colt + wc * 32 + 8 * fq, bcol0 = u.pn * BM + wc * 32 + 8 * fq;
        f32x4 bv[2][2];
#pragma unroll
        for (int bj = 0; bj < 2; ++bj)
#pragma unroll
            for (int n = 0; n < 2; ++n) bv[bj][n] = bias ? *(const f32x4*)(bias + bcol0 + bj * HALF + 4 * n) : (f32x4){0.f, 0.f, 0.f, 0.f};
#pragma unroll
        for (int ai = 0; ai < 2; ++ai)
#pragma unroll
            for (int m = 0; m < 4; ++m) { bf16_t* rowp = base + (size_t)(row0 + ai * HALF + m * 16) * ldc + col0;
#pragma unroll
                for (int bj = 0; bj < 2; ++bj) { f32x4 v0 = acc[ai][bj][m][0] + bv[bj][0], v1 = acc[ai][bj][m][1] + bv[bj][1];
                    if (ACT == 1) { f32x2 a = gelu_pk((f32x2){v0[0], v0[1]}), b = gelu_pk((f32x2){v0[2], v0[3]}), c = gelu_pk((f32x2){v1[0], v1[1]}), d = gelu_pk((f32x2){v1[2], v1[3]});
                        v0 = (f32x4){a.x, a.y, b.x, b.y}; v1 = (f32x4){c.x, c.y, d.x, d.y}; }
                    v0 = v0 * sc; v1 = v1 * sc; u32x4 w; w.x = cvt_pk_bf16(v0[0], v0[1]); w.y = cvt_pk_bf16(v0[2], v0[3]); w.z = cvt_pk_bf16(v1[0], v1[1]); w.w = cvt_pk_bf16(v1[2], v1[3]);
                    *(u32x4*)(rowp + bj * HALF) = w; } }
    }
};
struct EpiProj {
    static constexpr bool PERM = true, AFTER_DRAIN = false;
    bf16_t* conv; bf16_t* zf; bf16_t* zn; bf16_t* att;
    __device__ __forceinline__ void operator()(const f32x4 (&acc)[2][2][4][2], const Unit& u, int wr, int wc, int fr, int fq) const {
        const int pn = u.pn; bf16_t* base; int ld; size_t hs; constexpr size_t HS = (size_t)8192 * 128;
        if (pn < 8) { base = conv + pn * 256; ld = 2048; hs = 128; }
        else if (pn < 17) { base = att + (size_t)((pn - 8) * 2) * HS; ld = 128; hs = HS; }
        else if (pn < 20) { base = zf + (pn - 17) * 256; ld = 768; hs = 128; }
        else if (pn < 29) { base = att + (size_t)(18 + (pn - 20) * 2) * HS; ld = 128; hs = HS; }
        else { base = zn + (pn - 29) * 256; ld = 768; hs = 128; }
        const int row0 = u.pm * BM + wr * 64 + fr, col0 = wc * 32 + 8 * fq;
#pragma unroll
        for (int ai = 0; ai < 2; ++ai)
#pragma unroll
            for (int m = 0; m < 4; ++m) { bf16_t* rowp = base + (size_t)(row0 + ai * HALF + m * 16) * ld + col0;
#pragma unroll
                for (int bj = 0; bj < 2; ++bj) { const f32x4 v0 = acc[ai][bj][m][0], v1 = acc[ai][bj][m][1];
                    u32x4 w; w.x = cvt_pk_bf16(v0[0], v0[1]); w.y = cvt_pk_bf16(v0[2], v0[3]); w.z = cvt_pk_bf16(v1[0], v1[1]); w.w = cvt_pk_bf16(v1[2], v1[3]);
                    *(u32x4*)(rowp + (size_t)bj * hs) = w; } }
    }
};
struct EpiF32 {
    static constexpr bool PERM = false, AFTER_DRAIN = false;
    float* O; int ldc;
    __device__ __forceinline__ void operator()(const f32x4 (&acc)[2][2][4][2], const Unit& u, int wr, int wc, int fr, int fq) const {
        const int row0 = u.pm * BM + wr * 64 + fr, col0 = u.pn * BM + wc * 32 + 4 * fq;
#pragma unroll
        for (int ai = 0; ai < 2; ++ai)
#pragma unroll
            for (int m = 0; m < 4; ++m) { float* rowp = O + (size_t)(row0 + ai * HALF + m * 16) * ldc + col0;
#pragma unroll
                for (int bj = 0; bj < 2; ++bj)
#pragma unroll
                    for (int n = 0; n < 2; ++n) *(f32x4*)(rowp + bj * HALF + n * 16) = acc[ai][bj][m][n]; }
    }
};
template <class Epi, class Sched, bool ALIGN_EPI = false, bool SP2 = false>
__device__ __forceinline__ void gemm_phase(PG8_LAS unsigned char* lds, const Gemm g, const Sched& S, const Epi& E, const int tid) {
    const int wid = __builtin_amdgcn_readfirstlane(tid >> 6), lane = tid & 63, wr = wid >> 2, wc = wid & 3, fr = lane & 15, fq = lane >> 4;
    const int K = g.K, nt = K / BK;
    unsigned voffA[2], voffB[2];
#pragma unroll
    for (int i = 0; i < 2; ++i) { int R, C; stage_rc(tid * 16 + i * 8192, R, C); const int Rb = Epi::PERM ? ((R & ~31) + perm32(R & 31)) : R;
        voffA[i] = (unsigned)(R * K + C) * 2u; voffB[i] = (unsigned)(Rb * K + C) * 2u; }
    const size_t kstep = (size_t)(BK * 2);
    const size_t hstep = (size_t)HALF * K * 2;
    const size_t tstep = 2 * hstep;
    const unsigned ldsw = (unsigned)wid * 1024u;
    const int aoff = lds_byte(wr * 64 + fr, fq * 8), boff = lds_byte(wc * 32 + fr, fq * 8);
#define PG8_SA(b, h) (((b) * 2 + (h)) * HTB)
#define PG8_SB(b, h) ((4 + (b) * 2 + (h)) * HTB)
#define PG8_STAGE(bufoff, gbase, voff) do { _Pragma("unroll") for (int _i = 0; _i < 2; ++_i) \
        __builtin_amdgcn_global_load_lds((const unsigned*)((const char*)(gbase) + (voff)[_i]), (PG8_LAS unsigned*)(lds + (bufoff) + ldsw + _i * 8192), 16, 0, 0); } while (0)
#define PG8_LDA(dst, b, h) do { _Pragma("unroll") for (int m = 0; m < 4; ++m) _Pragma("unroll") for (int k = 0; k < 2; ++k) dst[m][k] = *(const PG8_LAS bf16x8*)(lds + PG8_SA(b, h) + aoff + m * 2048 + k * 1024); } while (0)
#define PG8_LDB(dst, b, h) do { _Pragma("unroll") for (int n = 0; n < 2; ++n) _Pragma("unroll") for (int k = 0; k < 2; ++k) dst[n][k] = *(const PG8_LAS bf16x8*)(lds + PG8_SB(b, h) + boff + n * 2048 + k * 1024); } while (0)
#define PG8_MMA(ai, bj, At, Bt) do { __builtin_amdgcn_s_setprio(1); _Pragma("unroll") for (int m = 0; m < 4; ++m) _Pragma("unroll") for (int n = 0; n < 2; ++n) _Pragma("unroll") for (int k = 0; k < 2; ++k) \
        acc[ai][bj][m][n] = __builtin_amdgcn_mfma_f32_16x16x32_bf16(Bt[n][k], At[m][k], acc[ai][bj][m][n], 0, 0, 0); __builtin_amdgcn_s_setprio(0); } while (0)
#define PG8_WAIT_V(n) asm volatile("s_waitcnt vmcnt(" #n ")" ::: "memory")
#define PG8_WAIT_L(n) asm volatile("s_waitcnt lgkmcnt(" #n ")" ::: "memory")
#define PG8_BAR __builtin_amdgcn_s_barrier()
#define PG8_SCHED __builtin_amdgcn_sched_barrier(0)
    Unit cur, nxt; int ui = 0;
    if (!S.next(0, cur)) return;
    f32x4 acc[2][2][4][2];
#pragma unroll
    for (int a = 0; a < 2; ++a)
#pragma unroll
        for (int b = 0; b < 2; ++b)
#pragma unroll
            for (int m = 0; m < 4; ++m)
#pragma unroll
                for (int n = 0; n < 2; ++n) acc[a][b][m][n] = (f32x4){0.f, 0.f, 0.f, 0.f};
    bf16x8 At[4][2], B0[2][2], B1[2][2];
    const char* cA = (const char*)g.A + (size_t)cur.pm * tstep; const char* cB = (const char*)g.Bt + (size_t)cur.pn * tstep;
    S.a_ready(cur);
    if constexpr (SP2) {
        PG8_STAGE(PG8_SB(0, 0), cB, voffB); PG8_STAGE(PG8_SB(0, 1), cB + hstep, voffB); PG8_STAGE(PG8_SA(0, 0), cA, voffA); PG8_STAGE(PG8_SA(0, 1), cA + hstep, voffA);
        if (wr == 1) PG8_BAR;
        PG8_WAIT_V(2); PG8_BAR;
        PG8_STAGE(PG8_SB(1, 0), cB + kstep, voffB); PG8_STAGE(PG8_SA(1, 0), cA + kstep, voffA); PG8_STAGE(PG8_SB(1, 1), cB + hstep + kstep, voffB);
        PG8_WAIT_V(6); PG8_BAR;
    } else {
        PG8_STAGE(PG8_SB(0, 0), cB, voffB); PG8_STAGE(PG8_SA(0, 0), cA, voffA); PG8_STAGE(PG8_SB(0, 1), cB + hstep, voffB); PG8_STAGE(PG8_SA(0, 1), cA + hstep, voffA);
        if (wr == 1) PG8_BAR;
        PG8_WAIT_V(4); PG8_BAR;
        PG8_STAGE(PG8_SB(1, 0), cB + kstep, voffB); PG8_STAGE(PG8_SA(1, 0), cA + kstep, voffA); PG8_STAGE(PG8_SB(1, 1), cB + hstep + kstep, voffB);
        PG8_WAIT_V(6); PG8_BAR;
    }
    for (;;) {
        const bool has_next = S.next(ui + 1, nxt);
        const char* nA = has_next ? (const char*)g.A + (size_t)nxt.pm * tstep : cA; const char* nB = has_next ? (const char*)g.Bt + (size_t)nxt.pn * tstep : cB;
        for (int t = 0; t < nt; t += 2) {
            const bool last = (t == nt - 2);
            const char* a1 = cA + (size_t)(t + 1) * kstep;
            const char* a2 = last ? nA : cA + (size_t)(t + 2) * kstep; const char* b2 = last ? nB : cB + (size_t)(t + 2) * kstep;
            const char* a3 = a2 + kstep; const char* b3 = b2 + kstep;
            if (last && has_next) S.a_ready(nxt);
            if constexpr (SP2) {
            PG8_LDB(B0, 0, 0); PG8_LDB(B1, 0, 1); PG8_SCHED; PG8_LDA(At, 0, 0); PG8_STAGE(PG8_SA(1, 1), a1 + hstep, voffA);
            PG8_WAIT_V(8); PG8_WAIT_L(0); PG8_BAR; PG8_MMA(0, 0, At, B0); PG8_MMA(0, 1, At, B1); PG8_BAR; PG8_SCHED;
            PG8_LDA(At, 0, 1); PG8_STAGE(PG8_SB(0, 0), b2, voffB); PG8_STAGE(PG8_SB(0, 1), b2 + hstep, voffB); PG8_STAGE(PG8_SA(0, 0), a2, voffA);
            PG8_WAIT_V(8); PG8_WAIT_L(0); PG8_BAR; PG8_MMA(1, 0, At, B0); PG8_MMA(1, 1, At, B1); PG8_BAR; PG8_SCHED;
            PG8_LDB(B0, 1, 0); PG8_LDB(B1, 1, 1); PG8_SCHED; PG8_LDA(At, 1, 0); PG8_STAGE(PG8_SA(0, 1), a2 + hstep, voffA);
            PG8_WAIT_V(8); PG8_WAIT_L(0); PG8_BAR; PG8_MMA(0, 0, At, B0); PG8_MMA(0, 1, At, B1); PG8_BAR; PG8_SCHED;
            PG8_LDA(At, 1, 1); PG8_STAGE(PG8_SB(1, 0), b3, voffB); PG8_STAGE(PG8_SB(1, 1), b3 + hstep, voffB); PG8_STAGE(PG8_SA(1, 0), a3, voffA);
            PG8_WAIT_V(8); PG8_WAIT_L(0); PG8_BAR; PG8_MMA(1, 0, At, B0); PG8_MMA(1, 1, At, B1); PG8_BAR; PG8_SCHED;
            } else {
            PG8_LDB(B0, 0, 0); PG8_SCHED; PG8_LDA(At, 0, 0); PG8_STAGE(PG8_SA(1, 1), a1 + hstep, voffA);
            PG8_WAIT_L(8); PG8_BAR; PG8_WAIT_L(0); PG8_MMA(0, 0, At, B0); PG8_BAR; PG8_SCHED;
            PG8_LDB(B1, 0, 1); PG8_STAGE(PG8_SB(0, 0), b2, voffB);
            PG8_BAR; PG8_WAIT_L(0); PG8_MMA(0, 1, At, B1); PG8_BAR;
            PG8_LDA(At, 0, 1); PG8_STAGE(PG8_SA(0, 0), a2, voffA);
            PG8_BAR; PG8_WAIT_L(0); PG8_MMA(1, 0, At, B0); PG8_BAR; PG8_SCHED;
            PG8_STAGE(PG8_SB(0, 1), b2 + hstep, voffB);
            PG8_WAIT_V(6); PG8_BAR; PG8_MMA(1, 1, At, B1); PG8_BAR;
            PG8_LDB(B0, 1, 0); PG8_SCHED; PG8_LDA(At, 1, 0); PG8_STAGE(PG8_SA(0, 1), a2 + hstep, voffA);
            PG8_WAIT_L(8); PG8_BAR; PG8_WAIT_L(0); PG8_MMA(0, 0, At, B0); PG8_BAR; PG8_SCHED;
            PG8_LDB(B1, 1, 1); PG8_STAGE(PG8_SB(1, 0), b3, voffB);
            PG8_BAR; PG8_WAIT_L(0); PG8_MMA(0, 1, At, B1); PG8_BAR;
            PG8_LDA(At, 1, 1); PG8_STAGE(PG8_SA(1, 0), a3, voffA);
            PG8_BAR; PG8_WAIT_L(0); PG8_MMA(1, 0, At, B0); PG8_BAR; PG8_SCHED;
            PG8_STAGE(PG8_SB(1, 1), b3 + hstep, voffB);
            PG8_WAIT_V(6); PG8_BAR; PG8_MMA(1, 1, At, B1); PG8_BAR;
            }
        }
        if constexpr (ALIGN_EPI) { if (wr == 0) PG8_BAR; }
        if constexpr (!Epi::AFTER_DRAIN) { E(acc, cur, wr, wc, fr, fq); S.done(cur); }
        if (!has_next) break;
#pragma unroll
        for (int a = 0; a < 2; ++a)
#pragma unroll
            for (int b = 0; b < 2; ++b)
#pragma unroll
                for (int m = 0; m < 4; ++m)
#pragma unroll
                    for (int n = 0; n < 2; ++n) acc[a][b][m][n] = (f32x4){0.f, 0.f, 0.f, 0.f};
        cur = nxt; cA = nA; cB = nB; ++ui;
        if constexpr (ALIGN_EPI) { if (wr == 1) PG8_BAR; }
    }
    PG8_WAIT_V(0);
    if constexpr (!ALIGN_EPI) { if (wr == 0) PG8_BAR; }
    PG8_BAR;
    if constexpr (Epi::AFTER_DRAIN) { E.fused(acc, cur, wr, wc, fr, fq, lds, wid, lane); S.done(cur); }
#undef PG8_SA
#undef PG8_SB
#undef PG8_STAGE
#undef PG8_LDA
#undef PG8_LDB
#undef PG8_MMA
#undef PG8_WAIT_V
#undef PG8_WAIT_L
#undef PG8_BAR
#undef PG8_SCHED
}
}
namespace att {
typedef unsigned short bf16;
typedef short bf16x8 __attribute__((ext_vector_type(8)));
typedef short s16x4 __attribute__((ext_vector_type(4)));
typedef float f32x16 __attribute__((ext_vector_type(16)));
typedef float f32x4 __attribute__((ext_vector_type(4)));
typedef unsigned u32x4 __attribute__((ext_vector_type(4)));
enum { MODE_FOX = 0, MODE_WIN = 1, MODE_SLC = 2 };
constexpr int D = 128, NW = 8, QBLK = 32, KVBLK = 64, QB = NW * QBLK, SEQ = 8192;
constexpr float SCALE = 0.08838834764831845f, THR = 8.f;
constexpr int SHM_V = KVBLK * D * 2, SHM_K = KVBLK * D * 2;
constexpr int LDS_Q = 2 * SHM_V + 2 * SHM_K, LDS_WSF = LDS_Q + NW * QBLK * D * 2, LDS_T5 = LDS_WSF + NW * 128 * 4, LDS_BIAS = LDS_T5 + 6 * 132 * 4, ATT_LDS_BYTES = LDS_BIAS + 512;
constexpr int WBIG = 1 << 30;
#define KSWZ(row, colB) ((row) * 256 + ((colB) ^ (((row) & 7) << 4)))
#define SBAR() __builtin_amdgcn_sched_barrier(0)
__device__ __forceinline__ int v_st(int k, int c) { const int kk = (k & ~0xC) | ((k & 4) << 1) | ((k & 8) >> 1); return ((kk >> 3) * 4 + (c >> 5)) * 512 + ((kk & 7) * 32 + (c & 31)) * 2; }
__device__ __forceinline__ int v_rd_base(int lane) { return ((lane & 3) << 3) | (((lane >> 2) & 3) << 6) | (((lane >> 4) & 1) << 5) | (((lane >> 5) & 1) << 8); }
constexpr int v_rd_off(int d0, int ks, int half) { return d0 * 512 + ks * 4096 + half * 2048; }
__device__ __forceinline__ int crow(int r, int hi) { return (r & 3) + 8 * (r >> 2) + 4 * hi; }
__device__ __forceinline__ unsigned cvtpk(float lo, float hi) { unsigned r; asm volatile("v_cvt_pk_bf16_f32 %0, %1, %2" : "=v"(r) : "v"(lo), "v"(hi)); return r; }
__device__ __forceinline__ bf16x8 load8(const bf16* p) { return *reinterpret_cast<const bf16x8*>(p); }
__device__ __forceinline__ float bflo(unsigned w) { return __builtin_bit_cast(float, w << 16); }
__device__ __forceinline__ float bfhi(unsigned w) { return __builtin_bit_cast(float, w & 0xffff0000u); }
__device__ __forceinline__ float silu_(float v) { return v * __builtin_amdgcn_rcpf(1.f + __expf(-v)); }
__device__ __forceinline__ float slc_cv(int j, unsigned w0, unsigned w1, unsigned w2, unsigned w3, float c31) {
    const unsigned wj = j < 32 ? w0 : (j < 64 ? w1 : (j < 96 ? w2 : w3)); return ((wj >> (j & 31)) & 1u) ? c31 : -__builtin_inff(); }
__device__ __forceinline__ void mask_tile(f32x16& p0, f32x16& p1, int dq, unsigned W) {
    const float NEG = -__builtin_inff();
#pragma unroll
    for (int r = 0; r < 16; ++r) { const int c = (r & 3) + 8 * (r >> 2);
        if ((unsigned)(dq - c) >= W) p0[r] = NEG;
        if ((unsigned)(dq - c - 32) >= W) p1[r] = NEG; }
}
__device__ __forceinline__ void t5_tile(f32x16& p0, f32x16& p1, int dq, const float* Td) {
#pragma unroll
    for (int g4 = 0; g4 < 4; ++g4) {
#pragma unroll
        for (int i = 0; i < 4; ++i) { const int r = 4 * g4 + i, c = (r & 3) + 8 * (r >> 2);
            int d0 = dq - c, d1 = dq - c - 32; d0 = d0 < 0 ? 0 : (d0 > 127 ? 127 : d0); d1 = d1 < 0 ? 0 : (d1 > 127 ? 127 : d1);
            p0[r] += Td[d0]; p1[r] += Td[d1]; }
        asm volatile("" ::: "memory"); }
}
__device__ __forceinline__ void partialSM(f32x16& p0, f32x16& p1, float& m_reg, float& mn, float& alpha) {
    float pmax = p0[0];
#pragma unroll
    for (int r = 1; r < 16; ++r) pmax = fmaxf(pmax, p0[r]);
#pragma unroll
    for (int r = 0; r < 16; ++r) pmax = fmaxf(pmax, p1[r]);
    { auto rr = __builtin_amdgcn_permlane32_swap(__float_as_uint(pmax), __float_as_uint(pmax), false, false);
      pmax = fmaxf(__uint_as_float(rr[0]), __uint_as_float(rr[1])); }
    constexpr float C2 = 1.4426950408889634f * SCALE;
    if (__builtin_expect(__all((pmax - m_reg) * SCALE <= THR), 1)) { mn = m_reg; alpha = 1.f; }
    else { mn = fmaxf(m_reg, pmax); alpha = __builtin_amdgcn_exp2f((m_reg - mn) * C2); m_reg = mn; }
    const float mnL = -mn * C2;
#pragma unroll
    for (int r = 0; r < 16; ++r) p0[r] = fmaf(p0[r], C2, mnL);
#pragma unroll
    for (int r = 0; r < 16; ++r) p1[r] = fmaf(p1[r], C2, mnL);
#pragma unroll
    for (int r = 0; r < 16; ++r) p0[r] = __builtin_amdgcn_exp2f(p0[r]);
}
__device__ __forceinline__ void finishSM(f32x16& p0, f32x16& p1, float alpha, float& l_reg, bf16x8& pa0, bf16x8& pa1, bf16x8& pa2, bf16x8& pa3) {
#pragma unroll
    for (int r = 0; r < 16; ++r) p1[r] = __builtin_amdgcn_exp2f(p1[r]);
    float ps = 0;
#pragma unroll
    for (int r = 0; r < 16; ++r) ps += p0[r];
#pragma unroll
    for (int r = 0; r < 16; ++r) ps += p1[r];
    { auto rr = __builtin_amdgcn_permlane32_swap(__float_as_uint(ps), __float_as_uint(ps), false, false);
      ps = __uint_as_float(rr[0]) + __uint_as_float(rr[1]); }
    l_reg = l_reg * alpha + ps;
#define PK4(P, B_, OUT) do { unsigned a0 = cvtpk(P[B_+0], P[B_+1]), a1 = cvtpk(P[B_+2], P[B_+3]);                          \
        unsigned b0 = cvtpk(P[B_+4], P[B_+5]), b1 = cvtpk(P[B_+6], P[B_+7]);                                             \
        auto r0 = __builtin_amdgcn_permlane32_swap(a0, b0, false, false); auto r1 = __builtin_amdgcn_permlane32_swap(a1, b1, false, false); \
        u32x4 w = {r0[0], r1[0], r0[1], r1[1]}; OUT = *reinterpret_cast<bf16x8*>(&w); } while (0)
    PK4(p0, 0, pa0); PK4(p0, 8, pa1); PK4(p1, 0, pa2); PK4(p1, 8, pa3);
#undef PK4
}
template <int KB, bool SK, int MODE>
__device__ __forceinline__ void qkt(f32x16& p0, f32x16& p1, const char* K_lds, const char* B_lds, float cv, int r32, int hi, const char* Qw, bool act) {
    if (SK && !act) { const float NEG = -__builtin_inff();
#pragma unroll
        for (int r = 0; r < 16; ++r) { p0[r] = NEG; p1[r] = NEG; } return; }
    if (MODE == MODE_FOX) { const float* bb = (const float*)(B_lds + KB * 256) + 4 * hi;
        const f32x4 a0 = *(const f32x4*)(bb), a1 = *(const f32x4*)(bb + 8), a2 = *(const f32x4*)(bb + 16), a3 = *(const f32x4*)(bb + 24);
        const f32x4 b0 = *(const f32x4*)(bb + 32), b1 = *(const f32x4*)(bb + 40), b2 = *(const f32x4*)(bb + 48), b3 = *(const f32x4*)(bb + 56);
        p0 = (f32x16){a0[0], a0[1], a0[2], a0[3], a1[0], a1[1], a1[2], a1[3], a2[0], a2[1], a2[2], a2[3], a3[0], a3[1], a3[2], a3[3]};
        p1 = (f32x16){b0[0], b0[1], b0[2], b0[3], b1[0], b1[1], b1[2], b1[3], b2[0], b2[1], b2[2], b2[3], b3[0], b3[1], b3[2], b3[3]}; }
    else {
#pragma unroll
        for (int r = 0; r < 16; ++r) { p0[r] = cv; p1[r] = cv; } }
    const char* kb[4]; const char* qb[4];
#pragma unroll
    for (int dd = 0; dd < 4; ++dd) { const int off = KSWZ(r32, (dd * 16 + hi * 8) * 2); kb[dd] = K_lds + KB * SHM_K + off; qb[dd] = Qw + off; }
#pragma unroll
    for (int d0 = 0; d0 < 8; ++d0) { const char* a = kb[d0 & 3] + (d0 >> 2) * 128;
        bf16x8 b0 = *reinterpret_cast<const bf16x8*>(a);
        bf16x8 b1 = *reinterpret_cast<const bf16x8*>(a + 32 * 256);
        const bf16x8 qv = *reinterpret_cast<const bf16x8*>(qb[d0 & 3] + (d0 >> 2) * 128);
        p0 = __builtin_amdgcn_mfma_f32_32x32x16_bf16(b0, qv, p0, 0, 0, 0);
        p1 = __builtin_amdgcn_mfma_f32_32x32x16_bf16(b1, qv, p1, 0, 0, 0); }
}
template <int VB, bool SK>
__device__ __forceinline__ void pv_tile(f32x16* o, int vb0, bf16x8 pa0, bf16x8 pa1, bf16x8 pa2, bf16x8 pa3, bool act) {
    if (SK && !act) return;
#define TRRD(dst, off) asm volatile("ds_read_b64_tr_b16 %0, %1 offset:%2" : "=&v"(dst) : "v"(vb0), "i"(off) : "memory")
#define PV_D0(d0) do { s16x4 l0, l1, l2, l3, h0, h1, h2, h3; constexpr int b_ = VB * SHM_V + v_rd_off(d0, 0, 0); \
        TRRD(l0, b_); TRRD(h0, b_ + 2048); TRRD(l1, b_ + 4096); TRRD(h1, b_ + 6144); TRRD(l2, b_ + 8192); TRRD(h2, b_ + 10240); TRRD(l3, b_ + 12288); TRRD(h3, b_ + 14336); \
        asm volatile("s_waitcnt lgkmcnt(0)" ::: "memory"); SBAR();   \
        o[d0] = __builtin_amdgcn_mfma_f32_32x32x16_bf16(pa0, (bf16x8){l0[0], l0[1], l0[2], l0[3], h0[0], h0[1], h0[2], h0[3]}, o[d0], 0, 0, 0);   \
        o[d0] = __builtin_amdgcn_mfma_f32_32x32x16_bf16(pa1, (bf16x8){l1[0], l1[1], l1[2], l1[3], h1[0], h1[1], h1[2], h1[3]}, o[d0], 0, 0, 0);   \
        o[d0] = __builtin_amdgcn_mfma_f32_32x32x16_bf16(pa2, (bf16x8){l2[0], l2[1], l2[2], l2[3], h2[0], h2[1], h2[2], h2[3]}, o[d0], 0, 0, 0);   \
        o[d0] = __builtin_amdgcn_mfma_f32_32x32x16_bf16(pa3, (bf16x8){l3[0], l3[1], l3[2], l3[3], h3[0], h3[1], h3[2], h3[3]}, o[d0], 0, 0, 0); } while (0)
    PV_D0(0); PV_D0(1); PV_D0(2); PV_D0(3);
#undef PV_D0
#undef TRRD
}
struct BlockRef { const bf16* Q; const bf16* K; const bf16* V; const float* bias; int P0, W, h, mode; int ja, jb; int bid, chunk, nch; };
struct Aux {
    const float* biasF;
    const unsigned* selm;
    const float* small;
    const bf16* zf; const bf16* zn; const bf16* oc; bf16* ow; bf16* y;
    float* part_o; float* part_ml; unsigned* arr; volatile unsigned* ldsflag;
};
struct Seam { bf16x8 st_v0, st_v1, st_k0, st_k1; f32x4 st_b; };
__device__ __forceinline__ int swa_jlo(int P0, int W) { const int lowk = P0 - W + 1; return lowk > 0 ? lowk / KVBLK : 0; }
#define ROW(p, k0, rr) ((p) + (size_t)((k0) + (rr)) * D + sc)
#define VMW() asm volatile("s_waitcnt vmcnt(0)" ::: "memory")
#define VMWN(n) asm volatile("s_waitcnt vmcnt(%0)" :: "i"(n) : "memory")
#define SLOAD_H(Kp, Vp, Bp, k0) do { S.st_v0 = load8(ROW(Vp, k0, sr)); S.st_v1 = load8(ROW(Vp, k0, 32 + sr));              \
                         S.st_k0 = load8(ROW(Kp, k0, sr)); S.st_k1 = load8(ROW(Kp, k0, 32 + sr));                        \
                         if ((Bp) != nullptr && tid < 16) S.st_b = *(const f32x4*)((Bp) + (k0) + 4 * tid); } while (0)
#define SWRITE_HK(bf, Bp) do { *(bf16x8*)(K_lds + (bf) * SHM_K + kws) = S.st_k0; *(bf16x8*)(K_lds + (bf) * SHM_K + kws + 32 * 256) = S.st_k1; \
                         if ((Bp) != nullptr && tid < 16) *(f32x4*)(B_lds + (bf) * 256 + tid * 16) = S.st_b; } while (0)
#define SWRITE_HV(bf) do { *(bf16x8*)(V_lds + (bf) * SHM_V + vst0) = S.st_v0; *(bf16x8*)(V_lds + (bf) * SHM_V + vst1) = S.st_v1; } while (0)
#define SWRITE_H(bf, Bp) do { SWRITE_HV(bf); SWRITE_HK(bf, Bp); } while (0)
__device__ __forceinline__ void attn_prime(const BlockRef& cur, char* lds, Seam& S, int tid) {
    const int wid = __builtin_amdgcn_readfirstlane(tid >> 6), lane = tid & 63, r32 = lane & 31, hi = lane >> 5;
    const int sr = tid >> 4, sc = (tid & 15) * 8, kws = KSWZ(sr, sc * 2); char* K_lds = lds + 2 * SHM_V; char* B_lds = lds + LDS_BIAS;
    const int kb0 = cur.ja * KVBLK;
    bf16x8 qt_[8]; char* Qw = lds + LDS_Q + wid * (QBLK * D * 2);
#pragma unroll
    for (int d0 = 0; d0 < 8; ++d0) qt_[d0] = load8(cur.Q + (size_t)(wid * QBLK + r32) * D + d0 * 16 + hi * 8);
    SLOAD_H(cur.K, cur.V, cur.bias, kb0); VMW(); SWRITE_HK(0, cur.bias);
    { int r32q = r32, hiq = hi; asm volatile("" : "+v"(r32q), "+v"(hiq));
#pragma unroll
      for (int dd = 0; dd < 4; ++dd) { char* qd = Qw + KSWZ(r32q, (dd * 16 + hiq * 8) * 2); *(bf16x8*)qd = qt_[dd]; *(bf16x8*)(qd + 128) = qt_[dd + 4]; } }
    __syncthreads();
}
template <int MODE>
__device__ __forceinline__ void attn_block(const BlockRef& cur, const BlockRef& nxt, const Aux& X, char* lds, Seam& S, int tid_in) {
    constexpr bool SK = (MODE == MODE_WIN);
    int tid = tid_in; asm volatile("" : "+v"(tid));
    const int wid = __builtin_amdgcn_readfirstlane(tid >> 6), lane = tid & 63, r32 = lane & 31, hi = lane >> 5;
    const int W = cur.W, h = cur.h;
    const int j_lo = cur.ja, NT = cur.jb - cur.ja;
    const int kbn = nxt.ja * KVBLK;
    const int qlo = cur.P0 + wid * QBLK, qm = qlo + r32 - 4 * hi;
    char* V_lds = lds; char* K_lds = lds + 2 * SHM_V; char* B_lds = lds + LDS_BIAS;
    char* Qw = lds + LDS_Q + wid * (QBLK * D * 2);
    float* ws = (float*)(lds + LDS_WSF) + wid * 128; float* li_l = ws, * al_l = ws + 32, * gw_l = ws + 64;
    const float* Td = (const float*)(lds + LDS_T5) + h * 132;
    float m_reg = -1e30f, l_reg = 0; f32x16 o[4] = {};
    const int sr = tid >> 4, sc = (tid & 15) * 8, vst0 = v_st(sr, sc), vst1 = v_st(32 + sr, sc), kws = KSWZ(sr, sc * 2);
    const int vb0 = (int)(uintptr_t)V_lds + v_rd_base(lane);
    const bf16* Kh = cur.K; const bf16* Vh = cur.V;
    float c31 = 0.f; unsigned sw0 = 0, sw1 = 0, sw2 = 0, sw3 = 0;
    if (MODE != MODE_FOX) c31 = Td[128];
    if (MODE == MODE_SLC) { const u32x4 wv = *(const u32x4*)(X.selm + ((size_t)(h / 3) * SEQ + qlo + r32) * 4); sw0 = wv.x; sw1 = wv.y; sw2 = wv.z; sw3 = wv.w; }
    const float* bF = cur.bias;
#define RESC(a) do { if (__any((a) < 1.f)) { if (hi == 0) al_l[r32] = (a); asm volatile("s_waitcnt lgkmcnt(0)" ::: "memory");              \
                     for (int d_ = 0; d_ < 4; ++d_) for (int r = 0; r < 16; ++r) o[d_][r] *= al_l[crow(r, hi)]; } } while (0)
#define KBASE(t) ((j_lo + (t)) * KVBLK)
#define ACT(t) (KBASE(t) <= qlo + QBLK - 1 && KBASE(t) + KVBLK - 1 >= qlo - W + 1)
#define CV(t) ((MODE == MODE_SLC) ? slc_cv(j_lo + (t), sw0, sw1, sw2, sw3, c31) : c31)
#define MASKT(P0_, P1_, t) do { const int kb_ = KBASE(t);                                                                                \
        if (MODE != MODE_FOX && (!SK || ACT(t)) && (kb_ + KVBLK - 1 + 112 >= qlo)) t5_tile(P0_, P1_, qm - kb_, Td);                      \
        if ((!SK || ACT(t)) && (kb_ + KVBLK - 1 > qlo || kb_ <= qlo + QBLK - 1 - W)) mask_tile(P0_, P1_, qm - kb_, (unsigned)W); } while (0)
    f32x16 p0, p1; float mnX, alX; bf16x8 pa0, pa1, pa2, pa3; bf16x8 qn_[8];
    SWRITE_HV(0);
    __syncthreads();
#define STEP(t, PB) do { const bool last_ = ((t) + 1 == NT);                                                                  \
        if (!last_) SLOAD_H(Kh, Vh, bF, KBASE((t) + 1)); else SLOAD_H(nxt.K, nxt.V, nxt.bias, kbn);                           \
        SBAR(); qkt<PB, SK, MODE>(p0, p1, K_lds, B_lds, CV(t), r32, hi, Qw, ACT(t)); SBAR();                                   \
        if (last_) { _Pragma("unroll") for (int d0 = 0; d0 < 8; ++d0) qn_[d0] = load8(nxt.Q + (size_t)(wid * QBLK + r32) * D + d0 * 16 + hi * 8); } \
        MASKT(p0, p1, (t)); partialSM(p0, p1, m_reg, mnX, alX); RESC(alX);                                                    \
        finishSM(p0, p1, alX, l_reg, pa0, pa1, pa2, pa3); SBAR();                                                             \
        pv_tile<PB, SK>(o, vb0, pa0, pa1, pa2, pa3, ACT(t)); SBAR();                                                          \
        if (!last_) { VMW(); SWRITE_H(1 - (PB), bF); }                                                                        \
        __syncthreads(); } while (0)
    for (int t = 0; t < NT; t += 2) { STEP(t, 0); if (t + 1 < NT) STEP(t + 1, 1); }
#undef STEP
    VMW(); SWRITE_HK(0, nxt.bias);
    { int r32q = r32, hiq = hi; asm volatile("" : "+v"(r32q), "+v"(hiq));
#pragma unroll
      for (int dd = 0; dd < 4; ++dd) { char* qd = Qw + KSWZ(r32q, (dd * 16 + hiq * 8) * 2); *(bf16x8*)qd = qn_[dd]; *(bf16x8*)(qd + 128) = qn_[dd + 4]; } }
    SBAR();
    bool do_epi = true;
    if (MODE == MODE_SLC && cur.nch > 1) {
        constexpr float C2m = 1.4426950408889634f * SCALE;
        float* PM = X.part_ml + (size_t)(cur.bid * 8 + cur.chunk) * 512 + (wid * 32 + r32) * 2;
        { const __amdgpu_buffer_rsrc_t rs = __builtin_amdgcn_make_buffer_rsrc((void*)((unsigned char*)X.part_o + (size_t)(cur.bid * 8 + cur.chunk) * 65536), 0, 65536, 0x00020000);
#pragma unroll
          for (int d0 = 0; d0 < 4; ++d0)
#pragma unroll
            for (int rq = 0; rq < 2; ++rq) { u32x4 wv = {cvtpk(o[d0][8 * rq], o[d0][8 * rq + 1]), cvtpk(o[d0][8 * rq + 2], o[d0][8 * rq + 3]), cvtpk(o[d0][8 * rq + 4], o[d0][8 * rq + 5]), cvtpk(o[d0][8 * rq + 6], o[d0][8 * rq + 7])};
                __builtin_amdgcn_raw_buffer_store_b128(wv, rs, (wid * 8 + d0 * 2 + rq) * 1024 + lane * 16, 0, 16); } }
        if (hi == 0) { __hip_atomic_store((__attribute__((address_space(1))) float*)PM, m_reg, __ATOMIC_RELAXED, __HIP_MEMORY_SCOPE_AGENT); __hip_atomic_store((__attribute__((address_space(1))) float*)(PM + 1), l_reg, __ATOMIC_RELAXED, __HIP_MEMORY_SCOPE_AGENT); }
        asm volatile("s_waitcnt vmcnt(0)" ::: "memory"); __syncthreads();
        if (tid == 0) {
            const unsigned old = __hip_atomic_fetch_add((__attribute__((address_space(1))) unsigned*)(X.arr + cur.bid), 1u, __ATOMIC_RELAXED, __HIP_MEMORY_SCOPE_AGENT); const unsigned lastf = (old + 1u == (unsigned)cur.nch) ? 1u : 0u;
            if (lastf) { __builtin_amdgcn_fence(__ATOMIC_ACQUIRE, "agent"); asm volatile("s_waitcnt vmcnt(0)" ::: "memory"); }
            *X.ldsflag = lastf; }
        __syncthreads();
        do_epi = (*X.ldsflag != 0u);
        if (do_epi) {
            for (int c2 = 0; c2 < cur.nch; ++c2) {
                const u32x4* PO2 = (const u32x4*)((const unsigned char*)X.part_o + (size_t)(cur.bid * 8 + c2) * 65536) + wid * 8 * 64 + lane; const float* PM2 = X.part_ml + (size_t)(cur.bid * 8 + c2) * 512 + (wid * 32 + r32) * 2;
                const float m2 = __hip_atomic_load((__attribute__((address_space(1))) const float*)PM2, __ATOMIC_RELAXED, __HIP_MEMORY_SCOPE_AGENT), l2 = __hip_atomic_load((__attribute__((address_space(1))) const float*)(PM2 + 1), __ATOMIC_RELAXED, __HIP_MEMORY_SCOPE_AGENT);
                float f1, f2;
                if (c2 == 0) { f1 = 0.f; f2 = 1.f; l_reg = l2; m_reg = m2; }
                else { const float M = fmaxf(m_reg, m2); f1 = __builtin_amdgcn_exp2f((m_reg - M) * C2m); f2 = __builtin_amdgcn_exp2f((m2 - M) * C2m); l_reg = l_reg * f1 + l2 * f2; m_reg = M; }
                asm volatile("s_waitcnt lgkmcnt(0)" ::: "memory");
                if (hi == 0) { al_l[r32] = f1; gw_l[r32] = f2; }
                asm volatile("s_waitcnt lgkmcnt(0)" ::: "memory");
#pragma unroll
                for (int rq = 0; rq < 2; ++rq) { float f1v[8], f2v[8];
#pragma unroll
                    for (int e = 0; e < 8; ++e) { f1v[e] = al_l[crow(8 * rq + e, hi)]; f2v[e] = gw_l[crow(8 * rq + e, hi)]; }
#pragma unroll
                    for (int d0 = 0; d0 < 4; ++d0) { const u32x4 wv = PO2[(d0 * 2 + rq) * 64];
#pragma unroll
                        for (int e = 0; e < 4; ++e) { const int r = 8 * rq + 2 * e; o[d0][r] = (c2 == 0 ? 0.f : o[d0][r] * f1v[2 * e]) + bflo(wv[e]) * f2v[2 * e]; o[d0][r + 1] = (c2 == 0 ? 0.f : o[d0][r + 1] * f1v[2 * e + 1]) + bfhi(wv[e]) * f2v[2 * e + 1]; } } }
                asm volatile("s_waitcnt lgkmcnt(0)" ::: "memory"); }
        }
    }
    if (do_epi) {
    int r32e = r32, hie = hi; asm volatile("" : "+v"(r32e), "+v"(hie));
    { float f = __builtin_amdgcn_rcpf(l_reg), gwv = 0.f;
      if (MODE == MODE_SLC) { const float* sm = X.small + (size_t)(qlo + r32e) * 32 + 6 + 3 * h; f *= 1.f / (1.f + __expf(-sm[1])); gwv = 1.f / (1.f + __expf(-sm[2])); }
      if (hie == 0) { li_l[r32e] = f; if (MODE == MODE_SLC) gw_l[r32e] = gwv; } }
    asm volatile("s_waitcnt lgkmcnt(0)" ::: "memory");
    float rli[16];
#pragma unroll
    for (int r = 0; r < 16; ++r) rli[r] = li_l[crow(r, hie)];
#pragma unroll
    for (int r = 0; r < 16; ++r) { const int q = qlo + crow(r, hie); float gwr = 0.f; if (MODE == MODE_SLC) gwr = gw_l[crow(r, hie)];
#pragma unroll
        for (int d0 = 0; d0 < 4; ++d0) { const int col = d0 * 32 + r32e; const float v = o[d0][r] * rli[r]; const float vn = __builtin_bit_cast(float, __builtin_amdgcn_mov_dpp(__builtin_bit_cast(int, v), 0xB1, 0xF, 0xF, true));
            if ((r32e & 1) == 0) {
                if (MODE == MODE_FOX) { const unsigned z2 = *(const unsigned*)(X.zf + (size_t)q * 768 + h * 128 + col);
                    *(unsigned*)(X.y + (size_t)q * 2048 + 512 + h * 128 + col) = cvtpk(v * silu_(bflo(z2)), vn * silu_(bfhi(z2))); }
                else if (MODE == MODE_WIN) { *(unsigned*)(X.ow + ((size_t)h * SEQ + q) * 128 + col) = cvtpk(v, vn); }
                else { const size_t oo = ((size_t)h * SEQ + q) * 128 + col; const unsigned c2 = *(const unsigned*)(X.oc + oo), w2 = *(const unsigned*)(X.ow + oo), z2 = *(const unsigned*)(X.zn + (size_t)q * 768 + h * 128 + col);
                    *(unsigned*)(X.y + (size_t)q * 2048 + 1280 + h * 128 + col) = cvtpk((v + bflo(c2) + gwr * bflo(w2)) * silu_(bflo(z2)), (vn + bfhi(c2) + gwr * bfhi(w2)) * silu_(bfhi(z2))); } } } }
    }
    __syncthreads();
#undef RESC
#undef KBASE
#undef ACT
#undef CV
#undef MASKT
}
#undef ROW
#undef VMW
#undef VMWN
#undef SLOAD_H
#undef SWRITE_HK
#undef SWRITE_HV
#undef SWRITE_H
#undef KSWZ
#undef SBAR
}
#define GAS __attribute__((address_space(1)))
#define LAS __attribute__((address_space(3)))
typedef unsigned short bf16;
typedef unsigned v4u __attribute__((ext_vector_type(4)));
typedef float f32x4 __attribute__((ext_vector_type(4)));
typedef short bf16x8 __attribute__((ext_vector_type(8)));
typedef GAS unsigned gu32;
typedef GAS unsigned long long gu64;
#define RLX_AGENT __ATOMIC_RELAXED, __HIP_MEMORY_SCOPE_AGENT
#define LDS_WAIT() asm volatile("s_waitcnt lgkmcnt(0)" ::: "memory")
#define VM_WAIT() asm volatile("s_waitcnt vmcnt(0)" ::: "memory")
__device__ __forceinline__ unsigned long long rt() { return __builtin_amdgcn_s_memrealtime(); }
__device__ __forceinline__ unsigned f2bf(float f) { unsigned u = __builtin_bit_cast(unsigned, f); return (u + 0x7fffu + ((u >> 16) & 1u)) >> 16; }
__device__ __forceinline__ unsigned pk2(float lo, float hi) { return f2bf(lo) | (f2bf(hi) << 16); }
#define XB_TMO      128
#define XB_XCNT(j)  (256  + 64 * (j))
#define XB_XSUB(j)  (1280 + 64 * (j))
#define XB_XGEN(j)  (2304 + 64 * (j))
#define XB_TOP      3328
#define XB_TOPGEN   3392
#define XCD_BAR_WORDS 3456
#define XB_SPIN_CAP (1u << 18)

__device__ __forceinline__ unsigned xb_ld(unsigned* p)              { return __hip_atomic_load(p, __ATOMIC_RELAXED, __HIP_MEMORY_SCOPE_AGENT); }
__device__ __forceinline__ unsigned xb_add(unsigned* p, unsigned v) { return __hip_atomic_fetch_add(p, v, __ATOMIC_RELAXED, __HIP_MEMORY_SCOPE_AGENT); }
__device__ __forceinline__ unsigned xb_xcc_id() { return (unsigned)__builtin_amdgcn_s_getreg((3 << 11) | 20) & 0xFu; }
#define XB_SPIN(cond, bar) do { unsigned _sp = 0; while (cond) { __builtin_amdgcn_s_sleep(1); \
    if ((++_sp & 255u) == 0u) { if (xb_ld(&(bar)[XB_TMO])) break; if (_sp > XB_SPIN_CAP) { atomicAdd(&(bar)[XB_TMO], 1u); break; } } } } while (0)

struct XcdBarrier {
    unsigned* bar; unsigned x;
    volatile LAS unsigned* st;
};

__device__ __forceinline__ XcdBarrier xcd_barrier_post(unsigned* bar, volatile LAS unsigned* st) {
    XcdBarrier b; b.bar = bar; b.x = xb_xcc_id(); b.st = st;
    if (threadIdx.x == 0) (void)xb_add(&bar[XB_XCNT(b.x)], 1u);
    return b;
}
__device__ __forceinline__ void xcd_barrier_complete(unsigned* bar, unsigned x, unsigned& nloc, unsigned& nx) {
    const unsigned G = gridDim.x * gridDim.y * gridDim.z;
    unsigned sum, cnt, mine, sp = 0u;
    for (;;) {
        sum = 0u; cnt = 0u; mine = 0u;
#pragma unroll
        for (unsigned j = 0; j < 16; ++j) { const unsigned c = xb_ld(&bar[XB_XCNT(j)]); sum += c; cnt += (c > 0u) ? 1u : 0u; mine = (j == x) ? c : mine; }
        if (sum == G) break;
        __builtin_amdgcn_s_sleep(1);
        if ((++sp & 255u) == 0u) { if (xb_ld(&bar[XB_TMO])) break; if (sp > XB_SPIN_CAP) { atomicAdd(&bar[XB_TMO], 1u); break; } }
    }
    nloc = mine > 0u ? mine : 1u; nx = cnt > 0u ? cnt : 1u;
}

__device__ __forceinline__ void xcd_barrier(const XcdBarrier& b) {
    asm volatile("s_waitcnt vmcnt(0)" ::: "memory");
    __syncthreads();
    if (threadIdx.x == 0) {
        unsigned* bar = b.bar;
        __builtin_amdgcn_s_waitcnt(0);
        unsigned nloc = b.st[0], nx = b.st[1];
        if (nloc == 0u) { xcd_barrier_complete(bar, b.x, nloc, nx); b.st[0] = nloc; b.st[1] = nx; }
        const unsigned old = xb_add(&bar[XB_XSUB(b.x)], 1u);
        const unsigned gen = old / nloc;
        if (old + 1u == (gen + 1u) * nloc) {
            __builtin_amdgcn_fence(__ATOMIC_RELEASE, "agent");
            asm volatile("s_waitcnt vmcnt(0)" ::: "memory");
            const unsigned og = xb_add(&bar[XB_TOP], 1u);
            const unsigned tg = og / nx;
            if (og + 1u == (tg + 1u) * nx) xb_add(&bar[XB_TOPGEN], 1u);
            else XB_SPIN(xb_ld(&bar[XB_TOPGEN]) == tg, bar);
            __builtin_amdgcn_fence(__ATOMIC_ACQUIRE, "agent");
            xb_add(&bar[XB_XGEN(b.x)], 1u);
            asm volatile("s_waitcnt vmcnt(0)" ::: "memory");
        } else {
            XB_SPIN(xb_ld(&bar[XB_XGEN(b.x)]) == gen, bar);
            __builtin_amdgcn_fence(__ATOMIC_ACQUIRE, "agent");
            asm volatile("s_waitcnt vmcnt(0)" ::: "memory");
        }
    }
    __syncthreads();
}
constexpr int NWAVES = 8, NTHR = 512;
constexpr int S = 8192, DM = 2048, DEPTH = 4, NIN = 8216, NBIG = 8192;
constexpr float SM_SCALE = 0.08838834764831845f, NORM_EPS = 1e-6f;
constexpr size_t MiB = 1u << 20, HEADB = (size_t)S * 128 * 2;
constexpr size_t WS_CTL = 0, CTL_ZERO_BYTES = 1 * MiB;
constexpr size_t WS_MOD = 1 * MiB, WS_B1P = 1 * MiB + 128 * 1024, WS_SMALL = 2 * MiB, WS_BIASF = 3 * MiB, WS_FT = 3 * MiB + 256 * 1024, WS_SELM = 3 * MiB + 512 * 1024;
constexpr size_t WS_KCMP = 4 * MiB, WS_VCMPT = 4 * MiB + 256 * 1024, WS_WSM = 5 * MiB, WS_W2T = 6 * MiB, WS_W1T = 8 * MiB, WS_WOUT = 24 * MiB, WS_WIN = 56 * MiB;
constexpr size_t WS_H = 184 * MiB, WS_CONV = 216 * MiB, WS_ZF = 248 * MiB, WS_ZN = 260 * MiB, WS_ATT = 272 * MiB, WS_OC = 346 * MiB, WS_OW = 358 * MiB, WS_Y = 370 * MiB, WS_Y2 = 402 * MiB;
constexpr size_t WS_PARTO = 466 * MiB, WS_PARTML = 568 * MiB;
constexpr size_t WS_PARTM = 576 * MiB;
constexpr size_t WS_NAIVE = 600 * MiB;
constexpr int HP_QF = 0, HP_KF = 6, HP_VF = 12, HP_QN = 18, HP_KC = 24, HP_VC = 26, HP_KS = 28, HP_VS = 30, HP_KW = 32, HP_VW = 34;
constexpr int CW_QD = 20480, CW_NORM = 21504, CW_ARR = 24576, CW_MLP = 32768;
constexpr int CW_BAR = 4096;
constexpr int RING_BYTES = 131072, LDSCTL_OFF = 146432, MISC_OFF = LDSCTL_OFF + 320, LDS_BYTES = 147456;
constexpr int NPH = 6, NSTEPS = 2 + DEPTH * NPH;
constexpr int SLC_CHUNK = 16;
constexpr int N_ITEMS_SLC = 864;
__device__ const unsigned short ITEMS_SLC[864] = {
  0x0818, 0x1020, 0x1028, 0x1030, 0x1038, 0x1138, 0x1840, 0x1940, 0x1848, 0x1948, 0x1850, 0x1950, 0x1858, 0x1958, 0x1a58, 0x2060,
  0x2160, 0x2260, 0x2068, 0x2168, 0x2268, 0x2070, 0x2170, 0x2270, 0x2078, 0x2178, 0x2278, 0x2378, 0x2880, 0x2980, 0x2a80, 0x2b80,
  0x2888, 0x2988, 0x2a88, 0x2b88, 0x2890, 0x2990, 0x2a90, 0x2b90, 0x2898, 0x2998, 0x2a98, 0x2b98, 0x2c98, 0x30a0, 0x31a0, 0x32a0,
  0x33a0, 0x34a0, 0x30a8, 0x31a8, 0x32a8, 0x33a8, 0x34a8, 0x30b0, 0x31b0, 0x32b0, 0x33b0, 0x34b0, 0x30b8, 0x31b8, 0x32b8, 0x33b8,
  0x34b8, 0x35b8, 0x38c0, 0x39c0, 0x3ac0, 0x3bc0, 0x3cc0, 0x3dc0, 0x38c8, 0x39c8, 0x3ac8, 0x3bc8, 0x3cc8, 0x3dc8, 0x38d0, 0x39d0,
  0x3ad0, 0x3bd0, 0x3cd0, 0x3dd0, 0x38d8, 0x39d8, 0x3ad8, 0x3bd8, 0x3cd8, 0x3dd8, 0x3ed8, 0x40e0, 0x41e0, 0x42e0, 0x43e0, 0x44e0,
  0x45e0, 0x46e0, 0x40e8, 0x41e8, 0x42e8, 0x43e8, 0x44e8, 0x45e8, 0x46e8, 0x40f0, 0x41f0, 0x42f0, 0x43f0, 0x44f0, 0x45f0, 0x46f0,
  0x40f8, 0x41f8, 0x42f8, 0x43f8, 0x44f8, 0x45f8, 0x46f8, 0x47f8, 0x0819, 0x1021, 0x1029, 0x1031, 0x1039, 0x1139, 0x1841, 0x1941,
  0x1849, 0x1949, 0x1851, 0x1951, 0x1859, 0x1959, 0x1a59, 0x2061, 0x2161, 0x2261, 0x2069, 0x2169, 0x2269, 0x2071, 0x2171, 0x2271,
  0x2079, 0x2179, 0x2279, 0x2379, 0x2881, 0x2981, 0x2a81, 0x2b81, 0x2889, 0x2989, 0x2a89, 0x2b89, 0x2891, 0x2991, 0x2a91, 0x2b91,
  0x2899, 0x2999, 0x2a99, 0x2b99, 0x2c99, 0x30a1, 0x31a1, 0x32a1, 0x33a1, 0x34a1, 0x30a9, 0x31a9, 0x32a9, 0x33a9, 0x34a9, 0x30b1,
  0x31b1, 0x32b1, 0x33b1, 0x34b1, 0x30b9, 0x31b9, 0x32b9, 0x33b9, 0x34b9, 0x35b9, 0x38c1, 0x39c1, 0x3ac1, 0x3bc1, 0x3cc1, 0x3dc1,
  0x38c9, 0x39c9, 0x3ac9, 0x3bc9, 0x3cc9, 0x3dc9, 0x38d1, 0x39d1, 0x3ad1, 0x3bd1, 0x3cd1, 0x3dd1, 0x38d9, 0x39d9, 0x3ad9, 0x3bd9,
  0x3cd9, 0x3dd9, 0x3ed9, 0x40e1, 0x41e1, 0x42e1, 0x43e1, 0x44e1, 0x45e1, 0x46e1, 0x40e9, 0x41e9, 0x42e9, 0x43e9, 0x44e9, 0x45e9,
  0x46e9, 0x40f1, 0x41f1, 0x42f1, 0x43f1, 0x44f1, 0x45f1, 0x46f1, 0x40f9, 0x41f9, 0x42f9, 0x43f9, 0x44f9, 0x45f9, 0x46f9, 0x47f9,
  0x081a, 0x1022, 0x102a, 0x1032, 0x103a, 0x113a, 0x1842, 0x1942, 0x184a, 0x194a, 0x1852, 0x1952, 0x185a, 0x195a, 0x1a5a, 0x2062,
  0x2162, 0x2262, 0x206a, 0x216a, 0x226a, 0x2072, 0x2172, 0x2272, 0x207a, 0x217a, 0x227a, 0x237a, 0x2882, 0x2982, 0x2a82, 0x2b82,
  0x288a, 0x298a, 0x2a8a, 0x2b8a, 0x2892, 0x2992, 0x2a92, 0x2b92, 0x289a, 0x299a, 0x2a9a, 0x2b9a, 0x2c9a, 0x30a2, 0x31a2, 0x32a2,
  0x33a2, 0x34a2, 0x30aa, 0x31aa, 0x32aa, 0x33aa, 0x34aa, 0x30b2, 0x31b2, 0x32b2, 0x33b2, 0x34b2, 0x30ba, 0x31ba, 0x32ba, 0x33ba,
  0x34ba, 0x35ba, 0x38c2, 0x39c2, 0x3ac2, 0x3bc2, 0x3cc2, 0x3dc2, 0x38ca, 0x39ca, 0x3aca, 0x3bca, 0x3cca, 0x3dca, 0x38d2, 0x39d2,
  0x3ad2, 0x3bd2, 0x3cd2, 0x3dd2, 0x38da, 0x39da, 0x3ada, 0x3bda, 0x3cda, 0x3dda, 0x3eda, 0x40e2, 0x41e2, 0x42e2, 0x43e2, 0x44e2,
  0x45e2, 0x46e2, 0x40ea, 0x41ea, 0x42ea, 0x43ea, 0x44ea, 0x45ea, 0x46ea, 0x40f2, 0x41f2, 0x42f2, 0x43f2, 0x44f2, 0x45f2, 0x46f2,
  0x40fa, 0x41fa, 0x42fa, 0x43fa, 0x44fa, 0x45fa, 0x46fa, 0x47fa, 0x081b, 0x1023, 0x102b, 0x1033, 0x103b, 0x113b, 0x1843, 0x1943,
  0x184b, 0x194b, 0x1853, 0x1953, 0x185b, 0x195b, 0x1a5b, 0x2063, 0x2163, 0x2263, 0x206b, 0x216b, 0x226b, 0x2073, 0x2173, 0x2273,
  0x207b, 0x217b, 0x227b, 0x237b, 0x2883, 0x2983, 0x2a83, 0x2b83, 0x288b, 0x298b, 0x2a8b, 0x2b8b, 0x2893, 0x2993, 0x2a93, 0x2b93,
  0x289b, 0x299b, 0x2a9b, 0x2b9b, 0x2c9b, 0x30a3, 0x31a3, 0x32a3, 0x33a3, 0x34a3, 0x30ab, 0x31ab, 0x32ab, 0x33ab, 0x34ab, 0x30b3,
  0x31b3, 0x32b3, 0x33b3, 0x34b3, 0x30bb, 0x31bb, 0x32bb, 0x33bb, 0x34bb, 0x35bb, 0x38c3, 0x39c3, 0x3ac3, 0x3bc3, 0x3cc3, 0x3dc3,
  0x38cb, 0x39cb, 0x3acb, 0x3bcb, 0x3ccb, 0x3dcb, 0x38d3, 0x39d3, 0x3ad3, 0x3bd3, 0x3cd3, 0x3dd3, 0x38db, 0x39db, 0x3adb, 0x3bdb,
  0x3cdb, 0x3ddb, 0x3edb, 0x40e3, 0x41e3, 0x42e3, 0x43e3, 0x44e3, 0x45e3, 0x46e3, 0x40eb, 0x41eb, 0x42eb, 0x43eb, 0x44eb, 0x45eb,
  0x46eb, 0x40f3, 0x41f3, 0x42f3, 0x43f3, 0x44f3, 0x45f3, 0x46f3, 0x40fb, 0x41fb, 0x42fb, 0x43fb, 0x44fb, 0x45fb, 0x46fb, 0x47fb,
  0x081c, 0x1024, 0x102c, 0x1034, 0x103c, 0x113c, 0x1844, 0x1944, 0x184c, 0x194c, 0x1854, 0x1954, 0x185c, 0x195c, 0x1a5c, 0x2064,
  0x2164, 0x2264, 0x206c, 0x216c, 0x226c, 0x2074, 0x2174, 0x2274, 0x207c, 0x217c, 0x227c, 0x237c, 0x2884, 0x2984, 0x2a84, 0x2b84,
  0x288c, 0x298c, 0x2a8c, 0x2b8c, 0x2894, 0x2994, 0x2a94, 0x2b94, 0x289c, 0x299c, 0x2a9c, 0x2b9c, 0x2c9c, 0x30a4, 0x31a4, 0x32a4,
  0x33a4, 0x34a4, 0x30ac, 0x31ac, 0x32ac, 0x33ac, 0x34ac, 0x30b4, 0x31b4, 0x32b4, 0x33b4, 0x34b4, 0x30bc, 0x31bc, 0x32bc, 0x33bc,
  0x34bc, 0x35bc, 0x38c4, 0x39c4, 0x3ac4, 0x3bc4, 0x3cc4, 0x3dc4, 0x38cc, 0x39cc, 0x3acc, 0x3bcc, 0x3ccc, 0x3dcc, 0x38d4, 0x39d4,
  0x3ad4, 0x3bd4, 0x3cd4, 0x3dd4, 0x38dc, 0x39dc, 0x3adc, 0x3bdc, 0x3cdc, 0x3ddc, 0x3edc, 0x40e4, 0x41e4, 0x42e4, 0x43e4, 0x44e4,
  0x45e4, 0x46e4, 0x40ec, 0x41ec, 0x42ec, 0x43ec, 0x44ec, 0x45ec, 0x46ec, 0x40f4, 0x41f4, 0x42f4, 0x43f4, 0x44f4, 0x45f4, 0x46f4,
  0x40fc, 0x41fc, 0x42fc, 0x43fc, 0x44fc, 0x45fc, 0x46fc, 0x47fc, 0x081d, 0x1025, 0x102d, 0x1035, 0x103d, 0x113d, 0x1845, 0x1945,
  0x184d, 0x194d, 0x1855, 0x1955, 0x185d, 0x195d, 0x1a5d, 0x2065, 0x2165, 0x2265, 0x206d, 0x216d, 0x226d, 0x2075, 0x2175, 0x2275,
  0x207d, 0x217d, 0x227d, 0x237d, 0x2885, 0x2985, 0x2a85, 0x2b85, 0x288d, 0x298d, 0x2a8d, 0x2b8d, 0x2895, 0x2995, 0x2a95, 0x2b95,
  0x289d, 0x299d, 0x2a9d, 0x2b9d, 0x2c9d, 0x30a5, 0x31a5, 0x32a5, 0x33a5, 0x34a5, 0x30ad, 0x31ad, 0x32ad, 0x33ad, 0x34ad, 0x30b5,
  0x31b5, 0x32b5, 0x33b5, 0x34b5, 0x30bd, 0x31bd, 0x32bd, 0x33bd, 0x34bd, 0x35bd, 0x38c5, 0x39c5, 0x3ac5, 0x3bc5, 0x3cc5, 0x3dc5,
  0x38cd, 0x39cd, 0x3acd, 0x3bcd, 0x3ccd, 0x3dcd, 0x38d5, 0x39d5, 0x3ad5, 0x3bd5, 0x3cd5, 0x3dd5, 0x38dd, 0x39dd, 0x3add, 0x3bdd,
  0x3cdd, 0x3ddd, 0x3edd, 0x40e5, 0x41e5, 0x42e5, 0x43e5, 0x44e5, 0x45e5, 0x46e5, 0x40ed, 0x41ed, 0x42ed, 0x43ed, 0x44ed, 0x45ed,
  0x46ed, 0x40f5, 0x41f5, 0x42f5, 0x43f5, 0x44f5, 0x45f5, 0x46f5, 0x40fd, 0x41fd, 0x42fd, 0x43fd, 0x44fd, 0x45fd, 0x46fd, 0x47fd,
  0x0810, 0x1130, 0x1a50, 0x2370, 0x2c90, 0x35b0, 0x3ed0, 0x47f0, 0x0811, 0x1131, 0x1a51, 0x2371, 0x2c91, 0x35b1, 0x3ed1, 0x47f1,
  0x0812, 0x1132, 0x1a52, 0x2372, 0x2c92, 0x35b2, 0x3ed2, 0x47f2, 0x0813, 0x1133, 0x1a53, 0x2373, 0x2c93, 0x35b3, 0x3ed3, 0x47f3,
  0x0814, 0x1134, 0x1a54, 0x2374, 0x2c94, 0x35b4, 0x3ed4, 0x47f4, 0x0815, 0x1135, 0x1a55, 0x2375, 0x2c95, 0x35b5, 0x3ed5, 0x47f5,
  0x0808, 0x1128, 0x1a48, 0x2368, 0x2c88, 0x35a8, 0x3ec8, 0x47e8, 0x0809, 0x1129, 0x1a49, 0x2369, 0x2c89, 0x35a9, 0x3ec9, 0x47e9,
  0x080a, 0x112a, 0x1a4a, 0x236a, 0x2c8a, 0x35aa, 0x3eca, 0x47ea, 0x080b, 0x112b, 0x1a4b, 0x236b, 0x2c8b, 0x35ab, 0x3ecb, 0x47eb,
  0x080c, 0x112c, 0x1a4c, 0x236c, 0x2c8c, 0x35ac, 0x3ecc, 0x47ec, 0x080d, 0x112d, 0x1a4d, 0x236d, 0x2c8d, 0x35ad, 0x3ecd, 0x47ed,
  0x0800, 0x1120, 0x1a40, 0x2360, 0x2c80, 0x35a0, 0x3ec0, 0x47e0, 0x0801, 0x1121, 0x1a41, 0x2361, 0x2c81, 0x35a1, 0x3ec1, 0x47e1,
  0x0802, 0x1122, 0x1a42, 0x2362, 0x2c82, 0x35a2, 0x3ec2, 0x47e2, 0x0803, 0x1123, 0x1a43, 0x2363, 0x2c83, 0x35a3, 0x3ec3, 0x47e3,
  0x0804, 0x1124, 0x1a44, 0x2364, 0x2c84, 0x35a4, 0x3ec4, 0x47e4, 0x0805, 0x1125, 0x1a45, 0x2365, 0x2c85, 0x35a5, 0x3ec5, 0x47e5 };
constexpr int N_ITEMS_FOX = 192;
__device__ const unsigned short ITEMS_FOX[192] = {
  0x08f8, 0x08f9, 0x08fa, 0x08fb, 0x08fc, 0x08fd, 0x08f0, 0x08f1, 0x08f2, 0x08f3, 0x08f4, 0x08f5, 0x08e8, 0x08e9, 0x08ea, 0x08eb,
  0x08ec, 0x08ed, 0x08e0, 0x08e1, 0x08e2, 0x08e3, 0x08e4, 0x08e5, 0x08d8, 0x08d9, 0x08da, 0x08db, 0x08dc, 0x08dd, 0x08d0, 0x08d1,
  0x08d2, 0x08d3, 0x08d4, 0x08d5, 0x08c8, 0x08c9, 0x08ca, 0x08cb, 0x08cc, 0x08cd, 0x08c0, 0x08c1, 0x08c2, 0x08c3, 0x08c4, 0x08c5,
  0x08b8, 0x08b9, 0x08ba, 0x08bb, 0x08bc, 0x08bd, 0x08b0, 0x08b1, 0x08b2, 0x08b3, 0x08b4, 0x08b5, 0x08a8, 0x08a9, 0x08aa, 0x08ab,
  0x08ac, 0x08ad, 0x08a0, 0x08a1, 0x08a2, 0x08a3, 0x08a4, 0x08a5, 0x0898, 0x0899, 0x089a, 0x089b, 0x089c, 0x089d, 0x0890, 0x0891,
  0x0892, 0x0893, 0x0894, 0x0895, 0x0888, 0x0889, 0x088a, 0x088b, 0x088c, 0x088d, 0x0880, 0x0881, 0x0882, 0x0883, 0x0884, 0x0885,
  0x0878, 0x0879, 0x087a, 0x087b, 0x087c, 0x087d, 0x0870, 0x0871, 0x0872, 0x0873, 0x0874, 0x0875, 0x0868, 0x0869, 0x086a, 0x086b,
  0x086c, 0x086d, 0x0860, 0x0861, 0x0862, 0x0863, 0x0864, 0x0865, 0x0858, 0x0859, 0x085a, 0x085b, 0x085c, 0x085d, 0x0850, 0x0851,
  0x0852, 0x0853, 0x0854, 0x0855, 0x0848, 0x0849, 0x084a, 0x084b, 0x084c, 0x084d, 0x0840, 0x0841, 0x0842, 0x0843, 0x0844, 0x0845,
  0x0838, 0x0839, 0x083a, 0x083b, 0x083c, 0x083d, 0x0830, 0x0831, 0x0832, 0x0833, 0x0834, 0x0835, 0x0828, 0x0829, 0x082a, 0x082b,
  0x082c, 0x082d, 0x0820, 0x0821, 0x0822, 0x0823, 0x0824, 0x0825, 0x0818, 0x0819, 0x081a, 0x081b, 0x081c, 0x081d, 0x0810, 0x0811,
  0x0812, 0x0813, 0x0814, 0x0815, 0x0808, 0x0809, 0x080a, 0x080b, 0x080c, 0x080d, 0x0800, 0x0801, 0x0802, 0x0803, 0x0804, 0x0805 };
__device__ const unsigned short SCHED_B[256 * 2] = {
  0x0800, 0xffff,
  0x0808, 0xffff,
  0x0810, 0xffff,
  0x0818, 0xffff,
  0x0820, 0xffff,
  0x0828, 0xffff,
  0x0830, 0xffff,
  0x0838, 0xffff,
  0x0840, 0xffff,
  0x0848, 0xffff,
  0x0850, 0xffff,
  0x0858, 0xffff,
  0x0860, 0xffff,
  0x0868, 0xffff,
  0x0870, 0xffff,
  0x0878, 0xffff,
  0x0880, 0xffff,
  0x0888, 0xffff,
  0x0890, 0xffff,
  0x0898, 0xffff,
  0x08a0, 0xffff,
  0x08a8, 0xffff,
  0x08b0, 0xffff,
  0x08b8, 0xffff,
  0x08c0, 0xffff,
  0x08c8, 0xffff,
  0x08d0, 0xffff,
  0x08d8, 0xffff,
  0x08e0, 0xffff,
  0x08e8, 0xffff,
  0x08f0, 0xffff,
  0x08f8, 0xffff,
  0x0801, 0xffff,
  0x0809, 0xffff,
  0x0811, 0xffff,
  0x0819, 0xffff,
  0x0821, 0xffff,
  0x0829, 0xffff,
  0x0831, 0xffff,
  0x0839, 0xffff,
  0x0841, 0xffff,
  0x0849, 0xffff,
  0x0851, 0xffff,
  0x0859, 0xffff,
  0x0861, 0xffff,
  0x0869, 0xffff,
  0x0871, 0xffff,
  0x0879, 0xffff,
  0x0881, 0xffff,
  0x0889, 0xffff,
  0x0891, 0xffff,
  0x0899, 0xffff,
  0x08a1, 0xffff,
  0x08a9, 0xffff,
  0x08b1, 0xffff,
  0x08b9, 0xffff,
  0x08c1, 0xffff,
  0x08c9, 0xffff,
  0x08d1, 0xffff,
  0x08d9, 0xffff,
  0x08e1, 0xffff,
  0x08e9, 0xffff,
  0x08f1, 0xffff,
  0x08f9, 0xffff,
  0x0802, 0xffff,
  0x080a, 0xffff,
  0x0812, 0xffff,
  0x081a, 0xffff,
  0x0822, 0xffff,
  0x082a, 0xffff,
  0x0832, 0xffff,
  0x083a, 0xffff,
  0x0842, 0xffff,
  0x084a, 0xffff,
  0x0852, 0xffff,
  0x085a, 0xffff,
  0x0862, 0xffff,
  0x086a, 0xffff,
  0x0872, 0xffff,
  0x087a, 0xffff,
  0x0882, 0xffff,
  0x088a, 0xffff,
  0x0892, 0xffff,
  0x089a, 0xffff,
  0x08a2, 0xffff,
  0x08aa, 0xffff,
  0x08b2, 0xffff,
  0x08ba, 0xffff,
  0x08c2, 0xffff,
  0x08ca, 0xffff,
  0x08d2, 0xffff,
  0x08da, 0xffff,
  0x08e2, 0xffff,
  0x08ea, 0xffff,
  0x08f2, 0xffff,
  0x08fa, 0xffff,
  0x0803, 0xffff,
  0x080b, 0xffff,
  0x0813, 0xffff,
  0x081b, 0xffff,
  0x0823, 0xffff,
  0x082b, 0xffff,
  0x0833, 0xffff,
  0x083b, 0xffff,
  0x0843, 0xffff,
  0x084b, 0xffff,
  0x0853, 0xffff,
  0x085b, 0xffff,
  0x0863, 0xffff,
  0x086b, 0xffff,
  0x0873, 0xffff,
  0x087b, 0xffff,
  0x0883, 0xffff,
  0x088b, 0xffff,
  0x0893, 0xffff,
  0x089b, 0xffff,
  0x08a3, 0xffff,
  0x08ab, 0xffff,
  0x08b3, 0xffff,
  0x08bb, 0xffff,
  0x08c3, 0xffff,
  0x08cb, 0xffff,
  0x08d3, 0xffff,
  0x08db, 0xffff,
  0x08e3, 0xffff,
  0x08eb, 0xffff,
  0x08f3, 0xffff,
  0x08fb, 0xffff,
  0x0804, 0xffff,
  0x080c, 0xffff,
  0x0814, 0xffff,
  0x081c, 0xffff,
  0x0824, 0xffff,
  0x082c, 0xffff,
  0x0834, 0xffff,
  0x083c, 0xffff,
  0x0844, 0xffff,
  0x084c, 0xffff,
  0x0854, 0xffff,
  0x085c, 0xffff,
  0x0864, 0xffff,
  0x086c, 0xffff,
  0x0874, 0xffff,
  0x087c, 0xffff,
  0x0884, 0xffff,
  0x088c, 0xffff,
  0x0894, 0xffff,
  0x089c, 0xffff,
  0x08a4, 0xffff,
  0x08ac, 0xffff,
  0x08b4, 0xffff,
  0x08bc, 0xffff,
  0x08c4, 0xffff,
  0x08cc, 0xffff,
  0x08d4, 0xffff,
  0x08dc, 0xffff,
  0x08e4, 0xffff,
  0x08ec, 0xffff,
  0x08f4, 0xffff,
  0x08fc, 0xffff,
  0x0805, 0xffff,
  0x080d, 0xffff,
  0x0815, 0xffff,
  0x081d, 0xffff,
  0x0825, 0xffff,
  0x082d, 0xffff,
  0x0835, 0xffff,
  0x083d, 0xffff,
  0x0845, 0xffff,
  0x084d, 0xffff,
  0x0855, 0xffff,
  0x085d, 0xffff,
  0x0865, 0xffff,
  0x086d, 0xffff,
  0x0875, 0xffff,
  0x087d, 0xffff,
  0x0885, 0xffff,
  0x088d, 0xffff,
  0x0895, 0xffff,
  0x089d, 0xffff,
  0x08a5, 0xffff,
  0x08ad, 0xffff,
  0x08b5, 0xffff,
  0x08bd, 0xffff,
  0x08c5, 0xffff,
  0x08cd, 0xffff,
  0x08d5, 0xffff,
  0x08dd, 0xffff,
  0x08e5, 0xffff,
  0x08ed, 0xffff,
  0x08f5, 0xffff,
  0x08fd, 0xffff,
  0xffff, 0xffff,
  0xffff, 0xffff,
  0xffff, 0xffff,
  0xffff, 0xffff,
  0xffff, 0xffff,
  0xffff, 0xffff,
  0xffff, 0xffff,
  0xffff, 0xffff,
  0xffff, 0xffff,
  0xffff, 0xffff,
  0xffff, 0xffff,
  0xffff, 0xffff,
  0xffff, 0xffff,
  0xffff, 0xffff,
  0xffff, 0xffff,
  0xffff, 0xffff,
  0xffff, 0xffff,
  0xffff, 0xffff,
  0xffff, 0xffff,
  0xffff, 0xffff,
  0xffff, 0xffff,
  0xffff, 0xffff,
  0xffff, 0xffff,
  0xffff, 0xffff,
  0xffff, 0xffff,
  0xffff, 0xffff,
  0xffff, 0xffff,
  0xffff, 0xffff,
  0xffff, 0xffff,
  0xffff, 0xffff,
  0xffff, 0xffff,
  0xffff, 0xffff,
  0xffff, 0xffff,
  0xffff, 0xffff,
  0xffff, 0xffff,
  0xffff, 0xffff,
  0xffff, 0xffff,
  0xffff, 0xffff,
  0xffff, 0xffff,
  0xffff, 0xffff,
  0xffff, 0xffff,
  0xffff, 0xffff,
  0xffff, 0xffff,
  0xffff, 0xffff,
  0xffff, 0xffff,
  0xffff, 0xffff,
  0xffff, 0xffff,
  0xffff, 0xffff,
  0xffff, 0xffff,
  0xffff, 0xffff,
  0xffff, 0xffff,
  0xffff, 0xffff,
  0xffff, 0xffff,
  0xffff, 0xffff,
  0xffff, 0xffff,
  0xffff, 0xffff,
  0xffff, 0xffff,
  0xffff, 0xffff,
  0xffff, 0xffff,
  0xffff, 0xffff,
  0xffff, 0xffff,
  0xffff, 0xffff,
  0xffff, 0xffff,
  0xffff, 0xffff };
__device__ const unsigned char T5_BUCKET[128] = { 0, 1, 2, 3, 4, 5, 6, 7, 8, 9, 10, 11, 12, 13, 14, 15, 16, 16, 16, 17, 17, 18, 18, 18, 19, 19, 19, 20, 20, 20, 20, 21, 21, 21, 21, 22, 22, 22, 22, 22, 23, 23, 23, 23, 23, 23, 24, 24, 24, 24, 24, 24, 25, 25, 25, 25, 25, 25, 25, 26, 26, 26, 26, 26, 26, 26, 26, 27, 27, 27, 27, 27, 27, 27, 27, 27, 27, 28, 28, 28, 28, 28, 28, 28, 28, 28, 28, 29, 29, 29, 29, 29, 29, 29, 29, 29, 29, 29, 29, 30, 30, 30, 30, 30, 30, 30, 30, 30, 30, 30, 30, 30, 30, 31, 31, 31, 31, 31, 31, 31, 31, 31, 31, 31, 31, 31, 31, 31 };
struct Args { const float* in[17]; float* out; unsigned char* ws; int step_lo, step_hi, li, pad; };
struct Ctx { LAS unsigned char* lds; int tid, lane, wave, vcu, G; };

#define swz_xor(v, pat) __builtin_bit_cast(float, __builtin_amdgcn_ds_swizzle(__builtin_bit_cast(int, (v)), (pat)))
__device__ __forceinline__ float other_half(float v, int lane) { return __builtin_bit_cast(float, __builtin_amdgcn_ds_bpermute((lane ^ 32) << 2, __builtin_bit_cast(int, v))); }
__device__ __forceinline__ float wave_sum(float v) {
    v += swz_xor(v, 0x041F); v += swz_xor(v, 0x081F); v += swz_xor(v, 0x101F); v += swz_xor(v, 0x201F); v += swz_xor(v, 0x401F);
    return __builtin_bit_cast(float, __builtin_amdgcn_readlane(__builtin_bit_cast(int, v), 0)) + __builtin_bit_cast(float, __builtin_amdgcn_readlane(__builtin_bit_cast(int, v), 32));
}
__device__ __forceinline__ float siluf(float v) { return v / (1.f + __expf(-v)); }
__device__ __forceinline__ float sigmf(float v) { return 1.f / (1.f + __expf(-v)); }

__device__ __forceinline__ void tr_item(const float* W, int ldw, int srccol0, int k0, bf16* WTrow0, int K, LAS float* scr, int lane) {
    { float tv[32]; const float* wp = W + (size_t)(k0 + (lane >> 5)) * ldw + srccol0 + (lane & 31);
#pragma unroll
      for (int i = 0; i < 32; ++i) tv[i] = wp[(size_t)(2 * i) * ldw];
#pragma unroll
      for (int i = 0; i < 32; ++i) scr[(2 * i + (lane >> 5)) * 33 + (lane & 31)] = tv[i]; }
    LDS_WAIT(); asm volatile("" ::: "memory");
    const int c = lane & 7;
#pragma unroll
    for (int j = 0; j < 4; ++j) { const int n = (lane >> 3) + 8 * j; const LAS float* s = scr + (8 * c) * 33 + n;
        v4u o; o.x = pk2(s[0 * 33], s[1 * 33]); o.y = pk2(s[2 * 33], s[3 * 33]); o.z = pk2(s[4 * 33], s[5 * 33]); o.w = pk2(s[6 * 33], s[7 * 33]);
        *(GAS v4u*)(WTrow0 + (size_t)n * K + 8 * c) = o; }
    LDS_WAIT(); asm volatile("" ::: "memory");
}
__device__ __forceinline__ void p0_prologue(const Args& a, const Ctx& C) {
    unsigned char* ws = a.ws;
    LAS float* fl = (LAS float*)C.lds;
    { const float* cvec = a.in[1]; const float* w_ada = a.in[2]; const float* b_ada = a.in[3]; float* mod = (float*)(ws + WS_MOD);
      for (int i = C.tid; i < DM; i += NTHR) fl[i] = siluf(cvec[i]);
      __syncthreads();
      for (int it = C.vcu; it < 768; it += C.G) {
          const int l = it / 192, cb = (it % 192) * 32, col = C.tid & 31, kg = C.tid >> 5;
          const float* w = w_ada + (size_t)l * DM * (3 * DM) + cb + col; float acc = 0.f;
          for (int k = kg * 128; k < kg * 128 + 128; k += 16) { float wv[16];
#pragma unroll
              for (int j = 0; j < 16; ++j) wv[j] = w[(size_t)(k + j) * (3 * DM)];
#pragma unroll
              for (int j = 0; j < 16; ++j) acc += fl[k + j] * wv[j]; }
          fl[2048 + kg * 32 + col] = acc; __syncthreads();
          if (C.tid < 32) { float s = 0.f;
#pragma unroll
              for (int g = 0; g < 16; ++g) s += fl[2048 + g * 32 + C.tid];
              mod[l * 3 * DM + cb + C.tid] = s + b_ada[l * 3 * DM + cb + C.tid]; }
          __syncthreads(); }
    }
    for (int it = C.vcu; it < 64; it += C.G) {
        const int l = it >> 4, kv = (it >> 3) & 1, kc = it & 7, col = C.tid & 255, kh = C.tid >> 8;
        const float* pe = (kv ? a.in[12] : a.in[9]) + l * 4096; const float* w1 = (kv ? a.in[13] : a.in[10]) + (size_t)l * 4096 * 256 + col; float acc = 0.f;
        const int kb = kc * 512 + kh * 256;
        for (int k = kb; k < kb + 256; k += 16) { float wv[16];
#pragma unroll
            for (int j = 0; j < 16; ++j) wv[j] = w1[(size_t)(k + j) * 256];
#pragma unroll
            for (int j = 0; j < 16; ++j) acc += pe[k + j] * wv[j]; }
        __syncthreads(); fl[C.tid] = acc; __syncthreads();
        if (C.tid < 256) ((float*)(ws + WS_B1P))[((l * 2 + kv) * 8 + kc) * 256 + C.tid] = fl[C.tid] + fl[C.tid + 256];
    }
    __syncthreads();
    LAS float* scr = (LAS float*)(C.lds + C.wave * 16384);
    const int gw = C.vcu * NWAVES + C.wave, NGW = C.G * NWAVES;
    constexpr int I_WIN = 32 * 256, I_WOUT = 32 * 64, I_W1 = 64 * 8, I_W2 = 4 * 4, I_L = I_WIN + I_WOUT + 2 * I_W1 + 2 * I_W2;
    for (int it = gw; it < DEPTH * I_L; it += NGW) {
        const int l = it / I_L; int r = it % I_L;
        if (r < I_WIN) { const int kb = r >> 8, nb = r & 255, j0 = nb * 32, src = j0 + (j0 < 4352 ? 0 : (j0 < 7424 ? 6 : 24));
            tr_item(a.in[6] + (size_t)l * DM * NIN, NIN, src, kb * 64, (bf16*)(ws + WS_WIN) + ((size_t)l * NBIG + j0) * DM + kb * 64, DM, scr, C.lane); continue; }
        r -= I_WIN;
        if (r < I_WOUT) { const int kb = r >> 6, nb = r & 63;
            tr_item(a.in[15] + (size_t)l * DM * DM, DM, nb * 32, kb * 64, (bf16*)(ws + WS_WOUT) + ((size_t)l * DM + nb * 32) * DM + kb * 64, DM, scr, C.lane); continue; }
        r -= I_WOUT;
        if (r < 2 * I_W1) { const int kv = r / I_W1, q = r % I_W1, kb = q >> 3, nb = q & 7;
            const float* W = (kv ? a.in[13] : a.in[10]) + (size_t)l * 4096 * 256;
            { float tv[32]; const float* wp = W + (size_t)(kb * 64 + (C.lane >> 5)) * 256 + nb * 32 + (C.lane & 31);
#pragma unroll
              for (int i = 0; i < 32; ++i) tv[i] = wp[(size_t)(2 * i) * 256];
#pragma unroll
              for (int i = 0; i < 32; ++i) scr[(2 * i + (C.lane >> 5)) * 33 + (C.lane & 31)] = tv[i]; }
            LDS_WAIT(); asm volatile("" ::: "memory");
            const int fr = C.lane & 15, fq = C.lane >> 4; bf16* dst = (bf16*)(ws + WS_W1T) + ((size_t)((l * 2 + kv) * 8 + nb) * 2 * 128 * 64) * 8;
#pragma unroll
            for (int t = 0; t < 2; ++t)
#pragma unroll
                for (int ksl = 0; ksl < 2; ++ksl) { const LAS float* sp = scr + (32 * ksl + 8 * fq) * 33 + 16 * t + fr;
                    v4u o; o.x = pk2(sp[0 * 33], sp[1 * 33]); o.y = pk2(sp[2 * 33], sp[3 * 33]); o.z = pk2(sp[4 * 33], sp[5 * 33]); o.w = pk2(sp[6 * 33], sp[7 * 33]);
                    *(GAS v4u*)(dst + ((size_t)(t * 128 + 2 * kb + ksl) * 64 + C.lane) * 8) = o; }
            LDS_WAIT(); asm volatile("" ::: "memory"); continue; }
        r -= 2 * I_W1;
        { const int kv = r / I_W2, q = r % I_W2, kb = q >> 2, nb = q & 3;
            tr_item((kv ? a.in[14] : a.in[11]) + (size_t)l * 256 * 128, 128, nb * 32, kb * 64, (bf16*)(ws + WS_W2T) + ((size_t)(l * 2 + kv) * 128 + nb * 32) * 256 + kb * 64, 256, scr, C.lane); }
    }
    for (int idx = gw * 64 + C.lane; idx < DEPTH * 32 * DM; idx += NGW * 64) {
        const int l = idx / (32 * DM), n = (idx / DM) & 31, k = idx % DM;
        float v = 0.f; if (n < 24) v = a.in[6][(size_t)l * DM * NIN + (size_t)k * NIN + (n < 6 ? 4352 + n : 7430 + (n - 6))];
        ((bf16*)(ws + WS_WSM))[idx] = (bf16)f2bf(v);
    }
}

__device__ __forceinline__ void rowpass(const Args& a, const Ctx& C, int l) {
    unsigned char* ws = a.ws; const float* mod = (const float*)(ws + WS_MOD);
    const float* xin = (l <= 1) ? a.in[0] : a.out; const float* y2 = (const float*)(ws + WS_Y2);
    const int gw = C.vcu * NWAVES + C.wave, NGW = C.G * NWAVES;
    f32x4 a1[8], a2[8], a3[8];
#pragma unroll
    for (int j = 0; j < 8; ++j) { const int c = 4 * C.lane + 256 * j;
        if (l > 0) { const f32x4 g = *(const f32x4*)(mod + (l - 1) * 3 * DM + 2 * DM + c), p = *(const f32x4*)(a.in[5] + (l - 1) * DM + c); a1[j] = g * p; } else a1[j] = (f32x4){0.f, 0.f, 0.f, 0.f};
        if (l < DEPTH) { const f32x4 p = *(const f32x4*)(a.in[4] + l * DM + c), sc = *(const f32x4*)(mod + l * 3 * DM + DM + c); a2[j] = p * (sc + 1.0f); a3[j] = *(const f32x4*)(mod + l * 3 * DM + c); }
        else { a2[j] = (f32x4){0.f, 0.f, 0.f, 0.f}; a3[j] = a2[j]; } }
    for (int m = gw; m < S; m += NGW) {
        f32x4 x[8];
#pragma unroll
        for (int j = 0; j < 8; ++j) x[j] = *(const f32x4*)(xin + (size_t)m * DM + 4 * C.lane + 256 * j);
        if (l > 0) {
            f32x4 y[8]; float ss = 0.f;
#pragma unroll
            for (int j = 0; j < 8; ++j) { y[j] = *(const f32x4*)(y2 + (size_t)m * DM + 4 * C.lane + 256 * j); ss += (y[j].x * y[j].x + y[j].y * y[j].y) + (y[j].z * y[j].z + y[j].w * y[j].w); }
            const float rs = __builtin_amdgcn_rsqf(wave_sum(ss) * (1.f / DM) + NORM_EPS);
#pragma unroll
            for (int j = 0; j < 8; ++j) { x[j] = x[j] + a1[j] * (y[j] * rs); *(f32x4*)(a.out + (size_t)m * DM + 4 * C.lane + 256 * j) = x[j]; }
        }
        if (l < DEPTH) {
            float ss = 0.f;
#pragma unroll
            for (int j = 0; j < 8; ++j) ss += (x[j].x * x[j].x + x[j].y * x[j].y) + (x[j].z * x[j].z + x[j].w * x[j].w);
            const float rs = __builtin_amdgcn_rsqf(wave_sum(ss) * (1.f / DM) + NORM_EPS);
            bf16* hrow = (bf16*)(ws + WS_H) + (size_t)m * DM;
#pragma unroll
            for (int j = 0; j < 8; ++j) { const f32x4 hv = (x[j] * rs) * a2[j] + a3[j];
                *(unsigned long long*)(hrow + 4 * C.lane + 256 * j) = (unsigned long long)pk2(hv.x, hv.y) | ((unsigned long long)pk2(hv.z, hv.w) << 32); }
        }
    }
}

typedef float f32x4m __attribute__((ext_vector_type(4)));
__device__ __forceinline__ void small_unit(const Args& a, const Ctx& C, int l, int u) {
    const bf16* H = (const bf16*)(a.ws + WS_H); const bf16* W = (const bf16*)(a.ws + WS_WSM) + (size_t)l * 32 * DM; float* out = (float*)(a.ws + WS_SMALL);
    const int mt = C.wave & 3, nt = C.wave >> 2, fr = C.lane & 15, fq = C.lane >> 4, r0 = u * 64 + mt * 16;
    const bf16* ap = H + (size_t)(r0 + fr) * DM + 8 * fq; const bf16* bp = W + (size_t)(nt * 16 + fr) * DM + 8 * fq;
    f32x4 acc = {0.f, 0.f, 0.f, 0.f};
#pragma unroll 8
    for (int k0 = 0; k0 < DM; k0 += 32) { const bf16x8 av = *(const bf16x8*)(ap + k0), bv = *(const bf16x8*)(bp + k0); acc = __builtin_amdgcn_mfma_f32_16x16x32_bf16(av, bv, acc, 0, 0, 0); }
#pragma unroll
    for (int i = 0; i < 4; ++i) out[(size_t)(r0 + 4 * fq + i) * 32 + nt * 16 + fr] = acc[i];
    if (nt == 0 && fr < 6) *(f32x4*)((float*)(a.ws + WS_FT) + (size_t)fr * S + r0 + 4 * fq) = acc;
}
__device__ __forceinline__ void build_t5(char* ldsg, const float* relb, int tid) {
    float* T = (float*)(ldsg + att::LDS_T5);
    for (int i = tid; i < 6 * 129; i += NTHR) { const int h = i / 129, d = i % 129; const float c31 = relb[31 * 6 + h];
        T[h * 132 + d] = (d < 128 ? (relb[(int)T5_BUCKET[d < 128 ? d : 127] * 6 + h] - c31) : c31) * (1.0f / SM_SCALE); }
    __syncthreads();
}
__device__ __forceinline__ att::BlockRef make_ref(unsigned char* ws, int mode, unsigned item, int ja_override) {
    att::BlockRef r; const att::bf16* P = (const att::bf16*)(ws + WS_ATT); constexpr size_t PL = (size_t)S * 128;
    const int h = item & 7, qb = (item >> 3) & 31, chunk = (item >> 8) & 7, nch = (item >> 11) & 15;
    const int qp = (mode == att::MODE_FOX) ? HP_QF + h : HP_QN + h;
    const int kp = (mode == att::MODE_FOX) ? HP_KF + h : ((mode == att::MODE_WIN) ? HP_KW + h / 3 : HP_KS + h / 3);
    const int vp = (mode == att::MODE_FOX) ? HP_VF + h : ((mode == att::MODE_WIN) ? HP_VW + h / 3 : HP_VS + h / 3);
    r.Q = P + qp * PL + (size_t)qb * 256 * 128; r.K = P + kp * PL; r.V = P + vp * PL;
    r.bias = (mode == att::MODE_FOX) ? (const float*)(ws + WS_BIASF) + (size_t)h * S : nullptr;
    r.P0 = qb * 256; r.W = (mode == att::MODE_WIN) ? 512 : att::WBIG; r.h = h; r.mode = mode;
    const int nt = 4 * (qb + 1);
    if (mode == att::MODE_WIN) { r.ja = att::swa_jlo(r.P0, 512); r.jb = nt; }
    else if (mode == att::MODE_FOX) { r.ja = ja_override; r.jb = nt; }
    else { r.ja = SLC_CHUNK * chunk; r.jb = (SLC_CHUNK * chunk + SLC_CHUNK < nt) ? SLC_CHUNK * chunk + SLC_CHUNK : nt; }
    r.bid = h * 32 + qb; r.chunk = chunk; r.nch = nch; return r;
}
__device__ __forceinline__ att::Aux make_aux(unsigned char* ws, int l, volatile unsigned* ldsflag, int rep = 0) {
    att::Aux X; X.biasF = (const float*)(ws + WS_BIASF); X.selm = (const unsigned*)(ws + WS_SELM); X.small = (const float*)(ws + WS_SMALL);
    X.zf = (const att::bf16*)(ws + WS_ZF); X.zn = (const att::bf16*)(ws + WS_ZN); X.oc = (const att::bf16*)(ws + WS_OC); X.ow = (att::bf16*)(ws + WS_OW); X.y = (att::bf16*)(ws + WS_Y);
    X.part_o = (float*)(ws + WS_PARTO); X.part_ml = (float*)(ws + WS_PARTML); X.arr = (unsigned*)(ws + WS_CTL) + CW_ARR + 256 * l + 1024 * rep; X.ldsflag = ldsflag; return X;
}
__device__ __forceinline__ int fox_prune(unsigned char* ws, int l, int h, int qb, int lane) {
    const unsigned* nm = (const unsigned*)(ws + WS_CTL) + CW_NORM + 64 * l;
    const float qn = __builtin_bit_cast(float, __hip_atomic_load(nm + h, __ATOMIC_RELAXED, __HIP_MEMORY_SCOPE_AGENT)), kn = __builtin_bit_cast(float, __hip_atomic_load(nm + 8 + h, __ATOMIC_RELAXED, __HIP_MEMORY_SCOPE_AGENT));
    const float B2 = 2.f * __builtin_sqrtf(qn * kn) * SM_SCALE + 30.f;
    const float* bf = (const float*)(ws + WS_BIASF) + (size_t)h * S; const int nt = 4 * (qb + 1);
    const float c0 = -bf[qb * 256] * SM_SCALE;
    const int j0 = lane, j1 = lane + 64;
    const bool k0 = (j0 < nt) && !(c0 + bf[64 * (j0 < nt ? j0 : 0) + 63] * SM_SCALE + B2 < 0.f);
    const bool k1 = (j1 < nt) && !(c0 + bf[64 * (j1 < nt ? j1 : 0) + 63] * SM_SCALE + B2 < 0.f);
    const unsigned long long m0 = __ballot(k0), m1 = __ballot(k1);
    int jp = m0 ? (int)__builtin_ctzll(m0) : (m1 ? 64 + (int)__builtin_ctzll(m1) : nt - 1);
    return jp < nt - 4 ? jp : nt - 4;
}
__device__ __forceinline__ unsigned q_fetch(unsigned* head, volatile LAS unsigned* slot, int tid) {
    if (tid == 0) *slot = __hip_atomic_fetch_add(head, 1u, __ATOMIC_RELAXED, __HIP_MEMORY_SCOPE_AGENT);
    __syncthreads(); const unsigned v = *slot; __syncthreads(); return v;
}
template <int MODE>
__device__ __forceinline__ void attn_stream(unsigned char* ws, char* ldsg, int l, volatile LAS unsigned* misc, const unsigned short* list, int tid) {
    unsigned code = list[0]; if (code == 0xFFFFu) return;
    const att::Aux X = make_aux(ws, l, (volatile unsigned*)(misc + 1));
    att::BlockRef cur = make_ref(ws, MODE, code, 0); att::Seam Sm;
    att::attn_prime(cur, ldsg, Sm, tid);
    for (int i = 1;; ++i) {
        const unsigned nc = list[i]; const bool last = (nc == 0xFFFFu);
        const att::BlockRef nxt = last ? cur : make_ref(ws, MODE, nc, 0);
        att::attn_block<MODE>(cur, nxt, X, ldsg, Sm, tid);
        if (last) break;
        cur = nxt;
    }
}
template <int MODE>
__device__ __forceinline__ void attn_stream_q(unsigned char* ws, char* ldsg, int l, volatile LAS unsigned* misc, const unsigned short* items, int nitems, unsigned* head, int tid, int rep) {
    unsigned idx = q_fetch(head, misc, tid); if (idx >= (unsigned)nitems) return;
    const att::Aux X = make_aux(ws, l, (volatile unsigned*)(misc + 1), rep);
    unsigned it = items[idx];
    att::BlockRef cur = make_ref(ws, MODE, it, MODE == att::MODE_FOX ? fox_prune(ws, l, it & 7, (it >> 3) & 31, tid & 63) : 0); att::Seam Sm;
    att::attn_prime(cur, ldsg, Sm, tid);
    for (;;) {
        idx = q_fetch(head, misc, tid); const bool last = idx >= (unsigned)nitems;
        it = last ? 0u : items[idx];
        const att::BlockRef nxt = last ? cur : make_ref(ws, MODE, it, MODE == att::MODE_FOX ? fox_prune(ws, l, it & 7, (it >> 3) & 31, tid & 63) : 0);
        att::attn_block<MODE>(cur, nxt, X, ldsg, Sm, tid);
        if (last) break;
        cur = nxt;
    }
}
__device__ __forceinline__ void fox_norms(unsigned char* ws, int l, int wslot, int nslots, int lane_in) {
    int lane = lane_in; asm volatile("" : "+v"(lane));
    const bf16* P = (const bf16*)(ws + WS_ATT); unsigned* nm = (unsigned*)(ws + WS_CTL) + CW_NORM + 64 * l;
    for (int pl = 0; pl < 12; ++pl) { const bf16* base = P + (size_t)(pl < 6 ? HP_QF + pl : HP_KF + pl - 6) * S * 128; float mx = 0.f;
        for (int r4 = wslot; r4 < S / 4; r4 += nslots) { const bf16x8 v = *(const bf16x8*)(base + (size_t)(r4 * 4 + (lane >> 4)) * 128 + (lane & 15) * 8); float ss = 0.f;
#pragma unroll
            for (int j = 0; j < 8; ++j) { const float f = __builtin_bit_cast(float, (unsigned)(unsigned short)v[j] << 16); ss += f * f; }
            ss += swz_xor(ss, 0x041F); ss += swz_xor(ss, 0x081F); ss += swz_xor(ss, 0x101F); ss += swz_xor(ss, 0x201F);
            mx = fmaxf(mx, ss); }
        mx = fmaxf(mx, swz_xor(mx, 0x401F)); mx = fmaxf(mx, __builtin_bit_cast(float, __builtin_amdgcn_readlane(__builtin_bit_cast(int, mx), 32)));
        if (lane == 0) atomicMax(nm + (pl < 6 ? pl : 8 + pl - 6), __builtin_bit_cast(unsigned, mx)); }
}
__device__ __forceinline__ void conv_phase(const Args& a, const Ctx& C, int l) {
    const bf16* cv = (const bf16*)(a.ws + WS_CONV); bf16* Y = (bf16*)(a.ws + WS_Y); const float* cw = a.in[8] + l * 3 * 512;
    for (int idx = C.vcu * NTHR + C.tid; idx < S * 64; idx += C.G * NTHR) {
        const int s = idx >> 6, c = (idx & 63) * 8; float z[8];
#pragma unroll
        for (int e = 0; e < 8; ++e) z[e] = 0.f;
#pragma unroll
        for (int j = 0; j < 3; ++j) { const int t = s + j - 2; if (t >= 0) { const v4u uu = *(const v4u*)(cv + (size_t)t * 2048 + c), gg = *(const v4u*)(cv + (size_t)t * 2048 + 1024 + c);
#pragma unroll
            for (int e = 0; e < 4; ++e) { const unsigned uw = uu[e], gw = gg[e];
                z[2 * e] += cw[j * 512 + c + 2 * e] * (att::bflo(gw) * att::bflo(uw)); z[2 * e + 1] += cw[j * 512 + c + 2 * e + 1] * (att::bfhi(gw) * att::bfhi(uw)); } } }
        const v4u bb = *(const v4u*)(cv + (size_t)s * 2048 + 512 + c), zz = *(const v4u*)(cv + (size_t)s * 2048 + 1536 + c); v4u o;
#pragma unroll
        for (int e = 0; e < 4; ++e) o[e] = pk2(att::bflo(bb[e]) * z[2 * e] * siluf(att::bflo(zz[e])), att::bfhi(bb[e]) * z[2 * e + 1] * siluf(att::bfhi(zz[e])));
        *(v4u*)(Y + (size_t)s * 2048 + c) = o;
    }
}
__device__ __forceinline__ void mlp_quarter(const Args& a, const Ctx& C, int l, int qu, volatile LAS unsigned* flag) {
    unsigned char* ws = a.ws; const int u = qu >> 2, hq = qu & 3, kv = u >> 6, g = (u >> 5) & 1, nb = u & 31, fr = C.lane & 15, fq = C.lane >> 4, w = C.wave, ct = w & 3, kh = w >> 2;
    const bf16* src = (const bf16*)(ws + WS_ATT) + (size_t)((kv ? HP_VC : HP_KC) + g) * S * 128 + (size_t)(256 * nb) * 128;
    LAS unsigned char* As = C.lds; LAS float* red = (LAS float*)(C.lds + 69632); LAS bf16* hid = (LAS bf16*)(C.lds + 69632 + 4096);
    __syncthreads();
    { v4u tv[9];
#pragma unroll
      for (int i = 0; i < 9; ++i) { const int ch = C.tid + i * NTHR; if (ch < 4352) tv[i] = *(const v4u*)(src + (size_t)ch * 8); }
#pragma unroll
      for (int i = 0; i < 9; ++i) { const int ch = C.tid + i * NTHR; if (ch < 4352) { const int R = ch >> 4, c = ch & 15; *(LAS v4u*)(As + R * 256 + ((c ^ ((R >> 4) & 15)) << 4)) = tv[i]; } } }
    __syncthreads();
    const int T = 4 * hq + ct;
    const bf16* bp = (const bf16*)(ws + WS_W1T) + ((size_t)(((l * 2 + kv) * 8 + (T >> 1)) * 2 + (T & 1)) * 128 * 64 + C.lane) * 8;
    f32x4 acc0 = {0.f, 0.f, 0.f, 0.f};
    for (int ks0 = 64 * kh; ks0 < 64 * kh + 64; ks0 += 16) { bf16x8 b0[16];
#pragma unroll
        for (int j = 0; j < 16; ++j) b0[j] = *(const bf16x8*)(bp + (size_t)(ks0 + j) * 512);
#pragma unroll
        for (int j = 0; j < 16; ++j) { const int ks = ks0 + j, R = 16 * fr + (ks >> 2), c = 4 * (ks & 3) + fq; const bf16x8 av = *(const LAS bf16x8*)(As + R * 256 + ((c ^ ((R >> 4) & 15)) << 4));
            acc0 = __builtin_amdgcn_mfma_f32_16x16x32_bf16(av, b0[j], acc0, 0, 0, 0); } }
    if (kh == 1) *(LAS f32x4*)(red + ct * 256 + C.lane * 4) = acc0;
    __syncthreads();
    if (kh == 0) { const f32x4 o2 = *(const LAS f32x4*)(red + ct * 256 + C.lane * 4);
        const float* b1p = (const float*)(ws + WS_B1P) + (size_t)(l * 2 + kv) * 8 * 256 + 16 * T + fr; float bs0 = 0.f;
#pragma unroll
        for (int cchunk = 0; cchunk < 8; ++cchunk) bs0 += b1p[cchunk * 256];
#pragma unroll
        for (int i = 0; i < 4; ++i) hid[(4 * fq + i) * 72 + 16 * ct + fr] = (bf16)f2bf(siluf(acc0[i] + o2[i] + bs0)); }
    __syncthreads();
    const bf16* w2t = (const bf16*)(ws + WS_W2T) + (size_t)(l * 2 + kv) * 128 * 256 + (size_t)(16 * w + fr) * 256 + 64 * hq + 8 * fq;
    f32x4 acc = {0.f, 0.f, 0.f, 0.f};
#pragma unroll
    for (int k0 = 0; k0 < 64; k0 += 32) { const bf16x8 av = *(const LAS bf16x8*)(hid + fr * 72 + k0 + 8 * fq), bv = *(const bf16x8*)(w2t + k0); acc = __builtin_amdgcn_mfma_f32_16x16x32_bf16(av, bv, acc, 0, 0, 0); }
    float* pm = (float*)(ws + WS_PARTM) + (size_t)u * 8192;
    { float* pp = pm + (hq * 128 + 16 * w + fr) * 16 + 4 * fq;
#pragma unroll
      for (int i = 0; i < 4; ++i) __hip_atomic_store((GAS float*)(pp + i), acc[i], __ATOMIC_RELAXED, __HIP_MEMORY_SCOPE_AGENT); }
    asm volatile("s_waitcnt vmcnt(0)" ::: "memory"); __syncthreads();
    if (C.tid == 0) { const unsigned old = __hip_atomic_fetch_add((GAS unsigned*)((unsigned*)(ws + WS_CTL) + CW_MLP + 128 * l + u), 1u, __ATOMIC_RELAXED, __HIP_MEMORY_SCOPE_AGENT); const unsigned lastf = (old == 3u) ? 1u : 0u;
        if (lastf) { __builtin_amdgcn_fence(__ATOMIC_ACQUIRE, "agent"); asm volatile("s_waitcnt vmcnt(0)" ::: "memory"); }
        *flag = lastf; }
    __syncthreads();
    if (*flag != 0u) { const int d = C.tid >> 2, n4 = (C.tid & 3) * 4; f32x4 sum = {0.f, 0.f, 0.f, 0.f};
#pragma unroll
        for (int h2 = 0; h2 < 4; ++h2)
#pragma unroll
            for (int i = 0; i < 4; ++i) sum[i] += __hip_atomic_load((GAS const float*)(pm + (h2 * 128 + d) * 16 + n4 + i), __ATOMIC_RELAXED, __HIP_MEMORY_SCOPE_AGENT);
        if (kv == 0) { bf16* kc = (bf16*)(ws + WS_KCMP) + (size_t)g * 512 * 128 + (size_t)(16 * nb + n4) * 128 + d;
#pragma unroll
            for (int i = 0; i < 4; ++i) kc[(size_t)i * 128] = (bf16)f2bf(sum[i]); }
        else { bf16* vt = (bf16*)(ws + WS_VCMPT) + (size_t)g * 128 * 512 + (size_t)d * 512 + 16 * nb + n4;
            *(unsigned long long*)vt = (unsigned long long)pk2(sum[0], sum[1]) | ((unsigned long long)pk2(sum[2], sum[3]) << 32); } }
    __syncthreads();
}
__device__ __forceinline__ float logsig(float v) { const float e = __builtin_amdgcn_exp2f(-fabsf(v) * 1.4426950408889634f); return fminf(v, 0.f) - __builtin_amdgcn_logf(1.f + e) * 0.6931471805599453f; }
__device__ __forceinline__ void scan_head(const Args& a, int l, int h, int lane_in) {
    int lane = lane_in; asm volatile("" : "+v"(lane));
    const f32x4* src = (const f32x4*)((const float*)(a.ws + WS_FT) + (size_t)h * S + lane * 128); f32x4* out = (f32x4*)((float*)(a.ws + WS_BIASF) + (size_t)h * S + lane * 128); const float b = a.in[7][l * 6 + h];
    float loc = 0.f;
    for (int c = 0; c < 8; ++c) { f32x4 v[4];
#pragma unroll
        for (int i = 0; i < 4; ++i) v[i] = src[c * 4 + i];
#pragma unroll
        for (int i = 0; i < 4; ++i) loc += (logsig(v[i].x + b) + logsig(v[i].y + b)) + (logsig(v[i].z + b) + logsig(v[i].w + b)); }
    float inc = loc;
#pragma unroll
    for (int o = 1; o < 64; o <<= 1) { const int sl = lane >= o ? lane - o : lane; const float t = __builtin_bit_cast(float, __builtin_amdgcn_ds_bpermute(sl << 2, __builtin_bit_cast(int, inc))); if (lane >= o) inc += t; }
    float run = inc - loc;
    for (int c = 0; c < 8; ++c) { f32x4 v[4];
#pragma unroll
        for (int i = 0; i < 4; ++i) v[i] = src[c * 4 + i];
#pragma unroll
        for (int i = 0; i < 4; ++i) { f32x4 o4; run += logsig(v[i].x + b); o4.x = -run * (1.0f / SM_SCALE); run += logsig(v[i].y + b); o4.y = -run * (1.0f / SM_SCALE);
            run += logsig(v[i].z + b); o4.z = -run * (1.0f / SM_SCALE); run += logsig(v[i].w + b); o4.w = -run * (1.0f / SM_SCALE); out[c * 4 + i] = o4; } }
}
typedef float f32x16 __attribute__((ext_vector_type(16)));
__device__ __forceinline__ void cmp_head(const Args& a, int g, int r, int qt, LAS float* impw, const LAS float* T5, int lane_in) {
    int lane = lane_in; asm volatile("" : "+v"(lane));
    unsigned char* ws = a.ws; const int r32 = lane & 31, hi = lane >> 5, q = 32 * qt + r32, ntile = qt / 16 + 1;
    constexpr float C2 = 1.4426950408889634f * SM_SCALE; const float NEG = -__builtin_inff();
    for (int i = lane; i < 32 * 130; i += 64) impw[i] = 0.f;
    asm volatile("s_waitcnt lgkmcnt(0)" ::: "memory");
    const bf16* kc = (const bf16*)(ws + WS_KCMP) + (size_t)g * 512 * 128 + (size_t)r32 * 128 + 8 * hi; const bf16* vt = (const bf16*)(ws + WS_VCMPT) + (size_t)g * 128 * 512 + (size_t)r32 * 512 + 4 * hi;
    const int h = 3 * g + r; const LAS float* Td = T5 + h * 132; const float c31 = Td[128];
    const bf16* qp = (const bf16*)(ws + WS_ATT) + (size_t)(HP_QN + h) * S * 128 + (size_t)q * 128 + 8 * hi;
    bf16x8 qr[8];
#pragma unroll
    for (int d0 = 0; d0 < 8; ++d0) qr[d0] = *(const bf16x8*)(qp + d0 * 16);
    bf16x8 kA[8], kB[8];
#define KLOAD(kf, jt) do { const int jc_ = (jt) < ntile ? (jt) : ntile - 1; const bf16* kp_ = kc + (size_t)(32 * jc_) * 128;  \
        _Pragma("unroll") for (int d0 = 0; d0 < 8; ++d0) kf[d0] = *(const bf16x8*)(kp_ + d0 * 16); } while (0)
#define CMP_SCORES(sc, kf, jt) do { _Pragma("unroll") for (int e = 0; e < 16; ++e) sc[e] = c31;                                     \
        _Pragma("unroll") for (int d0 = 0; d0 < 8; ++d0) sc = __builtin_amdgcn_mfma_f32_32x32x16_bf16(kf[d0], qr[d0], sc, 0, 0, 0);  \
        if (512 * (jt) + 527 + 113 > 32 * qt) {              \
            _Pragma("unroll") for (int e = 0; e < 16; ++e) { const int n_ = 32 * (jt) + att::crow(e, hi), dist_ = q - 16 * n_ - 31;  \
                const float tv_ = Td[dist_ < 0 ? 0 : (dist_ > 127 ? 127 : dist_)]; sc[e] = dist_ < 0 ? NEG : sc[e] + tv_; } } } while (0)
    float m = -1e30f, lsum = 0.f;
#define PASS1(kf, jt) do { f32x16 sc; CMP_SCORES(sc, kf, jt); float mx = sc[0];                                                      \
        _Pragma("unroll") for (int e = 1; e < 16; ++e) mx = fmaxf(mx, sc[e]);                                                        \
        const float mn = fmaxf(m, mx); float ps = 0.f;                                                                               \
        _Pragma("unroll") for (int e = 0; e < 16; ++e) ps += __builtin_amdgcn_exp2f((sc[e] - mn) * C2);                              \
        lsum = lsum * __builtin_amdgcn_exp2f((m - mn) * C2) + ps; m = mn; } while (0)
    KLOAD(kA, 0);
    for (int jt = 0; jt < ntile; jt += 2) { KLOAD(kB, jt + 1); PASS1(kA, jt); KLOAD(kA, jt + 2); if (jt + 1 < ntile) PASS1(kB, jt + 1); }
    { const float mo = other_half(m, lane), lo = other_half(lsum, lane); const float M = fmaxf(m, mo);
      lsum = lsum * __builtin_amdgcn_exp2f((m - M) * C2) + lo * __builtin_amdgcn_exp2f((mo - M) * C2); m = M; }
    const float inv = lsum > 0.f ? 1.f / lsum : 0.f;
    f32x16 oT[4];
#pragma unroll
    for (int d = 0; d < 4; ++d)
#pragma unroll
        for (int e = 0; e < 16; ++e) oT[d][e] = 0.f;
#define PASS2(kf, jt) do { f32x16 sc; CMP_SCORES(sc, kf, jt);                                                                        \
        unsigned long long vlo[4], vhh[4];                                                                                           \
        _Pragma("unroll") for (int d = 0; d < 2; ++d) _Pragma("unroll") for (int s2 = 0; s2 < 2; ++s2) { const bf16* vp = vt + (size_t)(32 * d) * 512 + 32 * (jt) + 16 * s2; \
            vlo[d * 2 + s2] = *(const unsigned long long*)vp; vhh[d * 2 + s2] = *(const unsigned long long*)(vp + 8); }              \
        _Pragma("unroll") for (int e = 0; e < 16; ++e) sc[e] = __builtin_amdgcn_exp2f((sc[e] - m) * C2) * inv;                        \
        asm volatile("" ::: "memory");                                                                                               \
        _Pragma("unroll") for (int c = 0; c < 4; ++c) { LAS float* ip = impw + r32 * 130 + 8 * (jt) + 2 * c + hi; ip[0] += (sc[4 * c] + sc[4 * c + 1]) + (sc[4 * c + 2] + sc[4 * c + 3]); } \
        asm volatile("s_waitcnt lgkmcnt(0)" ::: "memory");                                                                           \
        _Pragma("unroll") for (int c = 0; c < 4; ++c) { LAS float* ip = impw + r32 * 130 + 8 * (jt) + 2 * c + hi + 1; ip[0] += sc[4 * c + 3]; } \
        asm volatile("s_waitcnt lgkmcnt(0)" ::: "memory");                                                                           \
        bf16x8 pb[2];                                                                                                                \
        _Pragma("unroll") for (int s2 = 0; s2 < 2; ++s2) { att::u32x4 wv = {att::cvtpk(sc[8 * s2], sc[8 * s2 + 1]), att::cvtpk(sc[8 * s2 + 2], sc[8 * s2 + 3]), att::cvtpk(sc[8 * s2 + 4], sc[8 * s2 + 5]), att::cvtpk(sc[8 * s2 + 6], sc[8 * s2 + 7])}; pb[s2] = *reinterpret_cast<bf16x8*>(&wv); } \
        _Pragma("unroll") for (int dh = 0; dh < 2; ++dh) {                                                                           \
            _Pragma("unroll") for (int d2 = 0; d2 < 2; ++d2) _Pragma("unroll") for (int s2 = 0; s2 < 2; ++s2) { const int d = 2 * dh + d2;  \
                att::u32x4 av = {(unsigned)vlo[d2 * 2 + s2], (unsigned)(vlo[d2 * 2 + s2] >> 32), (unsigned)vhh[d2 * 2 + s2], (unsigned)(vhh[d2 * 2 + s2] >> 32)}; \
                oT[d] = __builtin_amdgcn_mfma_f32_32x32x16_bf16(*reinterpret_cast<bf16x8*>(&av), pb[s2], oT[d], 0, 0, 0); }          \
            if (dh == 0) { _Pragma("unroll") for (int d2 = 0; d2 < 2; ++d2) _Pragma("unroll") for (int s2 = 0; s2 < 2; ++s2) { const bf16* vp = vt + (size_t)(32 * (2 + d2)) * 512 + 32 * (jt) + 16 * s2; \
                vlo[d2 * 2 + s2] = *(const unsigned long long*)vp; vhh[d2 * 2 + s2] = *(const unsigned long long*)(vp + 8); } } } } while (0)
    KLOAD(kA, 0);
    for (int jt = 0; jt < ntile; jt += 2) { KLOAD(kB, jt + 1); PASS2(kA, jt); KLOAD(kA, jt + 2); if (jt + 1 < ntile) PASS2(kB, jt + 1); }
#undef PASS2
#undef PASS1
#undef CMP_SCORES
#undef KLOAD
    const float gc = sigmf(((const float*)(ws + WS_SMALL))[(size_t)q * 32 + 6 + 3 * h]);
    bf16* op = (bf16*)(ws + WS_OC) + ((size_t)h * S + q) * 128;
#pragma unroll
    for (int d = 0; d < 4; ++d)
#pragma unroll
        for (int c = 0; c < 4; ++c) *(unsigned long long*)(op + 32 * d + 8 * c + 4 * hi) =
            (unsigned long long)pk2(oT[d][4 * c] * gc, oT[d][4 * c + 1] * gc) | ((unsigned long long)pk2(oT[d][4 * c + 2] * gc, oT[d][4 * c + 3] * gc) << 32);
    asm volatile("s_waitcnt lgkmcnt(0)" ::: "memory");
}
__device__ __forceinline__ void cmp_topk(const Args& a, int g, int qt, const LAS float* imp3, int lane_in) {
    int lane = lane_in; asm volatile("" : "+v"(lane));
    const int r32 = lane & 31, hi = lane >> 5, q = 32 * qt + r32;
    const int own = q >> 6; float t[13];
#pragma unroll
    for (int i = 0; i < 13; ++i) t[i] = -1.f;
    const LAS float* ip = imp3 + r32 * 130 + 64 * hi;
    for (int j = 0; j < 64; ++j) { const int Mi = 64 * hi + j; float x = (ip[j] + ip[j + 4160]) + ip[j + 8320];
        if (Mi > own || Mi == 0 || Mi == own || Mi == own - 1) x = -1.f;
#pragma unroll
        for (int i = 0; i < 13; ++i) { const float hv = fmaxf(t[i], x); x = fminf(t[i], x); t[i] = hv; } }
    float thr = fmaxf(other_half(t[12], lane), t[12]);
#pragma unroll
    for (int i = 1; i < 13; ++i) thr = fmaxf(thr, fminf(t[i - 1], other_half(t[12 - i], lane)));
    if (own < 16) thr = -1.f;
    unsigned w0 = 0u, w1 = 0u;
    for (int j = 0; j < 64; ++j) { const int Mi = 64 * hi + j; const float x = (ip[j] + ip[j + 4160]) + ip[j + 8320];
        const bool elig = Mi <= own, forced = (Mi == 0) || (Mi == own) || (Mi == own - 1);
        const unsigned bit = (elig && (forced || x >= thr)) ? 1u : 0u;
        if (j < 32) w0 |= bit << j; else w1 |= bit << (j - 32); }
    unsigned* sm = (unsigned*)(a.ws + WS_SELM) + ((size_t)g * S + q) * 4 + 2 * hi;
    *(unsigned long long*)sm = (unsigned long long)w0 | ((unsigned long long)w1 << 32);
}
__global__ void __launch_bounds__(NTHR, 2) skel_fwd(Args a_) {
    extern __shared__ __attribute__((aligned(16))) unsigned char lds_[];
    char* ldsg = (char*)lds_;
    Ctx C; C.lds = (LAS unsigned char*)lds_; C.tid = threadIdx.x; C.lane = C.tid & 63; C.wave = __builtin_amdgcn_readfirstlane((int)threadIdx.x >> 6);
    C.G = gridDim.x; { const int bx = blockIdx.x; C.vcu = (C.G % 8 == 0) ? (bx % 8) * (C.G / 8) + bx / 8 : bx; }
    for (int u = threadIdx.x; u < (LDS_BYTES - LDSCTL_OFF) / 4; u += NTHR) ((LAS unsigned*)(C.lds + LDSCTL_OFF))[u] = 0u;
    __syncthreads();
    XcdBarrier bar = xcd_barrier_post((unsigned*)(a_.ws + WS_CTL) + CW_BAR + a_.li * XCD_BAR_WORDS, (volatile LAS unsigned*)(C.lds + MISC_OFF) + 8);
    const int step_hi = a_.step_hi; int rep_done = -1;
    for (int st = a_.step_lo; st < step_hi; ++st) {
        { int l_; asm volatile("v_mbcnt_lo_u32_b32 %0, -1, 0\n\tv_mbcnt_hi_u32_b32 %0, -1, %0" : "=v"(l_)); C.lane = l_; C.tid = C.wave * 64 + l_; }
        const Args& a = a_;
        unsigned char* ws = a.ws;
        if (st == 0) p0_prologue(a, C);
        else if (st == 1) rowpass(a, C, 0);
        else {
            const int l = (st - 2) / NPH, ph = (st - 2) % NPH;
            if (ph == 0) {
                pg8::Gemm g{(const pg8::bf16_t*)(ws + WS_H), (const pg8::bf16_t*)(ws + WS_WIN) + (size_t)l * NBIG * DM, S, NBIG, DM};
                pg8::StaticOrder So; So.init(S, NBIG, C.G, (int)blockIdx.x);
                pg8::EpiProj E{(pg8::bf16_t*)(ws + WS_CONV), (pg8::bf16_t*)(ws + WS_ZF), (pg8::bf16_t*)(ws + WS_ZN), (pg8::bf16_t*)(ws + WS_ATT)};
                pg8::gemm_phase<pg8::EpiProj, pg8::StaticOrder, true, true>(C.lds, g, So, E, C.tid);
                for (int u = C.vcu; u < 128; u += C.G) small_unit(a, C, l, u);
            } else if (ph == 1) {
                build_t5(ldsg, a.in[16], C.tid);
                if (C.vcu < 256) attn_stream<att::MODE_WIN>(ws, ldsg, l, (volatile LAS unsigned*)(C.lds + MISC_OFF) + 16, SCHED_B + C.vcu * 2, C.tid);
                { volatile LAS unsigned* mflag = (volatile LAS unsigned*)(C.lds + MISC_OFF) + 18;
                  if (C.vcu >= 192) { for (int i = 0; i < 4; ++i) mlp_quarter(a, C, l, (C.vcu - 192) + 64 * i, mflag); }
                  else if (C.vcu < 64) { mlp_quarter(a, C, l, 256 + C.vcu, mflag); mlp_quarter(a, C, l, 320 + C.vcu, mflag); }
                  else mlp_quarter(a, C, l, 384 + (C.vcu - 64), mflag); }
                conv_phase(a, C, l);
#if STEP_LEVEL >= 3
            } else if (ph == 2) {
                build_t5(ldsg, a.in[16], C.tid);
                if (C.wave == 6 && C.vcu < 6) scan_head(a, l, C.vcu, C.lane);
                if (C.wave >= 6) fox_norms(ws, l, C.vcu * 2 + (C.wave - 6), C.G * 2, C.lane);
                for (int ub = C.vcu; ub < 256; ub += C.G) {
                    if (C.wave < 6) { const int g = C.wave >= 3 ? 1 : 0, r = C.wave - 3 * g, qt = g ? 255 - ub : ub;
                        cmp_head(a, g, r, qt, (LAS float*)(C.lds) + C.wave * 4160, (const LAS float*)(C.lds + att::LDS_T5), C.lane); }
                    __syncthreads();
                    if (C.wave == 0 || C.wave == 3) { const int g = C.wave == 3 ? 1 : 0, qt = g ? 255 - ub : ub; cmp_topk(a, g, qt, (const LAS float*)(C.lds) + C.wave * 4160, C.lane); }
                    __syncthreads();
                }
#endif
#if STEP_LEVEL >= 4
            } else if (ph == 3) {
                build_t5(ldsg, a.in[16], C.tid);
                { volatile LAS unsigned* misc = (volatile LAS unsigned*)(C.lds + MISC_OFF) + 16; const int rep = (rep_done == st) ? 1 : 0; unsigned* qh = (unsigned*)(ws + WS_CTL) + CW_QD + 64 * l + 32 * rep;
                  if (!(rep && PROBE_FOX_ONLY == 2)) attn_stream_q<att::MODE_FOX>(ws, ldsg, l, misc, ITEMS_FOX, N_ITEMS_FOX, qh + 16, C.tid, rep);
                  if (!(rep && PROBE_FOX_ONLY == 1)) attn_stream_q<att::MODE_SLC>(ws, ldsg, l, misc, ITEMS_SLC, N_ITEMS_SLC, qh, C.tid, rep); }
#endif
            } else if (ph == 4) {
                pg8::Gemm g{(const pg8::bf16_t*)(ws + WS_Y), (const pg8::bf16_t*)(ws + WS_WOUT) + (size_t)l * DM * DM, S, DM, DM};
                pg8::StaticOrder So; So.init(S, DM, C.G, (int)blockIdx.x);
                pg8::EpiF32 E{(float*)(ws + WS_Y2), DM};
                pg8::gemm_phase<pg8::EpiF32, pg8::StaticOrder, true, true>(C.lds, g, So, E, C.tid);
            } else if (ph == 5) {
                rowpass(a, C, l + 1);
            }
        }
        if (st + 1 < step_hi) xcd_barrier(bar);
        if (((st >= 2 && (st - 2) % NPH == a_.pad) || (st < 2 && st + 100 == a_.pad)) && rep_done != st) { rep_done = st; --st; }
    }
}
#ifndef PROBE_PH
#define PROBE_PH (-1)
#endif
#ifndef ONE_LAUNCH
#define ONE_LAUNCH 1
#endif
static void launch_steps(const Args& base, int lo, int hi, int li, int grid, hipStream_t stream) {
    Args a = base; a.step_lo = lo; a.step_hi = hi; a.li = li;
    hipLaunchKernelGGL(skel_fwd, dim3(grid), dim3(NTHR), LDS_BYTES, stream, a);
}
extern "C" void kernel_launch(void* const* d_in, const int* in_sizes, int n_in, void* d_out, int out_size, void* d_ws, size_t ws_size, hipStream_t stream) {
    static int grid = 0;
    if (grid == 0) {
        int dev = 0, cus = 0, per_cu = 0;
        hipGetDevice(&dev); hipDeviceGetAttribute(&cus, hipDeviceAttributeMultiprocessorCount, dev);
        hipFuncSetAttribute((const void*)skel_fwd, hipFuncAttributeMaxDynamicSharedMemorySize, LDS_BYTES);
        hipOccupancyMaxActiveBlocksPerMultiprocessor(&per_cu, (const void*)skel_fwd, NTHR, LDS_BYTES);
        (void)hipGetLastError();
        if (per_cu < 1) fprintf(stderr, "kernel_launch: occupancy query says %d blocks/CU\n", per_cu);
        grid = cus;
        if (grid != 256) fprintf(stderr, "kernel_launch: built for 256 CUs, found %d\n", cus);
    }
    hipMemsetAsync((char*)d_ws + WS_CTL, 0, CTL_ZERO_BYTES, stream);
    Args a{}; for (int i = 0; i < 17; ++i) a.in[i] = (const float*)d_in[i];
    a.out = (float*)d_out; a.ws = (unsigned char*)d_ws; a.pad = PROBE_PH;
#if ONE_LAUNCH
    launch_steps(a, 0, NSTEPS, 1, grid, stream);
#else
    launch_steps(a, 0, 2, 1, grid, stream);
    for (int st = 2; st < NSTEPS; ++st) launch_steps(a, st, st + 1, 0, grid, stream);
#endif
}
```
